# Optimizing an MI355X kernel written in HIP

```python
import math
import jax, jax.numpy as jnp
from jax import lax
import numpy as np

D_MODEL = 1024
BATCH = 8
SEQ = 4096
DEPTH = 2

MEM_LEN = 256
D_MIX = D_MODEL
HEAD_DIM = 64
ATTN_Q_HEADS = 8
ATTN_KV_HEADS = 2
ATTN_WIDTH = ATTN_Q_HEADS * HEAD_DIM
KV_WIDTH = ATTN_KV_HEADS * HEAD_DIM
WINDOW = 128
BLOCK = 128
SC_WIDTH = D_MIX // 4
SC_CONV = 3
RG_HEADS = 4
RG_WIDTH = D_MIX // 4
RG_HEAD_DIM = RG_WIDTH // RG_HEADS
RG_CONV = 4
RG_C = 8.0
N_BUCKETS = 32
MAX_EXACT = N_BUCKETS // 2
MAX_DISTANCE = 128
XA_HEADS = 4
XA_HEAD_DIM = 128
XA_WIDTH = XA_HEADS * XA_HEAD_DIM
D_FF_DENSE = 2816
N_EXPERTS = 8
TOP_K = 2
D_FF_EXPERT = 3584
N_DENSE = (DEPTH + 1) // 2
N_MOE = DEPTH // 2
EPS = 1e-6
NEG_INF = -1e30
IN_COLS = ATTN_WIDTH + 2 * KV_WIDTH + 3 * SC_WIDTH + 2 * RG_WIDTH

kernel_name = "hymba_style_hybrid_swa_shortconv_rglru_moe"


def rms_norm(x, g):
    xf = x.astype(jnp.float32)
    y = xf * lax.rsqrt(jnp.mean(xf * xf, axis=-1, keepdims=True) + EPS) * g.astype(jnp.float32)
    return y.astype(x.dtype)


def causal_dwconv(u, w, b):
    k_width = w.shape[0]
    s = u.shape[1]
    up = jnp.pad(u, ((0, 0), (k_width - 1, 0), (0, 0)))
    out = b
    for k in range(k_width):
        out = out + w[k] * up[:, k:k + s]
    return out


def t5_bucket(dist):
    n = jnp.maximum(dist, 0)
    large = MAX_EXACT + (jnp.log(jnp.maximum(n, 1).astype(jnp.float32) / MAX_EXACT)
                         / math.log(MAX_DISTANCE / MAX_EXACT) * (N_BUCKETS - MAX_EXACT)).astype(jnp.int32)
    large = jnp.minimum(large, N_BUCKETS - 1)
    return jnp.where(n < MAX_EXACT, n, large)


def sliding_window_sink_attention(q, k, v, sinks, rel_bias):
    b, s, _ = q.shape
    nb = s // BLOCK
    g = ATTN_Q_HEADS // ATTN_KV_HEADS
    qb = q.reshape(b, nb, BLOCK, ATTN_KV_HEADS, g, HEAD_DIM)
    kb = k.reshape(b, nb, BLOCK, ATTN_KV_HEADS, HEAD_DIM)
    vb = v.reshape(b, nb, BLOCK, ATTN_KV_HEADS, HEAD_DIM)

    def band(t):
        prev = jnp.pad(t, ((0, 0), (1, 0), (0, 0), (0, 0), (0, 0)))[:, :-1]
        return jnp.concatenate([prev, t], axis=2)

    kband, vband = band(kb), band(vb)
    scores = jnp.einsum('bnqhgd,bnkhd->bnhgqk', qb, kband,
                        preferred_element_type=jnp.float32) / math.sqrt(HEAD_DIM)
    q_idx = jnp.arange(BLOCK)
    k_idx = jnp.arange(2 * BLOCK)
    dist = q_idx[:, None] + BLOCK - k_idx[None, :]
    in_window = (dist >= 0) & (dist < WINDOW)
    has_prev = (jnp.arange(nb)[:, None] > 0) | (k_idx[None, :] >= BLOCK)
    mask = in_window[None, :, :] & has_prev[:, None, :]
    bias = rel_bias[t5_bucket(dist)].astype(jnp.float32)
    bias = bias.transpose(2, 0, 1).reshape(ATTN_KV_HEADS, g, BLOCK, 2 * BLOCK)
    logits = jnp.where(mask[None, :, None, None, :, :], scores + bias, NEG_INF)
    sink = sinks.astype(jnp.float32).reshape(ATTN_KV_HEADS, g)[None, None, :, :, None, None]
    m = jnp.maximum(jnp.max(logits, axis=-1, keepdims=True), sink)
    p = jnp.exp(logits - m)
    probs = p / (jnp.sum(p, axis=-1, keepdims=True) + jnp.exp(sink - m))
    out = jnp.einsum('bnhgqk,bnkhd->bnqhgd', probs.astype(v.dtype), vband)
    return out.reshape(b, s, ATTN_WIDTH)


def rg_lru(x, w_a, b_a, w_x, b_x, lam):
    b, s, _ = x.shape
    xf = x.astype(jnp.float32)
    xb = xf.reshape(b, s, RG_HEADS, RG_HEAD_DIM)
    r = jax.nn.sigmoid(jnp.einsum('bshi,hij->bshj', xb, w_a.astype(jnp.float32)).reshape(b, s, RG_WIDTH)
                       + b_a.astype(jnp.float32))
    i = jax.nn.sigmoid(jnp.einsum('bshi,hij->bshj', xb, w_x.astype(jnp.float32)).reshape(b, s, RG_WIDTH)
                       + b_x.astype(jnp.float32))
    log_a = -RG_C * r * jax.nn.softplus(-lam.astype(jnp.float32))
    a = jnp.exp(log_a)
    u = jnp.sqrt(-jnp.expm1(2.0 * log_a)) * (i * xf)

    def combine(c1, c2):
        a1, b1 = c1
        a2, b2 = c2
        return a1 * a2, a2 * b1 + b2

    _, h = lax.associative_scan(combine, (a, u), axis=1)
    return h.astype(x.dtype)


def memory_cross_attention(h, mem_n, wq, wk, wv, wo):
    b, s, _ = h.shape
    q = (h @ wq).reshape(b, s, XA_HEADS, XA_HEAD_DIM)
    k = (mem_n @ wk).reshape(b, MEM_LEN, XA_HEADS, XA_HEAD_DIM)
    v = (mem_n @ wv).reshape(b, MEM_LEN, XA_HEADS, XA_HEAD_DIM)
    scores = jnp.einsum('bshd,bmhd->bhsm', q, k, preferred_element_type=jnp.float32) / math.sqrt(XA_HEAD_DIM)
    probs = jax.nn.softmax(scores, axis=-1).astype(v.dtype)
    out = jnp.einsum('bhsm,bmhd->bshd', probs, v).reshape(b, s, XA_WIDTH)
    return out @ wo


def swiglu(h, wg, wu, wd):
    return (jax.nn.silu(h @ wg) * (h @ wu)) @ wd


def moe_swiglu(h, router, wg, wu, wd):
    logits = (h @ router).astype(jnp.float32)
    top_val, top_idx = lax.top_k(logits, TOP_K)
    w = jax.nn.softmax(top_val, axis=-1)
    gates = jnp.sum(jax.nn.one_hot(top_idx, N_EXPERTS, dtype=jnp.float32) * w[..., None], axis=-2)
    out = jnp.zeros_like(h)
    for e in range(N_EXPERTS):
        out = out + gates[..., e:e + 1].astype(h.dtype) * swiglu(h, wg[e], wu[e], wd[e])
    return out


def setup_inputs(seed: int = 0) -> dict:
    key = jax.random.key(seed)
    ks = jax.random.split(key, 32)
    L = DEPTH

    def nrm(k, shape, scale):
        return jax.random.normal(k, shape, jnp.float32) * scale

    def gain(k, shape):
        return 1.0 + 0.05 * jax.random.normal(k, shape, jnp.float32)

    a0 = jax.random.uniform(ks[14], (L, RG_WIDTH), jnp.float32, minval=0.9, maxval=0.999)
    return {
        "x": nrm(ks[0], (BATCH, SEQ, D_MODEL), 1.0),
        "mem": nrm(ks[1], (BATCH, MEM_LEN, D_MODEL), 1.0),
        "rel_bias": nrm(ks[2], (N_BUCKETS, ATTN_Q_HEADS), 0.5),
        "mix_norm": gain(ks[3], (L, D_MODEL)),
        "w_in": nrm(ks[4], (L, D_MODEL, IN_COLS), D_MODEL ** -0.5),
        "attn_sinks": nrm(ks[5], (L, ATTN_Q_HEADS), 0.5),
        "sc_conv_w": nrm(ks[6], (L, SC_CONV, SC_WIDTH), SC_CONV ** -0.5),
        "sc_conv_b": nrm(ks[7], (L, SC_WIDTH), 0.01),
        "rg_conv_w": nrm(ks[8], (L, RG_CONV, RG_WIDTH), RG_CONV ** -0.5),
        "rg_conv_b": nrm(ks[9], (L, RG_WIDTH), 0.01),
        "rg_w_a": nrm(ks[10], (L, RG_HEADS, RG_HEAD_DIM, RG_HEAD_DIM), RG_HEAD_DIM ** -0.5),
        "rg_b_a": nrm(ks[11], (L, RG_WIDTH), 0.01),
        "rg_w_x": nrm(ks[12], (L, RG_HEADS, RG_HEAD_DIM, RG_HEAD_DIM), RG_HEAD_DIM ** -0.5),
        "rg_b_x": nrm(ks[13], (L, RG_WIDTH), 0.01),
        "rg_lambda": jnp.log(a0) - jnp.log1p(-a0),
        "w_out": nrm(ks[15], (L, D_MIX, D_MODEL), D_MIX ** -0.5),
        "xa_norm": gain(ks[16], (L, D_MODEL)),
        "mem_norm": gain(ks[17], (L, D_MODEL)),
        "xa_wq": nrm(ks[18], (L, D_MODEL, XA_WIDTH), D_MODEL ** -0.5),
        "xa_wk": nrm(ks[19], (L, D_MODEL, XA_WIDTH), D_MODEL ** -0.5),
        "xa_wv": nrm(ks[20], (L, D_MODEL, XA_WIDTH), D_MODEL ** -0.5),
        "xa_wo": nrm(ks[21], (L, XA_WIDTH, D_MODEL), XA_WIDTH ** -0.5),
        "ffn_norm": gain(ks[22], (L, D_MODEL)),
        "dense_wg": nrm(ks[23], (N_DENSE, D_MODEL, D_FF_DENSE), D_MODEL ** -0.5),
        "dense_wu": nrm(ks[24], (N_DENSE, D_MODEL, D_FF_DENSE), D_MODEL ** -0.5),
        "dense_wd": nrm(ks[25], (N_DENSE, D_FF_DENSE, D_MODEL), D_FF_DENSE ** -0.5),
        "moe_router": nrm(ks[26], (N_MOE, D_MODEL, N_EXPERTS), D_MODEL ** -0.5),
        "moe_wg": nrm(ks[27], (N_MOE, N_EXPERTS, D_MODEL, D_FF_EXPERT), D_MODEL ** -0.5),
        "moe_wu": nrm(ks[28], (N_MOE, N_EXPERTS, D_MODEL, D_FF_EXPERT), D_MODEL ** -0.5),
        "moe_wd": nrm(ks[29], (N_MOE, N_EXPERTS, D_FF_EXPERT, D_MODEL), D_FF_EXPERT ** -0.5),
        "final_norm": gain(ks[30], (D_MODEL,)),
    }


def reference(x, mem, rel_bias, mix_norm, w_in, attn_sinks, sc_conv_w, sc_conv_b,
              rg_conv_w, rg_conv_b, rg_w_a, rg_b_a, rg_w_x, rg_b_x, rg_lambda, w_out,
              xa_norm, mem_norm, xa_wq, xa_wk, xa_wv, xa_wo, ffn_norm,
              dense_wg, dense_wu, dense_wd, moe_router, moe_wg, moe_wu, moe_wd, final_norm):
    widths = [ATTN_WIDTH, KV_WIDTH, KV_WIDTH, SC_WIDTH, SC_WIDTH, SC_WIDTH, RG_WIDTH, RG_WIDTH]
    offsets = [int(o) for o in np.cumsum(widths)[:-1]]
    for layer in range(DEPTH):
        h = rms_norm(x, mix_norm[layer])
        proj = h @ w_in[layer]
        q, k, v, sc_b, sc_c, sc_x, rg_x, rg_g = jnp.split(proj, offsets, axis=-1)
        attn_out = sliding_window_sink_attention(q, k, v, attn_sinks[layer], rel_bias)
        conv_out = sc_b * causal_dwconv(sc_c * sc_x, sc_conv_w[layer], sc_conv_b[layer])
        rg_in = causal_dwconv(rg_x, rg_conv_w[layer], rg_conv_b[layer])
        rg_out = rg_lru(rg_in, rg_w_a[layer], rg_b_a[layer], rg_w_x[layer], rg_b_x[layer],
                        rg_lambda[layer]) * jax.nn.gelu(rg_g)
        mixed = jnp.concatenate([attn_out, conv_out, rg_out], axis=-1)
        x = x + mixed @ w_out[layer]
        hx = rms_norm(x, xa_norm[layer])
        mem_n = rms_norm(mem, mem_norm[layer])
        x = x + memory_cross_attention(hx, mem_n, xa_wq[layer], xa_wk[layer], xa_wv[layer], xa_wo[layer])
        hf = rms_norm(x, ffn_norm[layer])
        if layer % 2 == 0:
            j = layer // 2
            x = x + swiglu(hf, dense_wg[j], dense_wu[j], dense_wd[j])
        else:
            j = layer // 2
            x = x + moe_swiglu(hf, moe_router[j], moe_wg[j], moe_wu[j], moe_wd[j])
    return rms_norm(x, final_norm)
```

```cpp
#include <hip/hip_runtime.h>
#include <cstdio>
#include <cstdint>
#define MK_ONE_LAUNCH 1
namespace pg8 {
#define PG8_LAS __attribute__((address_space(3)))
typedef unsigned short bf16_t;
typedef short bf16x8 __attribute__((ext_vector_type(8)));
typedef float f32x4 __attribute__((ext_vector_type(4)));
typedef unsigned u32x4 __attribute__((ext_vector_type(4)));
constexpr int BM = 256, BK = 64, HALF = 128, HTB = HALF * BK * 2  , STAGE_BYTES = 8 * HTB, NXCD = 8, WGM = 4;

__host__ __device__ __forceinline__ int lds_byte(int r, int c) { const int st = (r >> 4) * 2 + (c >> 5), rr = r & 15, cc = c & 31, ob = rr * 64 + cc * 2; return st * 1024 + (ob ^ (((ob >> 9) & 1) << 5)); }
__host__ __device__ __forceinline__ void stage_rc(int b, int& R, int& C) { const int st = b / 1024, sb = b % 1024, swz = sb ^ (((sb >> 9) & 1) << 5); R = (st >> 1) * 16 + swz / 64; C = (st & 1) * 32 + (swz % 64) / 2; }
__host__ __device__ __forceinline__ int perm32(int rho) { const int n = rho >> 4, i = rho & 15; return 8 * (i >> 2) + 4 * n + (i & 3); }

struct Unit { int pm, pn; };
struct Gemm { const bf16_t* A; const bf16_t* Bt; int M, N, K; };

struct StaticOrder {
    int nM, nN, nwg, G, c;
    __host__ __device__ void init(int M, int N, int G_, int c_) { nM = M / BM; nN = N / BM; nwg = nM * nN; G = G_; c = c_; }
    __host__ __device__ bool next(int i, Unit& u) const {
        const long L = (long)i * G + c; if (L >= nwg) return false;
        int wgid = (int)L; { const int q = nwg / NXCD, r = nwg % NXCD, xcd = wgid % NXCD, off = wgid / NXCD; wgid = (xcd < r ? xcd * (q + 1) : r * (q + 1) + (xcd - r) * q) + off; }
        const int nig = WGM * nN, gid = wgid / nig, fm = gid * WGM, gsz = (nM - fm) < WGM ? (nM - fm) : WGM;
        u.pm = fm + ((wgid % nig) % gsz); u.pn = (wgid % nig) / gsz; return true;
    }
    __device__ __forceinline__ void a_ready(const Unit&) const {}
    __device__ __forceinline__ void done(const Unit&) const {}
    static constexpr bool GATHER = false; __device__ __forceinline__ int arow_raw(const Unit&, int) const { return 0; } __device__ __forceinline__ int arow_fix(int) const { return 0; }
};

__device__ __forceinline__ unsigned cvt_pk_bf16(float lo, float hi) { unsigned r; asm volatile("v_cvt_pk_bf16_f32 %0, %1, %2" : "=v"(r) : "v"(lo), "v"(hi)); return r; }
typedef float f32x2 __attribute__((ext_vector_type(2)));
__device__ __forceinline__ void plswap32(unsigned& a, unsigned& b) { auto r = __builtin_amdgcn_permlane32_swap(a, b, false, false); a = r[0]; b = r[1]; }
__device__ __forceinline__ void plswap16(unsigned& a, unsigned& b) { auto r = __builtin_amdgcn_permlane16_swap(a, b, false, false); a = r[0]; b = r[1]; }
__device__ __forceinline__ void swap32_pair(float x, float& r0, float& r1) { unsigned a = __builtin_bit_cast(unsigned, x), b = a; asm volatile("" : "+v"(b)); auto r = __builtin_amdgcn_permlane32_swap(a, b, false, false);
    unsigned q0 = r[0], q1 = r[1]; asm volatile("" : "+v"(q0), "+v"(q1)); r0 = __builtin_bit_cast(float, q0); r1 = __builtin_bit_cast(float, q1); }
__device__ __forceinline__ void swap16_pair(float x, float& r0, float& r1) { unsigned a = __builtin_bit_cast(unsigned, x), b = a; asm volatile("" : "+v"(b)); auto r = __builtin_amdgcn_permlane16_swap(a, b, false, false);
    unsigned q0 = r[0], q1 = r[1]; asm volatile("" : "+v"(q0), "+v"(q1)); r0 = __builtin_bit_cast(float, q0); r1 = __builtin_bit_cast(float, q1); }
__device__ __forceinline__ float xor32_sum(float x) { float a, b; swap32_pair(x, a, b); return a + b; }
__device__ __forceinline__ float xor32_max(float x) { float a, b; swap32_pair(x, a, b); return fmaxf(a, b); }
__device__ __forceinline__ float xor16_sum(float x) { float a, b; swap16_pair(x, a, b); return a + b; }
__device__ __forceinline__ float xor32_other(float x, int hi) { float a, b; swap32_pair(x, a, b); return hi ? a : b; }
typedef float f32x2 __attribute__((ext_vector_type(2)));
typedef unsigned u32x2 __attribute__((ext_vector_type(2)));
constexpr float RMS_EPS = 1e-6f;
__device__ __forceinline__ float rstd_of(float sumsq) { return __builtin_amdgcn_rsqf(sumsq * (1.0f / 1024.0f) + RMS_EPS); }
__device__ __forceinline__ unsigned pk4_fp8(float a, float b, float c, float d) { int w = __builtin_amdgcn_cvt_pk_fp8_f32(a, b, 0, false); w = __builtin_amdgcn_cvt_pk_fp8_f32(c, d, w, true); return (unsigned)w; }
__device__ __forceinline__ float silu_f(float g) { return g * __builtin_amdgcn_rcpf(1.0f + __expf(-g)); }

struct EpiScaleBf16 {
    static constexpr bool PERM = true, AFTER_DRAIN = false; static constexpr int VMOPS = 16;
    bf16_t* O; int ldc; const float* rowsq; float cs;
    __device__ __forceinline__ void operator()(const f32x4 (&acc)[2][2][4][2], const Unit& u, int wr, int wc, int fr, int fq) const {
        const int row0 = u.pm * BM + wr * 64 + fr, col0 = u.pn * BM + wc * 32 + 8 * fq;
        f32x4 pqv[2][4];
#pragma unroll
        for (int ai = 0; ai < 2; ++ai)
#pragma unroll
            for (int m = 0; m < 4; ++m) pqv[ai][m] = *(const f32x4*)(rowsq + (size_t)(row0 + ai * HALF + m * 16) * 4);
#pragma unroll
        for (int ai = 0; ai < 2; ++ai)
#pragma unroll
            for (int m = 0; m < 4; ++m) { const int row = row0 + ai * HALF + m * 16; const f32x4 pq = pqv[ai][m]; const float rs = rstd_of((pq[0] + pq[1]) + (pq[2] + pq[3])) * cs; bf16_t* rowp = O + (size_t)row * ldc + col0;
#pragma unroll
                for (int bj = 0; bj < 2; ++bj) { const f32x4 v0 = acc[ai][bj][m][0] * rs, v1 = acc[ai][bj][m][1] * rs;
                    u32x4 w; w.x = cvt_pk_bf16(v0[0], v0[1]); w.y = cvt_pk_bf16(v0[2], v0[3]); w.z = cvt_pk_bf16(v1[0], v1[1]); w.w = cvt_pk_bf16(v1[2], v1[3]);
                    *(u32x4*)(rowp + bj * HALF) = w; } }
    }
};
struct EpiResid {
    static constexpr bool PERM = true, AFTER_DRAIN = false; static constexpr int VMOPS = 24;
    bf16_t* xb; float* rowsq4; PG8_LAS float* red; unsigned char* x8; float ws;
    __device__ __forceinline__ void operator()(const f32x4 (&acc)[2][2][4][2], const Unit& u, int wr, int wc, int fr, int fq) const {
        const int row0 = u.pm * BM + wr * 64 + fr, col0 = u.pn * BM + wc * 32 + 8 * fq;
        u32x4 xiv[2][4][2];
#pragma unroll
        for (int ai = 0; ai < 2; ++ai)
#pragma unroll
            for (int m = 0; m < 4; ++m)
#pragma unroll
                for (int bj = 0; bj < 2; ++bj) xiv[ai][m][bj] = *(const u32x4*)(xb + (size_t)(row0 + ai * HALF + m * 16) * 1024 + col0 + bj * HALF);
#pragma unroll
        for (int ai = 0; ai < 2; ++ai)
#pragma unroll
            for (int mp = 0; mp < 2; ++mp) { unsigned qx[2][2], qy[2][2];
#pragma unroll
              for (int mm = 0; mm < 2; ++mm) { const int m = 2 * mp + mm; const int row = row0 + ai * HALF + m * 16; bf16_t* rowp = xb + (size_t)row * 1024 + col0; float ss = 0.f;
#pragma unroll
                for (int bj = 0; bj < 2; ++bj) { const u32x4 xi = xiv[ai][m][bj];
                    f32x4 o0 = acc[ai][bj][m][0] * ws, o1 = acc[ai][bj][m][1] * ws;
                    o0[0] += __builtin_bit_cast(float, xi.x << 16); o0[1] += __builtin_bit_cast(float, xi.x & 0xffff0000u); o0[2] += __builtin_bit_cast(float, xi.y << 16); o0[3] += __builtin_bit_cast(float, xi.y & 0xffff0000u);
                    o1[0] += __builtin_bit_cast(float, xi.z << 16); o1[1] += __builtin_bit_cast(float, xi.z & 0xffff0000u); o1[2] += __builtin_bit_cast(float, xi.w << 16); o1[3] += __builtin_bit_cast(float, xi.w & 0xffff0000u);
                    ss += ((o0[0] * o0[0] + o0[1] * o0[1]) + (o0[2] * o0[2] + o0[3] * o0[3])) + ((o1[0] * o1[0] + o1[1] * o1[1]) + (o1[2] * o1[2] + o1[3] * o1[3]));
                    u32x4 w; w.x = cvt_pk_bf16(o0[0], o0[1]); w.y = cvt_pk_bf16(o0[2], o0[3]); w.z = cvt_pk_bf16(o1[0], o1[1]); w.w = cvt_pk_bf16(o1[2], o1[3]);
                    *(u32x4*)(rowp + bj * HALF) = w;
                    if (x8) { qx[mm][bj] = pk4_fp8(o0[0], o0[1], o0[2], o0[3]); qy[mm][bj] = pk4_fp8(o1[0], o1[1], o1[2], o1[3]); } }
                ss = xor16_sum(ss); ss = xor32_sum(ss);
                if (fq == 0) red[(ai * HALF + wr * 64 + m * 16 + fr) * 4 + wc] = ss; }
              if (x8) { unsigned char* xp = x8 + (size_t)(row0 + ai * HALF + (2 * mp + (fq & 1)) * 16) * 1024 + u.pn * BM + wc * 32 + 16 * (fq >> 1);
#pragma unroll
                for (int bj = 0; bj < 2; ++bj) { plswap16(qx[0][bj], qx[1][bj]); plswap16(qy[0][bj], qy[1][bj]);
                    u32x4 w; w.x = qx[0][bj]; w.y = qy[0][bj]; w.z = qx[1][bj]; w.w = qy[1][bj]; *(u32x4*)(xp + bj * HALF) = w; } } }
        asm volatile("s_waitcnt lgkmcnt(0)" ::: "memory"); __builtin_amdgcn_s_barrier(); asm volatile("" ::: "memory");
        const int t = (wr * 4 + wc) * 64 + fq * 16 + fr;
        if (t < 256) { const f32x4 p = *(const PG8_LAS f32x4*)(red + t * 4); rowsq4[(size_t)(u.pm * BM + t) * 4 + u.pn] = (p[0] + p[1]) + (p[2] + p[3]); }
    }
};
template <bool DIRECT_RSTD> struct EpiSwiglu {
    static constexpr bool PERM = true, AFTER_DRAIN = false; static constexpr int VMOPS = 12;
    bf16_t* H; int ldh; const float* rs_src; int tile0, nct;
    __device__ __forceinline__ void operator()(const f32x4 (&acc)[2][2][4][2], const Unit& u, int wr, int wc, int fr, int fq) const {
        const int prow0 = u.pm * BM + wr * 64 + fr, orow0 = (u.pm - tile0) * BM + wr * 64 + fr, col0 = (u.pn % nct) * HALF + wc * 32 + 8 * fq;
        float rsv[2][4];
        if (DIRECT_RSTD) {
#pragma unroll
            for (int ai = 0; ai < 2; ++ai)
#pragma unroll
                for (int m = 0; m < 4; ++m) rsv[ai][m] = rs_src[prow0 + ai * HALF + m * 16];
        } else { f32x4 pqv[2][4];
#pragma unroll
            for (int ai = 0; ai < 2; ++ai)
#pragma unroll
                for (int m = 0; m < 4; ++m) pqv[ai][m] = *(const f32x4*)(rs_src + (size_t)(prow0 + ai * HALF + m * 16) * 4);
#pragma unroll
            for (int ai = 0; ai < 2; ++ai)
#pragma unroll
                for (int m = 0; m < 4; ++m) rsv[ai][m] = rstd_of((pqv[ai][m][0] + pqv[ai][m][1]) + (pqv[ai][m][2] + pqv[ai][m][3])); }
#pragma unroll
        for (int ai = 0; ai < 2; ++ai)
#pragma unroll
            for (int m = 0; m < 4; ++m) { const float rs = rsv[ai][m];
                const f32x4 g0 = acc[ai][0][m][0] * rs, g1 = acc[ai][0][m][1] * rs, u0 = acc[ai][1][m][0] * rs, u1 = acc[ai][1][m][1] * rs;
                u32x4 w; w.x = cvt_pk_bf16(silu_f(g0[0]) * u0[0], silu_f(g0[1]) * u0[1]); w.y = cvt_pk_bf16(silu_f(g0[2]) * u0[2], silu_f(g0[3]) * u0[3]);
                w.z = cvt_pk_bf16(silu_f(g1[0]) * u1[0], silu_f(g1[1]) * u1[1]); w.w = cvt_pk_bf16(silu_f(g1[2]) * u1[2], silu_f(g1[3]) * u1[3]);
                *(u32x4*)(H + (size_t)(orow0 + ai * HALF + m * 16) * ldh + col0) = w; }
    }
};
template <bool DIRECT_RSTD> struct EpiSwigluF8 {
    static constexpr bool PERM = true, AFTER_DRAIN = false; static constexpr int VMOPS = 10;
    unsigned char* H; int ldh; const float* rs_src; int tile0, nct; float ws;
    __device__ __forceinline__ void operator()(const f32x4 (&acc)[2][2][4][2], const Unit& u, int wr, int wc, int fr, int fq) const {
        const int prow0 = u.pm * BM + wr * 64 + fr, orow0 = (u.pm - tile0) * BM + wr * 64 + fr, colw = (u.pn % nct) * HALF + wc * 32 + 16 * (fq >> 1);
        float rsv[2][4];
        if (DIRECT_RSTD) {
#pragma unroll
            for (int ai = 0; ai < 2; ++ai)
#pragma unroll
                for (int m = 0; m < 4; ++m) rsv[ai][m] = rs_src[prow0 + ai * HALF + m * 16];
        } else { f32x4 pqv[2][4];
#pragma unroll
            for (int ai = 0; ai < 2; ++ai)
#pragma unroll
                for (int m = 0; m < 4; ++m) pqv[ai][m] = *(const f32x4*)(rs_src + (size_t)(prow0 + ai * HALF + m * 16) * 4);
#pragma unroll
            for (int ai = 0; ai < 2; ++ai)
#pragma unroll
                for (int m = 0; m < 4; ++m) rsv[ai][m] = rstd_of((pqv[ai][m][0] + pqv[ai][m][1]) + (pqv[ai][m][2] + pqv[ai][m][3])); }
#pragma unroll
        for (int ai = 0; ai < 2; ++ai)
#pragma unroll
            for (int mp = 0; mp < 2; ++mp) { unsigned qx[2], qy[2];
#pragma unroll
                for (int mm = 0; mm < 2; ++mm) { const int m = 2 * mp + mm;
                    const float rs = rsv[ai][m] * ws;
                    const f32x4 g0 = acc[ai][0][m][0] * rs, g1 = acc[ai][0][m][1] * rs, u0 = acc[ai][1][m][0] * rs, u1 = acc[ai][1][m][1] * rs;
                    qx[mm] = pk4_fp8(silu_f(g0[0]) * u0[0], silu_f(g0[1]) * u0[1], silu_f(g0[2]) * u0[2], silu_f(g0[3]) * u0[3]);
                    qy[mm] = pk4_fp8(silu_f(g1[0]) * u1[0], silu_f(g1[1]) * u1[1], silu_f(g1[2]) * u1[2], silu_f(g1[3]) * u1[3]); }
                plswap16(qx[0], qx[1]); plswap16(qy[0], qy[1]);
                u32x4 w; w.x = qx[0]; w.y = qy[0]; w.z = qx[1]; w.w = qy[1];
                *(u32x4*)(H + (size_t)(orow0 + ai * HALF + (2 * mp + (fq & 1)) * 16) * ldh + colw) = w; }
    }
};
struct EpiMoeDown {
    static constexpr bool PERM = true, AFTER_DRAIN = false; static constexpr int VMOPS = 8;
    unsigned char* Y0; unsigned char* Y1; const int* slot_tok; const float* slot_gate; int tile0, nct; float ws;
    __device__ __forceinline__ void operator()(const f32x4 (&acc)[2][2][4][2], const Unit& u, int wr, int wc, int fr, int fq) const {
        const int srow0 = (u.pm + tile0) * BM + wr * 64 + fr, colw = (u.pn % nct) * BM + wc * 32 + 16 * (fq >> 1);
        int tkv[2][4]; float gtv[2][4];
#pragma unroll
        for (int ai = 0; ai < 2; ++ai)
#pragma unroll
            for (int m = 0; m < 4; ++m) { tkv[ai][m] = slot_tok[srow0 + ai * HALF + m * 16]; gtv[ai][m] = slot_gate[srow0 + ai * HALF + m * 16]; }
#pragma unroll
        for (int ai = 0; ai < 2; ++ai)
#pragma unroll
            for (int mp = 0; mp < 2; ++mp) { const int tka = tkv[ai][2 * mp], tkb = tkv[ai][2 * mp + 1]; const float gta = gtv[ai][2 * mp] * ws, gtb = gtv[ai][2 * mp + 1] * ws;
                const int tk = (fq & 1) ? tkb : tka; unsigned char* yp = ((tk >> 24) ? Y1 : Y0) + (size_t)(tk & 0xffffff) * 1024 + colw;
#pragma unroll
                for (int bj = 0; bj < 2; ++bj) { const f32x4 a0 = acc[ai][bj][2 * mp][0] * gta, a1 = acc[ai][bj][2 * mp][1] * gta, b0 = acc[ai][bj][2 * mp + 1][0] * gtb, b1 = acc[ai][bj][2 * mp + 1][1] * gtb;
                    unsigned ax = pk4_fp8(a0[0], a0[1], a0[2], a0[3]), ay = pk4_fp8(a1[0], a1[1], a1[2], a1[3]), bx = pk4_fp8(b0[0], b0[1], b0[2], b0[3]), by = pk4_fp8(b1[0], b1[1], b1[2], b1[3]);
                    plswap16(ax, bx); plswap16(ay, by);
                    u32x4 w; w.x = ax; w.y = ay; w.z = bx; w.w = by;
                    if (tk >= 0) *(u32x4*)(yp + bj * HALF) = w; } }
    }
};
struct MoeOrder {
    int nM, nN, nwg, G, c, pm_base, tile0; const PG8_LAS int* tile_e;
    __device__ void init(int nM_, int nN_, int G_, int c_, int pm_base_, int tile0_, const PG8_LAS int* te) { nM = nM_; nN = nN_; nwg = nM * nN; G = G_; c = c_; pm_base = pm_base_; tile0 = tile0_; tile_e = te; }
    __device__ bool next(int i, Unit& u) const { return at((long)i * G + c, u); }
    __device__ bool at(long L, Unit& u) const {
        if (L >= nwg) return false;
        int wgid = (int)L; { const int q = nwg / NXCD, r = nwg % NXCD, xcd = wgid % NXCD, off = wgid / NXCD; wgid = (xcd < r ? xcd * (q + 1) : r * (q + 1) + (xcd - r) * q) + off; }
        const int nig = WGM * nN, gid = wgid / nig, fm = gid * WGM, gsz = (nM - fm) < WGM ? (nM - fm) : WGM;
        const int lm = fm + ((wgid % nig) % gsz), ln = (wgid % nig) / gsz;
        const int e = __builtin_amdgcn_readfirstlane(tile_e[lm]);
        u.pm = pm_base + lm; u.pn = e * nN + ln; return true;
    }
    __device__ __forceinline__ void a_ready(const Unit&) const {}
    __device__ __forceinline__ void done(const Unit&) const {}
    static constexpr bool GATHER = false; __device__ __forceinline__ int arow_raw(const Unit&, int) const { return 0; } __device__ __forceinline__ int arow_fix(int) const { return 0; }
};
struct MoeGatherOrder : MoeOrder {
    static constexpr bool GATHER = true; const int* slot_tok;
    __device__ __forceinline__ int arow_raw(const Unit& u, int r) const { return slot_tok[u.pm * BM + r]; }
    __device__ __forceinline__ int arow_fix(int tk) const { return tk < 0 ? 0 : (tk & 0xffffff); }
};
struct MoeGatherSkipOrder : MoeGatherOrder {
    int rem, skip;
    __device__ bool next(int i, Unit& u) const {
        long L;
        if (c < rem) L = (long)skip * (G - rem) + (long)i * G + c;
        else L = (i < skip) ? (long)i * (G - rem) + (c - rem) : (long)skip * (G - rem) + (long)(i - skip) * G + c;
        return at(L, u);
    }
};
typedef int i32x8 __attribute__((ext_vector_type(8)));
typedef int i32x4 __attribute__((ext_vector_type(4)));
__device__ __forceinline__ void mfma_f8_inplace(f32x4& acc, const i32x8& a, const i32x8& b, int sc) {
    asm volatile("v_mfma_scale_f32_16x16x128_f8f6f4 %0, %1, %2, %0, %3, %3 op_sel_hi:[0,0,0]" : "+v"(acc) : "v"(a), "v"(b), "v"(sc));
}
__device__ __forceinline__ i32x8 cat8(bf16x8 lo, bf16x8 hi) { const i32x4 a = __builtin_bit_cast(i32x4, lo), b = __builtin_bit_cast(i32x4, hi); return (i32x8){a.x, a.y, a.z, a.w, b.x, b.y, b.z, b.w}; }
template <class Epi, class Sched, bool ALIGN_EPI = false, bool SP2 = false, bool F8 = false>
__device__ __forceinline__ void gemm_phase(PG8_LAS unsigned char* lds, const Gemm g, const Sched& S, const Epi& E) {
    int tid_ = threadIdx.x; asm volatile("" : "+v"(tid_));
    const int tid = tid_, wid = __builtin_amdgcn_readfirstlane(tid >> 6), lane = tid & 63, wr = wid >> 2, wc = wid & 3, fr = lane & 15, fq = lane >> 4;
    constexpr int EB = F8 ? 1 : 2;
    const int K = g.K, nt = K * EB / (BK * 2);
    unsigned voffA[2], voffB[2];
#pragma unroll
    for (int i = 0; i < 2; ++i) { int R, C; stage_rc(tid * 16 + i * 8192, R, C); const int Rb = Epi::PERM ? ((R & ~31) + perm32(R & 31)) : R;
        voffA[i] = (unsigned)(R * K * EB + C * 2); voffB[i] = (unsigned)(Rb * K * EB + C * 2); }
    constexpr bool GATHER = Sched::GATHER;
    unsigned gvC[2][2], gvN[2][2], gvNN[2][2];
    int rawN[2][2];
#define PG8_RAW(dst, un) do { _Pragma("unroll") for (int h_ = 0; h_ < 2; ++h_) _Pragma("unroll") for (int i_ = 0; i_ < 2; ++i_) { int R_, C_; stage_rc(tid * 16 + i_ * 8192, R_, C_); dst[h_][i_] = S.arow_raw(un, h_ * HALF + R_); } } while (0)
#define PG8_GVR(dst, raw) do { _Pragma("unroll") for (int h_ = 0; h_ < 2; ++h_) _Pragma("unroll") for (int i_ = 0; i_ < 2; ++i_) { int R_, C_; stage_rc(tid * 16 + i_ * 8192, R_, C_); \
        dst[h_][i_] = (unsigned)S.arow_fix(raw[h_][i_]) * (unsigned)(K * EB) + (unsigned)(C_ * 2); } } while (0)
    const size_t kstep = (size_t)(BK * 2);
    const size_t hstep = (size_t)HALF * K * EB;
    const size_t tstep = 2 * hstep;
    const unsigned ldsw = (unsigned)wid * 1024u;
    const int aoff = lds_byte(wr * 64 + fr, fq * 8), boff = lds_byte(wc * 32 + fr, fq * 8);
#define PG8_SA(b, h) (((b) * 2 + (h)) * HTB)
#define PG8_SB(b, h) ((4 + (b) * 2 + (h)) * HTB)
#define PG8_STAGE(bufoff, gbase, voff) do { _Pragma("unroll") for (int _i = 0; _i < 2; ++_i) \
        __builtin_amdgcn_global_load_lds((const unsigned*)((const char*)(gbase) + (voff)[_i]), (PG8_LAS unsigned*)(lds + (bufoff) + ldsw + _i * 8192), 16, 0, 0); } while (0)
#define PG8_STA(bufoff, ptr, NX, H, KO) do { if constexpr (GATHER) { const unsigned g0_ = (NX) ? gvN[H][0] : gvC[H][0], g1_ = (NX) ? gvN[H][1] : gvC[H][1]; const char* gb_ = (const char*)g.A + (KO); \
        __builtin_amdgcn_global_load_lds((const unsigned*)(gb_ + g0_), (PG8_LAS unsigned*)(lds + (bufoff) + ldsw), 16, 0, 0); \
        __builtin_amdgcn_global_load_lds((const unsigned*)(gb_ + g1_), (PG8_LAS unsigned*)(lds + (bufoff) + ldsw + 8192), 16, 0, 0); } else { PG8_STAGE(bufoff, ptr, voffA); } } while (0)
#define PG8_LDF(dst8, dst, idx, addr) do { if constexpr (F8) { const i32x4 lo_ = *(const PG8_LAS i32x4*)(addr), hi_ = *(const PG8_LAS i32x4*)((addr) + 1024); dst8[idx] = __builtin_shufflevector(lo_, hi_, 0, 1, 2, 3, 4, 5, 6, 7); } \
        else { dst[idx][0] = *(const PG8_LAS bf16x8*)(addr); dst[idx][1] = *(const PG8_LAS bf16x8*)((addr) + 1024); } } while (0)
#define PG8_LDA(dst, b, h) do { _Pragma("unroll") for (int m = 0; m < 4; ++m) PG8_LDF(dst##8, dst, m, lds + PG8_SA(b, h) + aoff + m * 2048); } while (0)
#define PG8_LDB(dst, b, h) do { _Pragma("unroll") for (int n = 0; n < 2; ++n) PG8_LDF(dst##8, dst, n, lds + PG8_SB(b, h) + boff + n * 2048); } while (0)
#define PG8_MMA(ai, bj, At, Bt) do { __builtin_amdgcn_s_setprio(1); if constexpr (F8) { _Pragma("unroll") for (int m = 0; m < 4; ++m) _Pragma("unroll") for (int n = 0; n < 2; ++n) \
        mfma_f8_inplace(acc[ai][bj][m][n], Bt##8[n], At##8[m], one_scale); } else { \
        _Pragma("unroll") for (int m = 0; m < 4; ++m) _Pragma("unroll") for (int n = 0; n < 2; ++n) _Pragma("unroll") for (int k = 0; k < 2; ++k) \
        acc[ai][bj][m][n] = __builtin_amdgcn_mfma_f32_16x16x32_bf16(Bt[n][k], At[m][k], acc[ai][bj][m][n], 0, 0, 0); } __builtin_amdgcn_s_setprio(0); } while (0)
#define PG8_WAIT_V(n) asm volatile("s_waitcnt vmcnt(" #n ")" ::: "memory")
#define PG8_WAIT_L(n) asm volatile("s_waitcnt lgkmcnt(" #n ")" ::: "memory")
#define PG8_BAR __builtin_amdgcn_s_barrier()
#define PG8_SCHED __builtin_amdgcn_sched_barrier(0)
    Unit cur, nxt; int ui = 0;
    if (!S.next(0, cur)) return;
    f32x4 acc[2][2][4][2];
#pragma unroll
    for (int a = 0; a < 2; ++a)
#pragma unroll
        for (int b = 0; b < 2; ++b)
#pragma unroll
            for (int m = 0; m < 4; ++m)
#pragma unroll
                for (int n = 0; n < 2; ++n) acc[a][b][m][n] = (f32x4){0.f, 0.f, 0.f, 0.f};
    int one_scale = 0x7F7F7F7F; asm volatile("" : "+v"(one_scale));
    bf16x8 At[4][2], B0[2][2], B1[2][2]; i32x8 At8[4], B08[2], B18[2];
    const char* cA = (const char*)g.A + (size_t)cur.pm * tstep; const char* cB = (const char*)g.Bt + (size_t)cur.pn * tstep;
    S.a_ready(cur);
    if constexpr (GATHER) { PG8_RAW(rawN, cur); PG8_GVR(gvC, rawN); Unit n1_; if (S.next(1, n1_)) { PG8_RAW(rawN, n1_); } PG8_GVR(gvNN, rawN); }
    if constexpr (SP2) {
        PG8_STAGE(PG8_SB(0, 0), cB, voffB); PG8_STAGE(PG8_SB(0, 1), cB + hstep, voffB); PG8_STA(PG8_SA(0, 0), cA, false, 0, 0); PG8_STA(PG8_SA(0, 1), cA + hstep, false, 1, 0);
        if (wr == 1) PG8_BAR;
        PG8_WAIT_V(2); PG8_BAR;
        PG8_STAGE(PG8_SB(1, 0), cB + kstep, voffB); PG8_STA(PG8_SA(1, 0), cA + kstep, false, 0, kstep); PG8_STAGE(PG8_SB(1, 1), cB + hstep + kstep, voffB);
        PG8_WAIT_V(6); PG8_BAR;
    } else {
        PG8_STAGE(PG8_SB(0, 0), cB, voffB); PG8_STAGE(PG8_SA(0, 0), cA, voffA); PG8_STAGE(PG8_SB(0, 1), cB + hstep, voffB); PG8_STAGE(PG8_SA(0, 1), cA + hstep, voffA);
        if (wr == 1) PG8_BAR;
        PG8_WAIT_V(4); PG8_BAR;
        PG8_STAGE(PG8_SB(1, 0), cB + kstep, voffB); PG8_STAGE(PG8_SA(1, 0), cA + kstep, voffA); PG8_STAGE(PG8_SB(1, 1), cB + hstep + kstep, voffB);
        PG8_WAIT_V(6); PG8_BAR;
    }
    for (;;) {
        const bool has_next = S.next(ui + 1, nxt);
        if constexpr (GATHER) { if (has_next) { _Pragma("unroll") for (int h_ = 0; h_ < 2; ++h_) _Pragma("unroll") for (int i_ = 0; i_ < 2; ++i_) gvN[h_][i_] = gvNN[h_][i_]; }
                                else { _Pragma("unroll") for (int h_ = 0; h_ < 2; ++h_) _Pragma("unroll") for (int i_ = 0; i_ < 2; ++i_) gvN[h_][i_] = gvC[h_][i_]; } }
        const char* nA = has_next ? (const char*)g.A + (size_t)nxt.pm * tstep : cA; const char* nB = has_next ? (const char*)g.Bt + (size_t)nxt.pn * tstep : cB;
#pragma unroll 1
        for (int t = 0; t < nt; t += 2) {
            const bool last = (t == nt - 2);
            const char* a1 = cA + (size_t)(t + 1) * kstep;
            const char* a2 = last ? nA : cA + (size_t)(t + 2) * kstep; const char* b2 = last ? nB : cB + (size_t)(t + 2) * kstep;
            const char* a3 = a2 + kstep; const char* b3 = b2 + kstep; const size_t ko2 = last ? (size_t)0 : (size_t)(t + 2) * kstep; (void)ko2;
            if (last && has_next) S.a_ready(nxt);
            if constexpr (SP2) {
            PG8_LDB(B0, 0, 0); PG8_LDB(B1, 0, 1); PG8_SCHED; PG8_LDA(At, 0, 0); PG8_STA(PG8_SA(1, 1), a1 + hstep, false, 1, (size_t)(t + 1) * kstep);
            const bool relax = (t == 0 && ui > 0);
            if (relax) { asm volatile("s_waitcnt vmcnt(%0)" :: "n"(8 + Epi::VMOPS) : "memory"); } else { PG8_WAIT_V(8); }
            PG8_WAIT_L(0); PG8_BAR; PG8_MMA(0, 0, At, B0); PG8_MMA(0, 1, At, B1); PG8_BAR; PG8_SCHED;
            PG8_LDA(At, 0, 1); PG8_STAGE(PG8_SB(0, 0), b2, voffB); PG8_STAGE(PG8_SB(0, 1), b2 + hstep, voffB); PG8_STA(PG8_SA(0, 0), a2, last, 0, ko2);
            if (relax) { asm volatile("s_waitcnt vmcnt(%0)" :: "n"(8 + Epi::VMOPS) : "memory"); } else { PG8_WAIT_V(8); }
            PG8_WAIT_L(0); PG8_BAR; PG8_MMA(1, 0, At, B0); PG8_MMA(1, 1, At, B1); PG8_BAR; PG8_SCHED;
            PG8_LDB(B0, 1, 0); PG8_LDB(B1, 1, 1); PG8_SCHED; PG8_LDA(At, 1, 0); PG8_STA(PG8_SA(0, 1), a2 + hstep, last, 1, ko2);
            PG8_WAIT_V(8); PG8_WAIT_L(0); PG8_BAR; PG8_MMA(0, 0, At, B0); PG8_MMA(0, 1, At, B1); PG8_BAR; PG8_SCHED;
            PG8_LDA(At, 1, 1); PG8_STAGE(PG8_SB(1, 0), b3, voffB); PG8_STAGE(PG8_SB(1, 1), b3 + hstep, voffB); PG8_STA(PG8_SA(1, 0), a3, last, 0, ko2 + kstep);
            PG8_WAIT_V(8); PG8_WAIT_L(0); PG8_BAR; PG8_MMA(1, 0, At, B0); PG8_MMA(1, 1, At, B1); PG8_BAR; PG8_SCHED;
            } else {
            PG8_LDB(B0, 0, 0); PG8_SCHED; PG8_LDA(At, 0, 0); PG8_STAGE(PG8_SA(1, 1), a1 + hstep, voffA);
            PG8_WAIT_L(8); PG8_BAR; PG8_WAIT_L(0); PG8_MMA(0, 0, At, B0); PG8_BAR; PG8_SCHED;
            PG8_LDB(B1, 0, 1); PG8_STAGE(PG8_SB(0, 0), b2, voffB);
            PG8_BAR; PG8_WAIT_L(0); PG8_MMA(0, 1, At, B1); PG8_BAR;
            PG8_LDA(At, 0, 1); PG8_STAGE(PG8_SA(0, 0), a2, voffA);
            PG8_BAR; PG8_WAIT_L(0); PG8_MMA(1, 0, At, B0); PG8_BAR; PG8_SCHED;
            PG8_STAGE(PG8_SB(0, 1), b2 + hstep, voffB);
            PG8_WAIT_V(6); PG8_BAR; PG8_MMA(1, 1, At, B1); PG8_BAR;
            PG8_LDB(B0, 1, 0); PG8_SCHED; PG8_LDA(At, 1, 0); PG8_STAGE(PG8_SA(0, 1), a2 + hstep, voffA);
            PG8_WAIT_L(8); PG8_BAR; PG8_WAIT_L(0); PG8_MMA(0, 0, At, B0); PG8_BAR; PG8_SCHED;
            PG8_LDB(B1, 1, 1); PG8_STAGE(PG8_SB(1, 0), b3, voffB);
            PG8_BAR; PG8_WAIT_L(0); PG8_MMA(0, 1, At, B1); PG8_BAR;
            PG8_LDA(At, 1, 1); PG8_STAGE(PG8_SA(1, 0), a3, voffA);
            PG8_BAR; PG8_WAIT_L(0); PG8_MMA(1, 0, At, B0); PG8_BAR; PG8_SCHED;
            PG8_STAGE(PG8_SB(1, 1), b3 + hstep, voffB);
            PG8_WAIT_V(6); PG8_BAR; PG8_MMA(1, 1, At, B1); PG8_BAR;
            }
        }
        if constexpr (ALIGN_EPI) { if (wr == 0) PG8_BAR; }
        if constexpr (GATHER) { Unit n2_; if (has_next && S.next(ui + 2, n2_)) { PG8_RAW(rawN, n2_); } }
        if constexpr (F8) { asm volatile("s_nop 15\n\ts_nop 7" ::: "memory"); }
        if constexpr (!Epi::AFTER_DRAIN) { int fr_e = fr, fq_e = fq; asm volatile("" : "+v"(fr_e), "+v"(fq_e)); E(acc, cur, wr, wc, fr_e, fq_e); S.done(cur); }
        if constexpr (GATHER) { PG8_GVR(gvNN, rawN); }
        if (!has_next) break;
#pragma unroll
        for (int a = 0; a < 2; ++a)
#pragma unroll
            for (int b = 0; b < 2; ++b)
#pragma unroll
                for (int m = 0; m < 4; ++m)
#pragma unroll
                    for (int n = 0; n < 2; ++n) acc[a][b][m][n] = (f32x4){0.f, 0.f, 0.f, 0.f};
        cur = nxt; cA = nA; cB = nB; ++ui;
        if constexpr (GATHER) { _Pragma("unroll") for (int h_ = 0; h_ < 2; ++h_) _Pragma("unroll") for (int i_ = 0; i_ < 2; ++i_) gvC[h_][i_] = gvN[h_][i_]; }
        if constexpr (ALIGN_EPI) { if (wr == 1) PG8_BAR; }
    }
    PG8_WAIT_V(0);
    if constexpr (!ALIGN_EPI) { if (wr == 0) PG8_BAR; }
    PG8_BAR;
    if constexpr (Epi::AFTER_DRAIN) { E.fused(acc, cur, wr, wc, fr, fq, lds, wid, lane); S.done(cur); }
#undef PG8_SA
#undef PG8_SB
#undef PG8_STAGE
#undef PG8_STA
#undef PG8_RAW
#undef PG8_GVR
#undef PG8_LDF
#undef PG8_LDA
#undef PG8_LDB
#undef PG8_MMA
#undef PG8_WAIT_V
#undef PG8_WAIT_L
#undef PG8_BAR
#undef PG8_SCHED
}
}

constexpr int NWAVES = 8;
constexpr int BATCH = 8, SEQ = 4096, D = 1024, M = BATCH * SEQ, MEMLEN = 256, MROWS = BATCH * MEMLEN;
constexpr int INCOLS = 2048, FFD = 2816, FFE = 3584, NEXP = 8;
constexpr int NSLOT = 2 * M + NEXP * 256;
constexpr int MAXTILES = NSLOT / 256;
constexpr int NGROUPS = 2, GTILES = 128, GTILES_MAX = 136, MD_SKIP = 3;
constexpr float W8_SCALE = 64.0f;
constexpr float EPS = 1e-6f;
#ifndef MK_ONE_LAUNCH
#define MK_ONE_LAUNCH 0
#endif
constexpr size_t MiB = 1u << 20;
constexpr size_t WS_CTL = 0, CTL_ZERO_BYTES = 64 * 1024;
constexpr size_t WS_RGSUM = 2 * MiB, WS_TOKE = WS_RGSUM + 512 * 1024, WS_TOKW = WS_TOKE + 256 * 1024, WS_TOKP = WS_TOKW + 256 * 1024, WS_TOKR = WS_TOKP + 256 * 1024;
constexpr size_t WS_SLOTT = 3 * MiB + 512 * 1024, WS_SLOTG = 4 * MiB, WS_SLOTR = 4 * MiB + 512 * 1024, WS_TILEE = 5 * MiB, WS_WGCNT = 5 * MiB + 256 * 1024, WS_WVCNT = 5 * MiB + 384 * 1024, WS_MEMSQ = 5 * MiB + 512 * 1024;
constexpr size_t WS_WMGU = 8 * MiB, WS_WMD = 64 * MiB, WS_X8 = 92 * MiB, WS_XB = 176 * MiB;
constexpr size_t WS_WIN = 240 * MiB, WS_WOUT = 248 * MiB, WS_WXQ = 252 * MiB, WS_WKV = 254 * MiB, WS_WXO = 258 * MiB, WS_RGW = 260 * MiB;
constexpr size_t WS_WDGU = 261 * MiB, WS_WDD = 272 * MiB, WS_KVMEM = 278 * MiB, WS_MEMB = 286 * MiB, WS_PROJ = 290 * MiB, WS_MIXED = 418 * MiB;
constexpr size_t WS_RGC = 124 * MiB;
constexpr size_t WS_QXA = 290 * MiB, WS_XO = 322 * MiB, WS_HD = 290 * MiB, WS_HG = 240 * MiB, WS_HGB = 359 * MiB, WS_Y0 = 124 * MiB, WS_Y1 = 471 * MiB, WS_ROWSQ = 504 * MiB, WS_END = 508 * MiB;
static_assert(WS_TOKR + 128 * 1024 <= WS_SLOTT && WS_SLOTT + (size_t)NSLOT * 4 <= WS_SLOTG && WS_SLOTG + (size_t)NSLOT * 4 <= WS_SLOTR && WS_SLOTR + (size_t)NSLOT * 4 <= WS_TILEE, "small map");
static_assert(WS_WMGU + (size_t)NEXP * 2 * FFE * D <= WS_WMD && WS_WMD + (size_t)NEXP * D * FFE <= WS_X8 && WS_X8 + (size_t)M * D <= WS_XB && WS_XB + (size_t)M * D * 2 <= WS_WIN, "map1");
static_assert(WS_WDGU + (size_t)2 * FFD * D * 2 <= WS_WDD && WS_WDD + (size_t)D * FFD * 2 <= WS_KVMEM && WS_KVMEM + (size_t)MROWS * 2048 * 2 <= WS_MEMB && WS_MEMB + (size_t)MROWS * D * 2 <= WS_PROJ, "map2");
static_assert(WS_PROJ + (size_t)M * INCOLS * 2 <= WS_MIXED && WS_MIXED + (size_t)M * D * 2 <= WS_ROWSQ && WS_HD + (size_t)M * FFD * 2 <= WS_ROWSQ && WS_ROWSQ + (size_t)6 * M * 16 <= WS_END, "map3");
static_assert(WS_HG + (size_t)GTILES_MAX * 256 * FFE <= WS_HGB && WS_HGB + (size_t)GTILES * 256 * FFE <= WS_Y1 && WS_X8 + (size_t)M * D <= WS_Y0 && WS_Y0 + (size_t)M * D <= WS_XB && WS_Y1 + (size_t)M * D <= WS_ROWSQ, "map4");
constexpr int CW_TMO = 0, CW_CODE = 1, CW_BAR = 4096;
constexpr int RING_OFF = 0, RING_BYTES = 131072, LDSCTL_OFF = RING_BYTES, MISC_OFF = LDSCTL_OFF + 320, RED_OFF = LDSCTL_OFF + 1024, LDS_BYTES = 147456;

#define GAS __attribute__((address_space(1)))
#define LAS __attribute__((address_space(3)))
typedef unsigned short bf16;
typedef unsigned v4u __attribute__((ext_vector_type(4)));
typedef unsigned v2u __attribute__((ext_vector_type(2)));
typedef float f32x4 __attribute__((ext_vector_type(4)));
typedef GAS unsigned gu32;
#define RLX_AGENT __ATOMIC_RELAXED, __HIP_MEMORY_SCOPE_AGENT
#define LDS_WAIT() asm volatile("s_waitcnt lgkmcnt(0)" ::: "memory")
#define VM_WAIT() asm volatile("s_waitcnt vmcnt(0)" ::: "memory")
__device__ __forceinline__ unsigned f2bf(float f) { unsigned u = __builtin_bit_cast(unsigned, f); return (u + 0x7fffu + ((u >> 16) & 1u)) >> 16; }
__device__ __forceinline__ unsigned pk2(float lo, float hi) { return f2bf(lo) | (f2bf(hi) << 16); }
__device__ __forceinline__ float bf2f(unsigned short h) { return __builtin_bit_cast(float, (unsigned)h << 16); }
__device__ __forceinline__ float bflo(unsigned w) { return __builtin_bit_cast(float, w << 16); }
__device__ __forceinline__ float bfhi(unsigned w) { return __builtin_bit_cast(float, w & 0xffff0000u); }
#define XB_TMO      128
#define XB_XCNT(j)  (256  + 64 * (j))
#define XB_XSUB(j)  (1280 + 64 * (j))
#define XB_XGEN(j)  (2304 + 64 * (j))
#define XB_TOP      3328
#define XB_TOPGEN   3392
#define XCD_BAR_WORDS 3456
#define XB_SPIN_CAP (1u << 18)

__device__ __forceinline__ unsigned xb_ld(unsigned* p)              { return __hip_atomic_load(p, __ATOMIC_RELAXED, __HIP_MEMORY_SCOPE_AGENT); }
__device__ __forceinline__ unsigned xb_add(unsigned* p, unsigned v) { return __hip_atomic_fetch_add(p, v, __ATOMIC_RELAXED, __HIP_MEMORY_SCOPE_AGENT); }
__device__ __forceinline__ unsigned xb_xcc_id() { return (unsigned)__builtin_amdgcn_s_getreg((3 << 11) | 20) & 0xFu; }
#define XB_SPIN(cond, bar) do { unsigned _sp = 0; while (cond) { __builtin_amdgcn_s_sleep(1); \
    if ((++_sp & 255u) == 0u) { if (xb_ld(&(bar)[XB_TMO])) break; if (_sp > XB_SPIN_CAP) { atomicAdd(&(bar)[XB_TMO], 1u); break; } } } } while (0)

struct XcdBarrier {
    unsigned* bar; unsigned x;
    volatile LAS unsigned* st;
};

__device__ __forceinline__ XcdBarrier xcd_barrier_post(unsigned* bar, volatile LAS unsigned* st) {
    XcdBarrier b; b.bar = bar; b.x = xb_xcc_id(); b.st = st;
    if (threadIdx.x == 0) (void)xb_add(&bar[XB_XCNT(b.x)], 1u);
    return b;
}
__device__ __forceinline__ void xcd_barrier_complete(unsigned* bar, unsigned x, unsigned& nloc, unsigned& nx) {
    const unsigned G = gridDim.x * gridDim.y * gridDim.z;
    unsigned sum, cnt, mine, sp = 0u;
    for (;;) {
        sum = 0u; cnt = 0u; mine = 0u;
#pragma unroll
        for (unsigned j = 0; j < 16; ++j) { const unsigned c = xb_ld(&bar[XB_XCNT(j)]); sum += c; cnt += (c > 0u) ? 1u : 0u; mine = (j == x) ? c : mine; }
        if (sum == G) break;
        __builtin_amdgcn_s_sleep(1);
        if ((++sp & 255u) == 0u) { if (xb_ld(&bar[XB_TMO])) break; if (sp > XB_SPIN_CAP) { atomicAdd(&bar[XB_TMO], 1u); break; } }
    }
    nloc = mine > 0u ? mine : 1u; nx = cnt > 0u ? cnt : 1u;
}

__device__ __forceinline__ void xcd_barrier(const XcdBarrier& b) {
    asm volatile("s_waitcnt vmcnt(0)" ::: "memory");
    __syncthreads();
    if (threadIdx.x == 0) {
        unsigned* bar = b.bar;
        __builtin_amdgcn_s_waitcnt(0);
        unsigned nloc = b.st[0], nx = b.st[1];
        if (nloc == 0u) { xcd_barrier_complete(bar, b.x, nloc, nx); b.st[0] = nloc; b.st[1] = nx; }
        const unsigned old = xb_add(&bar[XB_XSUB(b.x)], 1u);
        const unsigned gen = old / nloc;
        if (old + 1u == (gen + 1u) * nloc) {
            __builtin_amdgcn_fence(__ATOMIC_RELEASE, "agent");
            asm volatile("s_waitcnt vmcnt(0)" ::: "memory");
            const unsigned og = xb_add(&bar[XB_TOP], 1u);
            const unsigned tg = og / nx;
            if (og + 1u == (tg + 1u) * nx) xb_add(&bar[XB_TOPGEN], 1u);
            else XB_SPIN(xb_ld(&bar[XB_TOPGEN]) == tg, bar);
            __builtin_amdgcn_fence(__ATOMIC_ACQUIRE, "agent");
            xb_add(&bar[XB_XGEN(b.x)], 1u);
            asm volatile("s_waitcnt vmcnt(0)" ::: "memory");
        } else {
            XB_SPIN(xb_ld(&bar[XB_XGEN(b.x)]) == gen, bar);
            __builtin_amdgcn_fence(__ATOMIC_ACQUIRE, "agent");
            asm volatile("s_waitcnt vmcnt(0)" ::: "memory");
        }
    }
    __syncthreads();
}

typedef float f32x2 __attribute__((ext_vector_type(2)));
struct Args { const float* in[31]; float* out; unsigned char* ws; int ph_lo, ph_hi; };
typedef const volatile __attribute__((address_space(4))) unsigned long long* karg_ptr;
__device__ __forceinline__ unsigned long long ldkarg(int i) { return ((karg_ptr)__builtin_amdgcn_kernarg_segment_ptr())[i]; }
struct KIn { __device__ __forceinline__ const float* operator[](int i) const { return (const float*)(const GAS float*)ldkarg(i); } };
struct KArgs { KIn in; __device__ __forceinline__ unsigned char* ws() const { return (unsigned char*)(GAS unsigned char*)ldkarg(32); } __device__ __forceinline__ float* out() const { return (float*)(GAS float*)ldkarg(31); } };
struct Frame {
    LAS unsigned char* lds;
    int tid, lane, wave, G, bid;
    const float* const* in;
};
__device__ __forceinline__ float wave_sum(float v) {
#pragma unroll
    for (int o = 1; o < 64; o <<= 1) v += __shfl_xor(v, o);
    return v;
}
__device__ __forceinline__ float gelu_tanh(float x) {
    const float y = 0.7978845608028654f * (x + 0.044715f * x * x * x);
    const float e = __expf(2.0f * y);
    const float th = 1.0f - 2.0f * __builtin_amdgcn_rcpf(e + 1.0f);
    return 0.5f * x * (1.0f + th);
}
__device__ __forceinline__ float sigmoid_f(float z) { return __builtin_amdgcn_rcpf(1.0f + __expf(-z)); }

__device__ __forceinline__ void transpose_tile(const float* Wt, int N, bf16* dst, int K, const float* gk, LAS float* scr, int lane) {
    float v[32];
#pragma unroll
    for (int i = 0; i < 32; ++i) v[i] = Wt[(size_t)(2 * i + (lane >> 5)) * N + (lane & 31)];
    if (gk) {
#pragma unroll
        for (int i = 0; i < 32; ++i) v[i] *= gk[2 * i + (lane >> 5)]; }
#pragma unroll
    for (int i = 0; i < 32; ++i) scr[(2 * i + (lane >> 5)) * 33 + (lane & 31)] = v[i];
    LDS_WAIT(); asm volatile("" ::: "memory");
    const int c = lane & 7;
#pragma unroll
    for (int j = 0; j < 4; ++j) { const int n = (lane >> 3) + 8 * j; const LAS float* s = scr + (8 * c) * 33 + n;
        v4u o; o.x = pg8::cvt_pk_bf16(s[0 * 33], s[1 * 33]); o.y = pg8::cvt_pk_bf16(s[2 * 33], s[3 * 33]); o.z = pg8::cvt_pk_bf16(s[4 * 33], s[5 * 33]); o.w = pg8::cvt_pk_bf16(s[6 * 33], s[7 * 33]);
        *(GAS v4u*)(dst + (size_t)n * K + 8 * c) = o; }
    LDS_WAIT(); asm volatile("" ::: "memory");
}
__device__ __forceinline__ void transpose_tile8(const float* Wt, int N, unsigned char* dst, int K, const float* gk, float scl, LAS float* scr, int lane) {
    float v[32];
#pragma unroll
    for (int i = 0; i < 32; ++i) v[i] = Wt[(size_t)(2 * i + (lane >> 5)) * N + (lane & 31)];
#pragma unroll
    for (int i = 0; i < 32; ++i) v[i] *= gk ? gk[2 * i + (lane >> 5)] * scl : scl;
#pragma unroll
    for (int i = 0; i < 32; ++i) scr[(2 * i + (lane >> 5)) * 33 + (lane & 31)] = v[i];
    LDS_WAIT(); asm volatile("" ::: "memory");
    const int c = lane & 7;
#pragma unroll
    for (int j = 0; j < 4; ++j) { const int n = (lane >> 3) + 8 * j; const LAS float* s = scr + (8 * c) * 33 + n;
        v2u o; o.x = pg8::pk4_fp8(s[0 * 33], s[1 * 33], s[2 * 33], s[3 * 33]); o.y = pg8::pk4_fp8(s[4 * 33], s[5 * 33], s[6 * 33], s[7 * 33]);
        *(GAS v2u*)(dst + (size_t)n * K + 8 * c) = o; }
    LDS_WAIT(); asm volatile("" ::: "memory");
}
__device__ __forceinline__ void conv_plain8(const float* W, int K, int N, int sub, unsigned char* WT, int drow0, const float* gain, float scl, LAS float* scr, int lane) {
    const int nblk = N / 32, kb = sub / nblk, nb = sub % nblk;
    transpose_tile8(W + (size_t)(64 * kb) * N + 32 * nb, N, WT + (size_t)(drow0 + 32 * nb) * K + 64 * kb, K, gain ? gain + 64 * kb : nullptr, scl, scr, lane);
}
__device__ __forceinline__ void conv_gu8(const float* W, int K, int N, int sub, unsigned char* WT, int up, const float* gain, float scl, LAS float* scr, int lane) {
    const int nblk = N / 32, kb = sub / nblk, nb = sub % nblk, n0 = 32 * nb, drow = (n0 >> 7) * 256 + (n0 & 127) + up * 128;
    transpose_tile8(W + (size_t)(64 * kb) * N + n0, N, WT + (size_t)drow * K + 64 * kb, K, gain ? gain + 64 * kb : nullptr, scl, scr, lane);
}
__device__ __forceinline__ void conv_plain(const float* W, int K, int N, int sub, bf16* WT, int drow0, const float* gain, LAS float* scr, int lane) {
    const int nblk = N / 32, kb = sub / nblk, nb = sub % nblk;
    transpose_tile(W + (size_t)(64 * kb) * N + 32 * nb, N, WT + (size_t)(drow0 + 32 * nb) * K + 64 * kb, K, gain ? gain + 64 * kb : nullptr, scr, lane);
}
__device__ __forceinline__ void conv_gu(const float* W, int K, int N, int sub, bf16* WT, int up, const float* gain, LAS float* scr, int lane) {
    const int nblk = N / 32, kb = sub / nblk, nb = sub % nblk, n0 = 32 * nb, drow = (n0 >> 7) * 256 + (n0 & 127) + up * 128;
    transpose_tile(W + (size_t)(64 * kb) * N + n0, N, WT + (size_t)drow * K + 64 * kb, K, gain ? gain + 64 * kb : nullptr, scr, lane);
}

struct ConvItem { const float* src; const float* gk; unsigned char* dst; int N, K; float scl; int f8; };
__device__ __forceinline__ void conv_load(const ConvItem& d, float (&v)[64], int lane) {
#pragma unroll
    for (int i = 0; i < 64; ++i) v[i] = d.src[(size_t)i * d.N + lane];
}
__device__ __forceinline__ void conv_finish(const ConvItem& d, float (&v)[64], int lane) {
    if (d.gk) {
#pragma unroll
        for (int i = 0; i < 64; ++i) v[i] *= d.gk[i] * d.scl;
    } else {
#pragma unroll
        for (int i = 0; i < 64; ++i) v[i] *= d.scl;
    }
    if (d.f8) { GAS v4u* o = (GAS v4u*)(d.dst + (size_t)lane * d.K);
#pragma unroll
        for (int c = 0; c < 4; ++c) { v4u w; w.x = pg8::pk4_fp8(v[16 * c], v[16 * c + 1], v[16 * c + 2], v[16 * c + 3]); w.y = pg8::pk4_fp8(v[16 * c + 4], v[16 * c + 5], v[16 * c + 6], v[16 * c + 7]);
            w.z = pg8::pk4_fp8(v[16 * c + 8], v[16 * c + 9], v[16 * c + 10], v[16 * c + 11]); w.w = pg8::pk4_fp8(v[16 * c + 12], v[16 * c + 13], v[16 * c + 14], v[16 * c + 15]); o[c] = w; } }
    else { GAS v4u* o = (GAS v4u*)(d.dst + (size_t)lane * d.K * 2);
#pragma unroll
        for (int c = 0; c < 8; ++c) { v4u w; w.x = pg8::cvt_pk_bf16(v[8 * c], v[8 * c + 1]); w.y = pg8::cvt_pk_bf16(v[8 * c + 2], v[8 * c + 3]); w.z = pg8::cvt_pk_bf16(v[8 * c + 4], v[8 * c + 5]); w.w = pg8::cvt_pk_bf16(v[8 * c + 6], v[8 * c + 7]); o[c] = w; } }
}
constexpr int N_CONV_ITEMS = 26192;
__device__ __forceinline__ ConvItem conv_decode(const KArgs& args, int it) {
    unsigned char* ws = args.ws();
    const float* W; const float* gain = nullptr; unsigned char* WT; int K, N, sub, drow0 = 0, gu = -1, f8 = 0; float scl = 1.0f; int r = it;
    if (r < 1024) { const int l = r >> 9; sub = r & 511; W = args.in[4] + (size_t)l * 1024 * 2048; K = 1024; N = 2048; WT = ws + WS_WIN + (size_t)l * 2048 * 1024 * 2; gain = args.in[3] + l * 1024; }
    else if ((r -= 1024) < 512) { const int l = r >> 8; sub = r & 255; W = args.in[15] + (size_t)l * 1024 * 1024; K = 1024; N = 1024; WT = ws + WS_WOUT + (size_t)l * 1024 * 1024 * 2; }
    else if ((r -= 512) < 256) { const int l = r >> 7; sub = r & 127; W = args.in[18] + (size_t)l * 1024 * 512; K = 1024; N = 512; WT = ws + WS_WXQ + (size_t)l * 512 * 1024; gain = args.in[16] + l * 1024; f8 = 1; scl = W8_SCALE; }
    else if ((r -= 256) < 256) { const int l = r >> 7; sub = r & 127; W = args.in[19] + (size_t)l * 1024 * 512; K = 1024; N = 512; WT = ws + WS_WKV + (size_t)l * 1024 * 1024 * 2; gain = args.in[17] + l * 1024; }
    else if ((r -= 256) < 256) { const int l = r >> 7; sub = r & 127; W = args.in[20] + (size_t)l * 1024 * 512; K = 1024; N = 512; WT = ws + WS_WKV + (size_t)l * 1024 * 1024 * 2; gain = args.in[17] + l * 1024; drow0 = 512; }
    else if ((r -= 256) < 256) { const int l = r >> 7; sub = r & 127; W = args.in[21] + (size_t)l * 512 * 1024; K = 512; N = 1024; WT = ws + WS_WXO + (size_t)l * 1024 * 512; f8 = 1; scl = W8_SCALE; }
    else if ((r -= 256) < 704) { sub = r; W = args.in[23]; K = 1024; N = FFD; WT = ws + WS_WDGU; gain = args.in[22]; gu = 0; }
    else if ((r -= 704) < 704) { sub = r; W = args.in[24]; K = 1024; N = FFD; WT = ws + WS_WDGU; gain = args.in[22]; gu = 1; }
    else if ((r -= 704) < 704) { sub = r; W = args.in[25]; K = FFD; N = 1024; WT = ws + WS_WDD; }
    else if ((r -= 704) < 7168) { const int e = r / 896; sub = r % 896; W = args.in[27] + (size_t)e * 1024 * FFE; K = 1024; N = FFE; WT = ws + WS_WMGU + (size_t)e * 2 * FFE * 1024; gain = args.in[22] + 1024; gu = 0; f8 = 1; scl = W8_SCALE; }
    else if ((r -= 7168) < 7168) { const int e = r / 896; sub = r % 896; W = args.in[28] + (size_t)e * 1024 * FFE; K = 1024; N = FFE; WT = ws + WS_WMGU + (size_t)e * 2 * FFE * 1024; gain = args.in[22] + 1024; gu = 1; f8 = 1; scl = W8_SCALE; }
    else if ((r -= 7168) < 7168) { const int e = r / 896; sub = r % 896; W = args.in[29] + (size_t)e * FFE * 1024; K = FFE; N = 1024; WT = ws + WS_WMD + (size_t)e * 1024 * FFE; f8 = 1; scl = W8_SCALE; }
    else { r -= 7168; const int q = r, l = q >> 3, mat = (q >> 2) & 1, hh = q & 3; sub = 0; W = args.in[mat ? 12 : 10] + (size_t)(l * 4 + hh) * 4096; K = 64; N = 64; WT = ws + WS_RGW + (size_t)q * 4096 * 2; }
    const int nkb = K / 64, kb = sub % nkb, nb = sub / nkb, n0 = 64 * nb;
    const int drow = (gu < 0) ? drow0 + n0 : (n0 >> 7) * 256 + (n0 & 127) + gu * 128;
    ConvItem d; d.src = W + (size_t)(64 * kb) * N + n0; d.gk = gain ? gain + 64 * kb : nullptr; d.dst = WT + ((size_t)drow * K + 64 * kb) * (f8 ? 1 : 2); d.N = N; d.K = K; d.scl = scl; d.f8 = f8;
    return d;
}


typedef short bf16x8v __attribute__((ext_vector_type(8)));
typedef float f32x16 __attribute__((ext_vector_type(16)));
constexpr float LOG2E = 1.4426950408889634f;
__device__ __forceinline__ bf16x8v pack8(const f32x16& p, int b) {
    v4u w; w.x = pg8::cvt_pk_bf16(p[b + 0], p[b + 1]); w.y = pg8::cvt_pk_bf16(p[b + 2], p[b + 3]); w.z = pg8::cvt_pk_bf16(p[b + 4], p[b + 5]); w.w = pg8::cvt_pk_bf16(p[b + 6], p[b + 7]);
    return __builtin_bit_cast(bf16x8v, w);
}
__device__ __forceinline__ void xa_unit_mfma(const KArgs& args, LAS unsigned char* lds, int l, int unit, int tid) {
    asm volatile("" : "+v"(tid));
    const int lane = tid & 63, wave = __builtin_amdgcn_readfirstlane(tid >> 6), r32 = lane & 31, hi = lane >> 5;
    const int b = unit >> 5, hh = (unit >> 3) & 3, tc = unit & 7;
    const bf16* kv = (const bf16*)(args.ws() + WS_KVMEM) + (size_t)(b * 256) * 2048 + l * 1024 + hh * 128;
    const bf16* qxa = (const bf16*)(args.ws() + WS_QXA); unsigned char* xo = (unsigned char*)(args.ws() + WS_XO);
    v4u kq[8], vq[8];
#pragma unroll
    for (int i = 0; i < 8; ++i) { const int piece = tid + 512 * i, r = piece >> 4, c = piece & 15; kq[i] = *(const v4u*)(kv + (size_t)r * 2048 + c * 8); }
#pragma unroll
    for (int i = 0; i < 8; ++i) { const int piece = tid + 512 * i, key = piece & 255, dc = piece >> 8; vq[i] = *(const v4u*)(kv + (size_t)key * 2048 + 512 + dc * 8); }
    asm volatile("" : "+v"(vq[0]), "+v"(vq[1]), "+v"(vq[2]), "+v"(vq[3]), "+v"(vq[4]), "+v"(vq[5]), "+v"(vq[6]), "+v"(vq[7]));
#pragma unroll
    for (int i = 0; i < 8; ++i) { const int piece = tid + 512 * i, r = piece >> 4, c = piece & 15;
        *(LAS v4u*)(lds + r * 256 + ((c ^ (r & 15)) << 4)) = kq[i]; }
#pragma unroll
    for (int i = 0; i < 8; ++i) { const int piece = tid + 512 * i, key = piece & 255, dc = piece >> 8;
        const v4u v = vq[i]; const unsigned w[4] = {v.x, v.y, v.z, v.w};
#pragma unroll
        for (int j = 0; j < 8; ++j) { const int d = dc * 8 + j; const unsigned short val = (unsigned short)((j & 1) ? (w[j >> 1] >> 16) : (w[j >> 1] & 0xffffu));
            *(LAS unsigned short*)(lds + 65536 + d * 512 + (((key >> 2) ^ (d & 31)) << 3) + (key & 3) * 2) = val; } }
    __syncthreads();
    const float sc = 0.08838834764831845f * LOG2E;
    int kb[8], vb[8];
#pragma unroll
    for (int ks = 0; ks < 8; ++ks) kb[ks] = r32 * 256 + (((2 * ks + hi) ^ (r32 & 15)) << 4);
#pragma unroll
    for (int c = 0; c < 8; ++c) vb[c] = 65536 + r32 * 512 + ((((c >> 1) * 8 + (c & 1) * 4 + hi) ^ r32) << 3);
#pragma unroll 1
    for (int qb = 0; qb < 2; ++qb) {
        const size_t tok = (size_t)b * SEQ + tc * 512 + wave * 64 + qb * 32 + r32;
        const bf16* qp = qxa + tok * 512 + hh * 128 + hi * 8;
        f32x16 o[4];
#pragma unroll
        for (int db = 0; db < 4; ++db)
#pragma unroll
            for (int r = 0; r < 16; ++r) o[db][r] = 0.f;
        float mrun = 0.f, sum = 0.f;
#pragma unroll
        for (int pass = 0; pass < 4; ++pass) {
            asm volatile("" ::: "memory");
            bf16x8v qf[8];
#pragma unroll
            for (int ks = 0; ks < 8; ++ks) qf[ks] = *(const bf16x8v*)(qp + ks * 16);
            f32x16 s[2];
#pragma unroll
            for (int k2 = 0; k2 < 2; ++k2) { const int kt = 2 * pass + k2;
#pragma unroll
                for (int r = 0; r < 16; ++r) s[k2][r] = 0.f;
#pragma unroll
                for (int ks = 0; ks < 8; ++ks) { const bf16x8v kf = *(const LAS bf16x8v*)(lds + kb[ks] + kt * 8192); s[k2] = __builtin_amdgcn_mfma_f32_32x32x16_bf16(kf, qf[ks], s[k2], 0, 0, 0); }
            }
            float mx = -3.0e38f;
#pragma unroll
            for (int k2 = 0; k2 < 2; ++k2)
#pragma unroll
                for (int r = 0; r < 16; ++r) mx = fmaxf(mx, s[k2][r]);
            mx = pg8::xor32_max(mx);
            if (pass > 0) {
                if (__any((mx - mrun) * sc > 8.0f)) {
                    const float mn = fmaxf(mrun, mx); const float f = __builtin_amdgcn_exp2f((mrun - mn) * sc); mx = mn; sum *= f;
#pragma unroll
                    for (int db = 0; db < 4; ++db)
#pragma unroll
                        for (int r = 0; r < 16; ++r) o[db][r] *= f;
                } else mx = mrun; }
            mrun = mx;
            const float mb = mx * sc;
            bf16x8v pf[4];
#pragma unroll
            for (int k2 = 0; k2 < 2; ++k2) {
#pragma unroll
                for (int r = 0; r < 16; ++r) { const float p = __builtin_amdgcn_exp2f(s[k2][r] * sc - mb); s[k2][r] = p; sum += p; }
                pf[2 * k2] = pack8(s[k2], 0); pf[2 * k2 + 1] = pack8(s[k2], 8);
            }
#pragma unroll
            for (int k2 = 0; k2 < 2; ++k2)
#pragma unroll
                for (int s2 = 0; s2 < 2; ++s2) {
#pragma unroll
                    for (int db = 0; db < 4; ++db) { const int kt = 2 * pass + k2, c = (kt & 3) * 2 + s2, off = (kt >> 2) * 256 + db * 16384;
                        const v2u lo = *(const LAS v2u*)(lds + vb[c] + off), hi2 = *(const LAS v2u*)(lds + (vb[c] ^ 16) + off);
                        v4u vv; vv.x = lo.x; vv.y = lo.y; vv.z = hi2.x; vv.w = hi2.y;
                        o[db] = __builtin_amdgcn_mfma_f32_32x32x16_bf16(__builtin_bit_cast(bf16x8v, vv), pf[2 * k2 + s2], o[db], 0, 0, 0); } }
        }
        sum = pg8::xor32_sum(sum);
        const float inv = 1.0f / sum; unsigned char* op = xo + tok * 512 + hh * 128 + 16 * hi;
#pragma unroll
        for (int db = 0; db < 4; ++db) {
            unsigned w[4];
#pragma unroll
            for (int g = 0; g < 4; ++g) w[g] = pg8::pk4_fp8(o[db][4 * g] * inv, o[db][4 * g + 1] * inv, o[db][4 * g + 2] * inv, o[db][4 * g + 3] * inv);
            pg8::plswap32(w[0], w[1]); pg8::plswap32(w[2], w[3]);
            pg8::plswap32(w[0], w[2]); pg8::plswap32(w[1], w[3]);
            *(v4u*)(op + db * 32) = (v4u){w[0], w[1], w[2], w[3]}; }
    }
    __syncthreads();
}
__device__ __forceinline__ void swa_unit_mfma(const KArgs& args, LAS unsigned char* lds, int tb_off, int l, int unit, int tid) {
    asm volatile("" : "+v"(tid));
    const int lane = tid & 63, wave = __builtin_amdgcn_readfirstlane(tid >> 6), r32 = lane & 31, hi = lane >> 5;
    const int b = unit >> 5, n = unit & 31; const size_t row0 = (size_t)b * SEQ + (size_t)n * 128;
    const bf16* proj = (const bf16*)(args.ws() + WS_PROJ); bf16* mixed = (bf16*)(args.ws() + WS_MIXED);
    v4u kq[8], vq[8];
#pragma unroll
    for (int i = 0; i < 8; ++i) { const int piece = tid + 512 * i, c = piece & 7, key = (piece >> 3) & 255, kvh = piece >> 11; const bool ok = n > 0 || key >= 128;
        kq[i] = *(const v4u*)(proj + (ok ? row0 - 128 + key : row0) * INCOLS + 512 + kvh * 64 + c * 8); }
#pragma unroll
    for (int i = 0; i < 8; ++i) { const int piece = tid + 512 * i, key = piece & 255, dc = (piece >> 8) & 7, kvh = piece >> 11; const bool ok = n > 0 || key >= 128;
        vq[i] = *(const v4u*)(proj + (ok ? row0 - 128 + key : row0) * INCOLS + 640 + kvh * 64 + dc * 8); }
#pragma unroll
    for (int i = 0; i < 8; ++i) { const int piece = tid + 512 * i, c = piece & 7, key = (piece >> 3) & 255, kvh = piece >> 11;
        v4u v = kq[i]; if (!(n > 0 || key >= 128)) v = (v4u){0u, 0u, 0u, 0u};
        *(LAS v4u*)(lds + kvh * 32768 + key * 128 + ((c ^ ((key >> 1) & 7)) << 4)) = v; }
#pragma unroll
    for (int i = 0; i < 8; ++i) { const int piece = tid + 512 * i, key = piece & 255, dc = (piece >> 8) & 7, kvh = piece >> 11;
        v4u v = vq[i]; if (!(n > 0 || key >= 128)) v = (v4u){0u, 0u, 0u, 0u};
        const unsigned w[4] = {v.x, v.y, v.z, v.w};
#pragma unroll
        for (int j = 0; j < 8; ++j) { const int d = dc * 8 + j; const unsigned short val = (unsigned short)((j & 1) ? (w[j >> 1] >> 16) : (w[j >> 1] & 0xffffu));
            *(LAS unsigned short*)(lds + 65536 + kvh * 32768 + d * 512 + (((key >> 2) ^ (d & 31)) << 3) + (key & 3) * 2) = val; } }
    __syncthreads();
    const int kvh = wave >> 2, hq = wave;
    const float sink2 = args.in[5][l * 8 + hq] * LOG2E;
    const LAS float* T = (const LAS float*)(lds + tb_off) + hq * 192 + (r32 + 160 - 4 * hi);
    const float sc = 0.125f * LOG2E;
    bf16x8v qf[4];
    { const bf16* qp = proj + (row0 + r32) * INCOLS + hq * 64 + hi * 8;
#pragma unroll
      for (int ks = 0; ks < 4; ++ks) qf[ks] = *(const bf16x8v*)(qp + ks * 16); }
#pragma unroll
    for (int j = 0; j < 4; ++j) {
        const size_t tok = row0 + j * 32 + r32;
        f32x16 s[5];
#pragma unroll
        for (int tt = 0; tt < 5; ++tt) {
            const int key = (j + tt) * 32 + r32; const LAS unsigned char* kp = lds + kvh * 32768 + key * 128;
#pragma unroll
            for (int r = 0; r < 16; ++r) s[tt][r] = 0.f;
#pragma unroll
            for (int ks = 0; ks < 4; ++ks) { const bf16x8v kf = *(const LAS bf16x8v*)(kp + (((2 * ks + hi) ^ ((key >> 1) & 7)) << 4)); s[tt] = __builtin_amdgcn_mfma_f32_32x32x16_bf16(kf, qf[ks], s[tt], 0, 0, 0); }
        }
        if (j < 3) { const bf16* qp = proj + (tok + 32) * INCOLS + hq * 64 + hi * 8;
#pragma unroll
            for (int ks = 0; ks < 4; ++ks) qf[ks] = *(const bf16x8v*)(qp + ks * 16); }
        float mx = sink2;
#pragma unroll
        for (int tt = 0; tt < 5; ++tt) { const bool dead = (n == 0) && (j + tt < 4);
#pragma unroll
            for (int r = 0; r < 16; ++r) { float v = s[tt][r] * sc + T[-(32 * tt + (r & 3) + 8 * (r >> 2))]; v = dead ? -1.0e30f : v; s[tt][r] = v; mx = fmaxf(mx, v); } }
        mx = pg8::xor32_max(mx);
        float sum = 0.f;
#pragma unroll
        for (int tt = 0; tt < 5; ++tt)
#pragma unroll
            for (int r = 0; r < 16; ++r) { const float p = __builtin_amdgcn_exp2f(s[tt][r] - mx); s[tt][r] = p; sum += p; }
        sum = pg8::xor32_sum(sum);
        sum += __builtin_amdgcn_exp2f(sink2 - mx);
        f32x16 o[2];
#pragma unroll
        for (int db = 0; db < 2; ++db)
#pragma unroll
            for (int r = 0; r < 16; ++r) o[db][r] = 0.f;
#pragma unroll
        for (int tt = 0; tt < 5; ++tt)
#pragma unroll
            for (int s2 = 0; s2 < 2; ++s2) { const bf16x8v pf = pack8(s[tt], 8 * s2); const int q0 = 8 * (j + tt) + 4 * s2 + hi;
#pragma unroll
                for (int db = 0; db < 2; ++db) { const LAS unsigned char* vp = lds + 65536 + kvh * 32768 + (db * 32 + r32) * 512;
                    const v2u lo = *(const LAS v2u*)(vp + ((q0 ^ r32) << 3)), hi2 = *(const LAS v2u*)(vp + (((q0 + 2) ^ r32) << 3));
                    v4u vv; vv.x = lo.x; vv.y = lo.y; vv.z = hi2.x; vv.w = hi2.y;
                    o[db] = __builtin_amdgcn_mfma_f32_32x32x16_bf16(__builtin_bit_cast(bf16x8v, vv), pf, o[db], 0, 0, 0); } }
        const float inv = 1.0f / sum; bf16* op = mixed + tok * D + hq * 64 + 8 * hi;
#pragma unroll
        for (int db = 0; db < 2; ++db)
#pragma unroll
            for (int g = 0; g < 4; g += 2) { unsigned a0 = pg8::cvt_pk_bf16(o[db][4 * g] * inv, o[db][4 * g + 1] * inv), a1 = pg8::cvt_pk_bf16(o[db][4 * g + 2] * inv, o[db][4 * g + 3] * inv);
                unsigned b0 = pg8::cvt_pk_bf16(o[db][4 * g + 4] * inv, o[db][4 * g + 5] * inv), b1 = pg8::cvt_pk_bf16(o[db][4 * g + 6] * inv, o[db][4 * g + 7] * inv);
                pg8::plswap32(a0, b0); pg8::plswap32(a1, b1);
                *(v4u*)(op + db * 32 + 8 * g) = (v4u){a0, a1, b0, b1}; }
    }
    __syncthreads();
}

__device__ __forceinline__ int rg_sw(int t) { return ((t >> 4) & 1) * 8 + (t & 7); }
__device__ __forceinline__ void rg_conv_to_lds(const KArgs& args, LAS unsigned char* lds, int l, int unit, int tid) {
    const int b = unit >> 5, n = unit & 31, ch = tid & 31, c0 = ch * 8; const size_t row0 = (size_t)b * SEQ + (size_t)n * 128;
    const bf16* proj = (const bf16*)(args.ws() + WS_PROJ);
    float cw[4][8], cb[8];
    { const float* w = args.in[8] + (size_t)l * 4 * 256 + c0; const float* bb = args.in[9] + l * 256 + c0;
#pragma unroll
      for (int k = 0; k < 4; ++k) { const f32x4 a = *(const f32x4*)(w + k * 256), c = *(const f32x4*)(w + k * 256 + 4); cw[k][0] = a[0]; cw[k][1] = a[1]; cw[k][2] = a[2]; cw[k][3] = a[3]; cw[k][4] = c[0]; cw[k][5] = c[1]; cw[k][6] = c[2]; cw[k][7] = c[3]; }
      const f32x4 a = *(const f32x4*)bb, c = *(const f32x4*)(bb + 4); cb[0] = a[0]; cb[1] = a[1]; cb[2] = a[2]; cb[3] = a[3]; cb[4] = c[0]; cb[5] = c[1]; cb[6] = c[2]; cb[7] = c[3]; }
    const int t0 = (tid >> 5) * 8;
    v4u xr[11];
#pragma unroll
    for (int r = 0; r < 11; ++r) { const int tt = t0 - 3 + r; xr[r] = (v4u){0u, 0u, 0u, 0u}; if (n > 0 || tt >= 0) xr[r] = *(const v4u*)(proj + (row0 + tt) * INCOLS + 1536 + c0); }
#pragma unroll
    for (int i = 0; i < 8; ++i) {
        const int t = t0 + i;
        float acc[8];
#pragma unroll
        for (int j = 0; j < 8; ++j) acc[j] = cb[j];
#pragma unroll
        for (int k = 0; k < 4; ++k) { const v4u v = xr[i + k];
            acc[0] += cw[k][0] * bflo(v.x); acc[1] += cw[k][1] * bfhi(v.x); acc[2] += cw[k][2] * bflo(v.y); acc[3] += cw[k][3] * bfhi(v.y);
            acc[4] += cw[k][4] * bflo(v.z); acc[5] += cw[k][5] * bfhi(v.z); acc[6] += cw[k][6] * bflo(v.w); acc[7] += cw[k][7] * bfhi(v.w); }
        v4u o; o.x = pg8::cvt_pk_bf16(acc[0], acc[1]); o.y = pg8::cvt_pk_bf16(acc[2], acc[3]); o.z = pg8::cvt_pk_bf16(acc[4], acc[5]); o.w = pg8::cvt_pk_bf16(acc[6], acc[7]);
        *(LAS v4u*)(lds + t * 512 + ((ch ^ rg_sw(t & 31)) << 4)) = o;
    }
}
template <int PASS> __device__ __forceinline__ void rg_scan_mfma(const KArgs& args, LAS unsigned char* lds, int l, int unit, int tid) {
    const int lane = tid & 63, wave = __builtin_amdgcn_readfirstlane(tid >> 6), r32 = lane & 31, hi = lane >> 5;
    const int hh = wave >> 1, nb = wave & 1, c = hh * 64 + nb * 32 + r32, b = unit >> 5, n = unit & 31; const size_t row0 = (size_t)b * SEQ + (size_t)n * 128;
    const bf16* rgw = (const bf16*)(args.ws() + WS_RGW) + (size_t)(l * 2) * 4 * 4096 + (size_t)hh * 4096 + (size_t)(nb * 32 + r32) * 64 + hi * 8;
    bf16x8v waf[4], wxf[4];
#pragma unroll
    for (int ks = 0; ks < 4; ++ks) { waf[ks] = *(const bf16x8v*)(rgw + ks * 16); wxf[ks] = *(const bf16x8v*)(rgw + 4 * 4096 + ks * 16); }
    const float ba = args.in[11][l * 256 + c], bx = args.in[13][l * 256 + c], lam = args.in[14][l * 256 + c];
    const float c8 = -8.0f * log1pf(expf(-lam)) * LOG2E;
    float* rgsum = (float*)(args.ws() + WS_RGSUM);
    float carry = 0.f, Atot = 1.f;
    if (PASS == 2) { for (int j = 0; j < n; ++j) { const float aj = rgsum[(size_t)(b * 32 + j) * 512 + c], hj = rgsum[(size_t)(b * 32 + j) * 512 + 256 + c]; carry = aj * carry + hj; } }
    const int atok = 16 * ((r32 >> 2) & 1) + (r32 & 3) + 4 * (r32 >> 3);
    const bf16* proj = (const bf16*)(args.ws() + WS_PROJ); bf16* mixed = (bf16*)(args.ws() + WS_MIXED);
#pragma unroll 1
    for (int sc = 0; sc < 4; ++sc) {
        f32x16 rp, ip;
        unsigned short gq[16];
        if (PASS == 2) {
#pragma unroll
            for (int r = 0; r < 16; ++r) gq[r] = proj[(row0 + sc * 32 + 16 * hi + r) * INCOLS + 1792 + c]; }
#pragma unroll
        for (int r = 0; r < 16; ++r) { rp[r] = 0.f; ip[r] = 0.f; }
        { const int t = sc * 32 + atok; const LAS unsigned char* ap = lds + t * 512; const int sw = rg_sw(atok);
#pragma unroll
          for (int ks = 0; ks < 4; ++ks) { const bf16x8v af = *(const LAS bf16x8v*)(ap + (((8 * hh + 2 * ks + hi) ^ sw) << 4));
              rp = __builtin_amdgcn_mfma_f32_32x32x16_bf16(af, waf[ks], rp, 0, 0, 0); ip = __builtin_amdgcn_mfma_f32_32x32x16_bf16(af, wxf[ks], ip, 0, 0, 0); } }
        float hl[16], ac[16]; float hrun = 0.f, arun = 1.f;
#pragma unroll
        for (int r = 0; r < 16; ++r) { const int tl = 16 * hi + r, t = sc * 32 + tl;
            const float xin = bf2f(*(const LAS unsigned short*)(lds + t * 512 + ((((c >> 3)) ^ rg_sw(tl)) << 4) + (c & 7) * 2));
            const float rg = sigmoid_f(rp[r] + ba), ig = sigmoid_f(ip[r] + bx);
            const float a = __builtin_amdgcn_exp2f(c8 * rg);
            const float u = sqrtf(fmaxf(1.0f - a * a, 0.f)) * (ig * xin);
            hrun = a * hrun + u; arun *= a; hl[r] = hrun; ac[r] = arun; }
        const float a_o = pg8::xor32_other(arun, hi), h_o = pg8::xor32_other(hrun, hi);
        const float hin = hi ? (a_o * carry + h_o) : carry;
        const float hend = hl[15] + ac[15] * hin;
        const float hend_hi = __shfl(hend, r32 + 32);
        if (PASS == 1) {
            const float Ag = hi ? Atot * a_o : Atot;
            unsigned* rgc = (unsigned*)(args.ws() + WS_RGC) + (row0 + sc * 32 + 16 * hi) * 256 + c;
#pragma unroll
            for (int r = 0; r < 16; ++r) rgc[r * 256] = pg8::cvt_pk_bf16(hl[r] + ac[r] * hin, ac[r] * Ag);
            Atot *= arun * a_o; }
        if (PASS == 2) {
#pragma unroll
            for (int r = 0; r < 16; ++r) { const size_t row = row0 + sc * 32 + 16 * hi + r; const float h = hl[r] + ac[r] * hin;
                const float g = bf2f(gq[r]); mixed[row * D + 768 + c] = (bf16)f2bf(h * gelu_tanh(g)); } }
        carry = hend_hi;
    }
    if (PASS == 1 && hi == 0) { rgsum[(size_t)unit * 512 + c] = Atot; rgsum[(size_t)unit * 512 + 256 + c] = carry; }
}
__device__ __forceinline__ void sc_conv_vec(const KArgs& args, int l, int unit, int tid) {
    const int b = unit >> 5, n = unit & 31, c0 = (tid & 31) * 8; const size_t row0 = (size_t)b * SEQ + (size_t)n * 128;
    const bf16* proj = (const bf16*)(args.ws() + WS_PROJ); bf16* mixed = (bf16*)(args.ws() + WS_MIXED);
    float cw[3][8], cb[8];
    { const float* w = args.in[6] + (size_t)l * 3 * 256 + c0; const float* bb = args.in[7] + l * 256 + c0;
#pragma unroll
      for (int k = 0; k < 3; ++k) { const f32x4 a = *(const f32x4*)(w + k * 256), c = *(const f32x4*)(w + k * 256 + 4); cw[k][0] = a[0]; cw[k][1] = a[1]; cw[k][2] = a[2]; cw[k][3] = a[3]; cw[k][4] = c[0]; cw[k][5] = c[1]; cw[k][6] = c[2]; cw[k][7] = c[3]; }
      const f32x4 a = *(const f32x4*)bb, c = *(const f32x4*)(bb + 4); cb[0] = a[0]; cb[1] = a[1]; cb[2] = a[2]; cb[3] = a[3]; cb[4] = c[0]; cb[5] = c[1]; cb[6] = c[2]; cb[7] = c[3]; }
    const int t0 = (tid >> 5) * 8;
    v4u cr[10], xr[10], br[8];
#pragma unroll
    for (int r = 0; r < 10; ++r) { const int tt = t0 - 2 + r; cr[r] = (v4u){0u, 0u, 0u, 0u}; xr[r] = cr[r];
        if (n > 0 || tt >= 0) { const bf16* p = proj + (row0 + tt) * INCOLS + 1024 + c0; cr[r] = *(const v4u*)p; xr[r] = *(const v4u*)(p + 256); } }
#pragma unroll
    for (int i = 0; i < 8; ++i) br[i] = *(const v4u*)(proj + (row0 + t0 + i) * INCOLS + 768 + c0);
    float u[10][8];
#pragma unroll
    for (int r = 0; r < 10; ++r) { u[r][0] = bflo(cr[r].x) * bflo(xr[r].x); u[r][1] = bfhi(cr[r].x) * bfhi(xr[r].x); u[r][2] = bflo(cr[r].y) * bflo(xr[r].y); u[r][3] = bfhi(cr[r].y) * bfhi(xr[r].y);
        u[r][4] = bflo(cr[r].z) * bflo(xr[r].z); u[r][5] = bfhi(cr[r].z) * bfhi(xr[r].z); u[r][6] = bflo(cr[r].w) * bflo(xr[r].w); u[r][7] = bfhi(cr[r].w) * bfhi(xr[r].w); }
#pragma unroll
    for (int i = 0; i < 8; ++i) {
        float acc[8];
#pragma unroll
        for (int j = 0; j < 8; ++j) acc[j] = cb[j] + cw[0][j] * u[i][j] + cw[1][j] * u[i + 1][j] + cw[2][j] * u[i + 2][j];
        const v4u vb = br[i];
        v4u o; o.x = pg8::cvt_pk_bf16(acc[0] * bflo(vb.x), acc[1] * bfhi(vb.x)); o.y = pg8::cvt_pk_bf16(acc[2] * bflo(vb.y), acc[3] * bfhi(vb.y));
        o.z = pg8::cvt_pk_bf16(acc[4] * bflo(vb.z), acc[5] * bfhi(vb.z)); o.w = pg8::cvt_pk_bf16(acc[6] * bflo(vb.w), acc[7] * bfhi(vb.w));
        *(v4u*)(mixed + (row0 + t0 + i) * D + 512 + c0) = o;
    }
}
__device__ __forceinline__ void rg_out_vec(const KArgs& args, LAS unsigned char* lds, int l, int unit, int tid) {
    (void)l;
    const int b = unit >> 5, n = unit & 31, c0 = (tid & 31) * 8, t0 = (tid >> 5) * 8; const size_t row0 = (size_t)b * SEQ + (size_t)n * 128;
    const bf16* proj = (const bf16*)(args.ws() + WS_PROJ); bf16* mixed = (bf16*)(args.ws() + WS_MIXED); const unsigned* rgc = (const unsigned*)(args.ws() + WS_RGC);
    v4u q0[8], q1[8], gq[8];
#pragma unroll
    for (int i = 0; i < 8; ++i) { const size_t row = row0 + t0 + i; q0[i] = *(const v4u*)(rgc + row * 256 + c0); q1[i] = *(const v4u*)(rgc + row * 256 + c0 + 4); gq[i] = *(const v4u*)(proj + row * INCOLS + 1792 + c0); }
    float carry[8];
#pragma unroll
    for (int k = 0; k < 8; ++k) carry[k] = 0.f;
    { const f32x4* src = (const f32x4*)((const float*)(args.ws() + WS_RGSUM) + (size_t)(b * 32) * 512); LAS f32x4* dst = (LAS f32x4*)lds;
      f32x4 sv[8];
#pragma unroll
      for (int i = 0; i < 8; ++i) { const int idx = tid + 512 * i; sv[i] = (f32x4){0.f, 0.f, 0.f, 0.f}; if (idx < n * 128) sv[i] = src[idx]; }
#pragma unroll
      for (int i = 0; i < 8; ++i) { const int idx = tid + 512 * i; if (idx < n * 128) dst[idx] = sv[i]; } }
    __syncthreads();
    { const LAS float* sm = (const LAS float*)lds + c0;
#pragma unroll 4
      for (int j = 0; j < n; ++j) { const f32x4 a0 = *(const LAS f32x4*)(sm + j * 512), a1 = *(const LAS f32x4*)(sm + j * 512 + 4), h0 = *(const LAS f32x4*)(sm + j * 512 + 256), h1 = *(const LAS f32x4*)(sm + j * 512 + 260);
#pragma unroll
        for (int k = 0; k < 4; ++k) { carry[k] = a0[k] * carry[k] + h0[k]; carry[4 + k] = a1[k] * carry[4 + k] + h1[k]; } } }
    __syncthreads();
#pragma unroll
    for (int i = 0; i < 8; ++i) { const unsigned w[8] = {q0[i].x, q0[i].y, q0[i].z, q0[i].w, q1[i].x, q1[i].y, q1[i].z, q1[i].w}; const unsigned gw[4] = {gq[i].x, gq[i].y, gq[i].z, gq[i].w};
        float o[8];
#pragma unroll
        for (int k = 0; k < 8; ++k) { const float g = (k & 1) ? bfhi(gw[k >> 1]) : bflo(gw[k >> 1]); o[k] = (bflo(w[k]) + bfhi(w[k]) * carry[k]) * gelu_tanh(g); }
        v4u ov; ov.x = pg8::cvt_pk_bf16(o[0], o[1]); ov.y = pg8::cvt_pk_bf16(o[2], o[3]); ov.z = pg8::cvt_pk_bf16(o[4], o[5]); ov.w = pg8::cvt_pk_bf16(o[6], o[7]);
        *(v4u*)(mixed + (row0 + t0 + i) * D + 768 + c0) = ov; }
}

constexpr int NPHASES = 24;
__global__ void __launch_bounds__(NWAVES * 64, 2) hymba_fwd(Args kernarg_block) {
    KArgs args; int lo, hi; { const unsigned long long pp = ldkarg(33); lo = (int)(unsigned)pp; hi = (int)(unsigned)(pp >> 32); }
    extern __shared__ __attribute__((aligned(16))) unsigned char lds_raw[];
    LAS unsigned char* lds = (LAS unsigned char*)lds_raw;
    volatile LAS unsigned* MISC = (volatile LAS unsigned*)(lds + MISC_OFF);
    const int G = gridDim.x, bid = blockIdx.x;
#define ws (args.ws())
#define xres (args.out())
#define rowsq ((float*)(ws + WS_ROWSQ))
#define xb ((bf16*)(ws + WS_XB))
    gu32* ctl = (gu32*)(ws + WS_CTL);
    for (int u = threadIdx.x; u < (LDS_BYTES - LDSCTL_OFF) / 4; u += NWAVES * 64) ((LAS unsigned*)(lds + LDSCTL_OFF))[u] = 0u;
    __syncthreads();
#if MK_ONE_LAUNCH
    XcdBarrier bar = xcd_barrier_post((unsigned*)(ctl + CW_BAR), MISC + 8);
#define GRID_BAR() xcd_barrier(bar)
#else
    (void)MISC;
#define GRID_BAR() do { } while (0)
#endif
    int ph = 0;
#define PHASE_BEGIN if (lo <= ph && ph < hi) { int tid_p = threadIdx.x; asm volatile("" : "+v"(tid_p)); const int tid = tid_p, lane = tid & 63, wave = __builtin_amdgcn_readfirstlane(tid >> 6); (void)lane; (void)wave;
#define PHASE_END if (ph + 1 < hi) { GRID_BAR(); } else { VM_WAIT(); __syncthreads(); } } ++ph;

    PHASE_BEGIN
    {
        const int gw = bid * NWAVES + wave, NGW = G * NWAVES;
        if (gw < N_CONV_ITEMS) {
            ConvItem d0 = conv_decode(args, gw); float va[64]; conv_load(d0, va, lane);
#pragma unroll 1
            for (int it = gw; it < N_CONV_ITEMS; it += NGW) {
                const int itn = it + NGW; const bool hn = itn < N_CONV_ITEMS;
                ConvItem d1 = d0; float vb[64];
                if (hn) { d1 = conv_decode(args, itn); conv_load(d1, vb, lane); }
                conv_finish(d0, va, lane);
                if (hn) {
#pragma unroll
                    for (int i = 0; i < 64; ++i) va[i] = vb[i];
                    d0 = d1; }
            }
        }
        float* memsq = (float*)(ws + WS_MEMSQ); bf16* memb = (bf16*)(ws + WS_MEMB);
        for (int m0 = gw; m0 < M + MROWS; m0 += 2 * NGW) {
            f32x4 v[2][4]; bool ok[2]; int mm[2]; bool isx[2];
#pragma unroll
            for (int u = 0; u < 2; ++u) { const int m = m0 + u * NGW; ok[u] = m < M + MROWS; isx[u] = m < M; mm[u] = isx[u] ? m : m - M;
                if (ok[u]) { const GAS f32x4* src = (const GAS f32x4*)((isx[u] ? args.in[0] : args.in[1]) + (size_t)mm[u] * D) + lane;
#pragma unroll
                    for (int j = 0; j < 4; ++j) v[u][j] = src[64 * j]; } }
#pragma unroll
            for (int u = 0; u < 2; ++u) if (ok[u]) { float s = 0.f;
#pragma unroll
                for (int j = 0; j < 4; ++j) s += (v[u][j].x * v[u][j].x + v[u][j].y * v[u][j].y) + (v[u][j].z * v[u][j].z + v[u][j].w * v[u][j].w);
                s = wave_sum(s);
                if (lane == 0) { *(f32x4*)((isx[u] ? rowsq : memsq) + (size_t)mm[u] * 4) = (f32x4){s, 0.f, 0.f, 0.f}; }
                GAS v2u* o8 = (GAS v2u*)((isx[u] ? xb : memb) + (size_t)mm[u] * D) + lane;
#pragma unroll
                for (int j = 0; j < 4; ++j) { v2u w; w.x = pg8::cvt_pk_bf16(v[u][j].x, v[u][j].y); w.y = pg8::cvt_pk_bf16(v[u][j].z, v[u][j].w); o8[64 * j] = w; } }
        }
    }
    PHASE_END

    {
        constexpr int l = 0;
        PHASE_BEGIN
        {
            pg8::Gemm g{xb, (const bf16*)(ws + WS_WIN) + (size_t)l * 2048 * 1024, M, INCOLS, 1024}; pg8::StaticOrder S; S.init(M, INCOLS, G, bid);
            pg8::EpiScaleBf16 E{(bf16*)(ws + WS_PROJ), INCOLS, rowsq + (size_t)(3 * l) * M * 4, 1.0f};
            pg8::gemm_phase<pg8::EpiScaleBf16, pg8::StaticOrder, true, true>(lds + RING_OFF, g, S, E);
        }
        PHASE_END
        PHASE_BEGIN
        {
            int u0 = bid, ustep = G;
            if (l == 0) {
                const int nkv = (G >= 128) ? 64 : G;
                if (bid < nkv) {
                    pg8::Gemm g{(const bf16*)(ws + WS_MEMB), (const bf16*)(ws + WS_WKV), MROWS, 2048, 1024}; pg8::StaticOrder S; S.init(MROWS, 2048, nkv, bid);
                    pg8::EpiScaleBf16 E{(bf16*)(ws + WS_KVMEM), 2048, (const float*)(ws + WS_MEMSQ), 1.0f};
                    pg8::gemm_phase<pg8::EpiScaleBf16, pg8::StaticOrder, true, true>(lds + RING_OFF, g, S, E);
                    __syncthreads();
                }
                if (G >= 128) { u0 = (bid < nkv) ? 256 : bid - nkv; ustep = G - nkv; }
            }
            for (int unit = u0; unit < 256; unit += ustep) {
                { int t0 = threadIdx.x; asm volatile("" : "+v"(t0)); rg_conv_to_lds(args, lds, l, unit, t0); }
                __syncthreads();
                { int t1 = threadIdx.x; asm volatile("" : "+v"(t1)); rg_scan_mfma<1>(args, lds, l, unit, t1); }
                __syncthreads();
            }
        }
        PHASE_END
        PHASE_BEGIN
        {
            constexpr int TB_OFF = LDSCTL_OFF + 6144;
            if (tid < 192) { const int dist = tid - 32; int bk = dist;
                if (dist >= 16) { const float v = logf((float)dist / 16.0f) / logf(8.0f) * 16.0f; bk = 16 + (int)v; if (bk > 31) bk = 31; }
                const bool ok = dist >= 0 && dist < 128;
                const float* bp = args.in[2] + (ok ? bk : 0) * 8; const f32x4 b0 = *(const f32x4*)bp, b1 = *(const f32x4*)(bp + 4);
                const float bv[8] = {b0[0], b0[1], b0[2], b0[3], b1[0], b1[1], b1[2], b1[3]};
#pragma unroll
                for (int h = 0; h < 8; ++h) ((LAS float*)(lds + TB_OFF))[h * 192 + tid] = ok ? bv[h] * LOG2E : -1.0e30f; }
            __syncthreads();
            for (int unit = bid; unit < 256; unit += G) {
                { int t1 = threadIdx.x; asm volatile("" : "+v"(t1)); rg_out_vec(args, lds, l, unit, t1); }
                { int t3 = threadIdx.x; asm volatile("" : "+v"(t3)); sc_conv_vec(args, l, unit, t3); }
                { int t2 = threadIdx.x; asm volatile("" : "+v"(t2)); swa_unit_mfma(args, lds, TB_OFF, l, unit, t2); }
            }
        }
        PHASE_END
        PHASE_BEGIN
        {
            pg8::Gemm g{(const bf16*)(ws + WS_MIXED), (const bf16*)(ws + WS_WOUT) + (size_t)l * 1024 * 1024, M, D, 1024}; pg8::StaticOrder S; S.init(M, D, G, bid);
            pg8::EpiResid E{xb, rowsq + (size_t)(3 * l + 1) * M * 4, (LAS float*)(lds + RED_OFF), (unsigned char*)(ws + WS_X8), 1.0f};
            pg8::gemm_phase<pg8::EpiResid, pg8::StaticOrder, true, true>(lds + RING_OFF, g, S, E);
        }
        PHASE_END
        PHASE_BEGIN
        {
            pg8::Gemm g{(const bf16*)(ws + WS_X8), (const bf16*)(ws + WS_WXQ + (size_t)l * 512 * 1024), M, 512, 1024}; pg8::StaticOrder S; S.init(M, 512, G, bid);
            pg8::EpiScaleBf16 E{(bf16*)(ws + WS_QXA), 512, rowsq + (size_t)(3 * l + 1) * M * 4, 1.0f / W8_SCALE};
            pg8::gemm_phase<pg8::EpiScaleBf16, pg8::StaticOrder, true, true, true>(lds + RING_OFF, g, S, E);
        }
        PHASE_END
        PHASE_BEGIN
        {
            for (int unit = bid; unit < 256; unit += G) xa_unit_mfma(args, lds, l, unit, tid);
        }
        PHASE_END
        PHASE_BEGIN
        {
            pg8::Gemm g{(const bf16*)(ws + WS_XO), (const bf16*)(ws + WS_WXO + (size_t)l * 1024 * 512), M, D, 512}; pg8::StaticOrder S; S.init(M, D, G, bid);
            pg8::EpiResid E{xb, rowsq + (size_t)(3 * l + 2) * M * 4, (LAS float*)(lds + RED_OFF), l == 1 ? (unsigned char*)(ws + WS_X8) : nullptr, 1.0f / W8_SCALE};
            pg8::gemm_phase<pg8::EpiResid, pg8::StaticOrder, true, true, true>(lds + RING_OFF, g, S, E);
        }
        PHASE_END
        if (l == 0) {
            PHASE_BEGIN
            {
                pg8::Gemm g{xb, (const bf16*)(ws + WS_WDGU), M, 2 * FFD, 1024}; pg8::StaticOrder S; S.init(M, 2 * FFD, G, bid);
                pg8::EpiSwiglu<false> E{(bf16*)(ws + WS_HD), FFD, rowsq + (size_t)2 * M * 4, 0, 2 * FFD / 256};
                pg8::gemm_phase<pg8::EpiSwiglu<false>, pg8::StaticOrder, true, true>(lds + RING_OFF, g, S, E);
            }
            PHASE_END
            PHASE_BEGIN
            {
                pg8::Gemm g{(const bf16*)(ws + WS_HD), (const bf16*)(ws + WS_WDD), M, D, FFD}; pg8::StaticOrder S; S.init(M, D, G, bid);
                pg8::EpiResid E{xb, rowsq + (size_t)3 * M * 4, (LAS float*)(lds + RED_OFF), nullptr, 1.0f};
                pg8::gemm_phase<pg8::EpiResid, pg8::StaticOrder, true, true>(lds + RING_OFF, g, S, E);
            }
            PHASE_END
        } else {
            int* tok_e = (int*)(ws + WS_TOKE); float* tok_w = (float*)(ws + WS_TOKW); int* tok_p = (int*)(ws + WS_TOKP); float* tok_r = (float*)(ws + WS_TOKR);
            int* slot_tok = (int*)(ws + WS_SLOTT); float* slot_gate = (float*)(ws + WS_SLOTG); float* slot_rstd = (float*)(ws + WS_SLOTR);
            int* tile_e = (int*)(ws + WS_TILEE); int* wgcnt = (int*)(ws + WS_WGCNT); int* wvbase = (int*)(ws + WS_WVCNT);
            PHASE_BEGIN
            {
                LAS unsigned char* Rt = lds;
                LAS float* Dl = (LAS float*)(lds + 32768);
                LAS int* wcnt = (LAS int*)(lds + 32768 + 8192);
                { const float* rp = args.in[26]; const float* gp = args.in[22] + 1024;
#pragma unroll
                  for (int i = 0; i < 16; ++i) { const int q = tid + i * NWAVES * 64, k = q >> 3, e = q & 7; const float v = rp[q] * gp[k];
                      const unsigned hb = f2bf(v); const unsigned lb = f2bf(v - __builtin_bit_cast(float, hb << 16));
                      *(LAS unsigned short*)(Rt + e * 2048 + (((k >> 3) ^ e) << 4) + (k & 7) * 2) = (unsigned short)hb;
                      *(LAS unsigned short*)(Rt + (8 + e) * 2048 + (((k >> 3) ^ (8 + e)) << 4) + (k & 7) * 2) = (unsigned short)lb; } }
                for (int tb = bid; tb < 256; tb += G) {
                    __syncthreads();
                    if (tid < 64) wcnt[tid] = 0;
                    __syncthreads();
                    if (wave < 4) {
                        const int r32 = lane & 31, hi = lane >> 5; const int t = tb * 128 + wave * 32 + r32;
                        const bf16* xp = xb + (size_t)t * D + hi * 8;
                        f32x16 acc;
#pragma unroll
                        for (int r = 0; r < 16; ++r) acc[r] = 0.f;
#pragma unroll 1
                        for (int ks0 = 0; ks0 < 64; ks0 += 8) {
                            bf16x8v a[8];
#pragma unroll
                            for (int j = 0; j < 8; ++j) a[j] = *(const bf16x8v*)(xp + (ks0 + j) * 16);
#pragma unroll
                            for (int j = 0; j < 8; ++j) { const int ks = ks0 + j; v4u bz = (v4u){0u, 0u, 0u, 0u};
                                if (r32 < 16) bz = *(const LAS v4u*)(Rt + r32 * 2048 + (((2 * ks + hi) ^ r32) << 4));
                                acc = __builtin_amdgcn_mfma_f32_32x32x16_bf16(a[j], __builtin_bit_cast(bf16x8v, bz), acc, 0, 0, 0); }
                        }
                        LAS float* dw = Dl + wave * 512;
                        if (r32 < 16) {
#pragma unroll
                            for (int r = 0; r < 16; ++r) dw[((r & 3) + 8 * (r >> 2) + 4 * hi) * 16 + r32] = acc[r]; }
                        LDS_WAIT();
                        int e1 = -1, e2 = -1; float w1 = 0.f, w2 = 0.f, rs = 0.f;
                        if (lane < 32) {
                            const f32x4 pq = *(const f32x4*)(rowsq + ((size_t)5 * M + t) * 4);
                            rs = pg8::rstd_of((pq[0] + pq[1]) + (pq[2] + pq[3]));
                            float lg[8];
#pragma unroll
                            for (int e = 0; e < 8; ++e) lg[e] = (dw[lane * 16 + e] + dw[lane * 16 + 8 + e]) * rs;
                            e1 = 0; float l1 = lg[0];
#pragma unroll
                            for (int e = 1; e < 8; ++e) if (lg[e] > l1) { l1 = lg[e]; e1 = e; }
                            float l2 = -3.0e38f;
#pragma unroll
                            for (int e = 0; e < 8; ++e) if (e != e1 && lg[e] > l2) { l2 = lg[e]; e2 = e; }
                            w2 = 1.0f / (1.0f + expf(l1 - l2)); w1 = 1.0f - w2;
                        }
                        int p1 = 0, p2 = 0, cnt_e = 0;
#pragma unroll
                        for (int e = 0; e < 8; ++e) { const unsigned long long m = __ballot((e1 == e) || (e2 == e)); const int rk = __popcll(m & ((1ull << lane) - 1ull));
                            if (e1 == e) p1 = rk; if (e2 == e) p2 = rk; if (lane == e) cnt_e = __popcll(m); }
                        if (lane < 8) wcnt[wave * 8 + lane] = cnt_e;
                        if (lane < 32) { tok_e[2 * t] = e1; tok_e[2 * t + 1] = e2; tok_w[2 * t] = w1; tok_w[2 * t + 1] = w2; tok_p[2 * t] = p1; tok_p[2 * t + 1] = p2; tok_r[t] = rs; }
                    }
                    __syncthreads();
                    if (tid < 8) { int s = 0; for (int w = 0; w < 8; ++w) { const int c = wcnt[w * 8 + tid]; wvbase[(tb * 8 + w) * 8 + tid] = s; s += c; } wgcnt[tb * 8 + tid] = s; }
                }
            }
            PHASE_END
            PHASE_BEGIN
            {
                LAS int* tot = (LAS int*)lds; LAS int* offs = (LAS int*)(lds + 64); LAS int* base = (LAS int*)(lds + 128);
                LAS int* cl = (LAS int*)(lds + 1024);
                LAS int* ps = (LAS int*)(lds + 1024 + 8192);
                LAS int* pb = (LAS int*)(lds + 1024 + 8192 + 2048);
                for (int i = tid; i < 2048; i += NWAVES * 64) cl[i] = wgcnt[i];
                __syncthreads();
                for (int tb = bid; tb < 256; tb += G) {
                    { const int e = tid & 7, part = tid >> 3; int s = 0, sb = 0;
#pragma unroll
                      for (int j = 0; j < 4; ++j) { const int w = part * 4 + j; const int c = cl[w * 8 + e]; s += c; sb += (w < tb) ? c : 0; }
                      ps[tid] = s; pb[tid] = sb; }
                    __syncthreads();
                    if (tid < 8) { int s = 0, sb = 0;
#pragma unroll 8
                        for (int part = 0; part < 64; ++part) { s += ps[part * 8 + tid]; sb += pb[part * 8 + tid]; }
                        tot[tid] = s; base[tid] = sb; }
                    __syncthreads();
                    if (tid == 0) { int o = 0; for (int e = 0; e < 8; ++e) { offs[e] = o; o += (tot[e] + 255) & ~255; } offs[8] = o; }
                    __syncthreads();
                    if (tb == 0) {
                        if (tid == 0) { int nt = 0; for (int e = 0; e < 8; ++e) { const int k = (offs[e + 1] - offs[e]) >> 8; for (int j = 0; j < k; ++j) tile_e[nt++] = e; } tile_e[300] = nt; }
                        for (int e = 0; e < 8; ++e) for (int s = offs[e] + tot[e] + tid; s < offs[e + 1]; s += NWAVES * 64) slot_tok[s] = -1;
                    }
                    if (tid < 256) {
                        const int p = tid, t = tb * 128 + (p >> 1), k = p & 1;
                        const int e = tok_e[2 * t + k]; const int slot = offs[e] + base[e] + wvbase[(tb * 8 + (p >> 6)) * 8 + e] + tok_p[2 * t + k];
                        slot_tok[slot] = t | (k << 24); slot_gate[slot] = tok_w[2 * t + k]; slot_rstd[slot] = tok_r[t];
                    }
                    __syncthreads();
                }
            }
            PHASE_END
            PHASE_BEGIN
            {
                const int nt = __builtin_amdgcn_readfirstlane(__hip_atomic_load(tile_e + 300, RLX_AGENT)); const int ntA = nt - GTILES;
                LAS int* te_lds = (LAS int*)(lds + LDSCTL_OFF + 6144);
                for (int i = tid; i < nt; i += NWAVES * 64) te_lds[i] = __hip_atomic_load(tile_e + i, RLX_AGENT);
                __syncthreads();
                pg8::Gemm g{(const bf16*)(ws + WS_X8), (const bf16*)(ws + WS_WMGU), 0, 0, 1024}; pg8::MoeGatherOrder S; S.init(ntA, 2 * FFE / 256, G, bid, 0, 0, te_lds); S.slot_tok = slot_tok;
                pg8::EpiSwigluF8<true> E{(unsigned char*)(ws + WS_HG), FFE, slot_rstd, 0, 2 * FFE / 256, 1.0f / W8_SCALE};
                pg8::gemm_phase<pg8::EpiSwigluF8<true>, pg8::MoeGatherOrder, true, true, true>(lds + RING_OFF, g, S, E);
            }
            PHASE_END
            PHASE_BEGIN
            {
                const int nt = __builtin_amdgcn_readfirstlane(__hip_atomic_load(tile_e + 300, RLX_AGENT)); const int ntA = nt - GTILES;
                LAS int* te_lds = (LAS int*)(lds + LDSCTL_OFF + 6144);
                for (int i = tid; i < nt; i += NWAVES * 64) te_lds[i] = __hip_atomic_load(tile_e + i, RLX_AGENT);
                __syncthreads();
                {
                    pg8::Gemm g{(const bf16*)(ws + WS_HG), (const bf16*)(ws + WS_WMD), 0, 0, FFE}; pg8::MoeOrder S; S.init(ntA, D / 256, G, bid, 0, 0, te_lds);
                    pg8::EpiMoeDown E{(unsigned char*)(ws + WS_Y0), (unsigned char*)(ws + WS_Y1), slot_tok, slot_gate, 0, D / 256, 1.0f / W8_SCALE};
                    pg8::gemm_phase<pg8::EpiMoeDown, pg8::MoeOrder, true, true, true>(lds + RING_OFF, g, S, E);
                }
                __syncthreads();
                {
                    const int nmd = ntA * (D / 256);
                    pg8::Gemm g{(const bf16*)(ws + WS_X8), (const bf16*)(ws + WS_WMGU), 0, 0, 1024}; pg8::MoeGatherSkipOrder S; S.init(GTILES, 2 * FFE / 256, G, bid, ntA, ntA, te_lds + ntA); S.slot_tok = slot_tok;
                    S.rem = nmd % G; S.skip = (S.rem == 0) ? 0 : MD_SKIP;
                    pg8::EpiSwigluF8<true> E{(unsigned char*)(ws + WS_HGB), FFE, slot_rstd, ntA, 2 * FFE / 256, 1.0f / W8_SCALE};
                    pg8::gemm_phase<pg8::EpiSwigluF8<true>, pg8::MoeGatherSkipOrder, true, true, true>(lds + RING_OFF, g, S, E);
                }
            }
            PHASE_END
            PHASE_BEGIN
            {
                const int nt = __builtin_amdgcn_readfirstlane(__hip_atomic_load(tile_e + 300, RLX_AGENT)); const int ntA = nt - GTILES;
                LAS int* te_lds = (LAS int*)(lds + LDSCTL_OFF + 6144);
                for (int i = tid; i < nt; i += NWAVES * 64) te_lds[i] = __hip_atomic_load(tile_e + i, RLX_AGENT);
                __syncthreads();
                pg8::Gemm g{(const bf16*)(ws + WS_HGB), (const bf16*)(ws + WS_WMD), 0, 0, FFE}; pg8::MoeOrder S; S.init(GTILES, D / 256, G, bid, 0, ntA, te_lds + ntA);
                pg8::EpiMoeDown E{(unsigned char*)(ws + WS_Y0), (unsigned char*)(ws + WS_Y1), slot_tok, slot_gate, ntA, D / 256, 1.0f / W8_SCALE};
                pg8::gemm_phase<pg8::EpiMoeDown, pg8::MoeOrder, true, true, true>(lds + RING_OFF, g, S, E);
            }
            PHASE_END
        }
    }
    {
        constexpr int l = 1;
        PHASE_BEGIN
        {
            pg8::Gemm g{xb, (const bf16*)(ws + WS_WIN) + (size_t)l * 2048 * 1024, M, INCOLS, 1024}; pg8::StaticOrder S; S.init(M, INCOLS, G, bid);
            pg8::EpiScaleBf16 E{(bf16*)(ws + WS_PROJ), INCOLS, rowsq + (size_t)(3 * l) * M * 4, 1.0f};
            pg8::gemm_phase<pg8::EpiScaleBf16, pg8::StaticOrder, true, true>(lds + RING_OFF, g, S, E);
        }
        PHASE_END
        PHASE_BEGIN
        {
            int u0 = bid, ustep = G;
            if (l == 0) {
                const int nkv = (G >= 128) ? 64 : G;
                if (bid < nkv) {
                    pg8::Gemm g{(const bf16*)(ws + WS_MEMB), (const bf16*)(ws + WS_WKV), MROWS, 2048, 1024}; pg8::StaticOrder S; S.init(MROWS, 2048, nkv, bid);
                    pg8::EpiScaleBf16 E{(bf16*)(ws + WS_KVMEM), 2048, (const float*)(ws + WS_MEMSQ), 1.0f};
                    pg8::gemm_phase<pg8::EpiScaleBf16, pg8::StaticOrder, true, true>(lds + RING_OFF, g, S, E);
                    __syncthreads();
                }
                if (G >= 128) { u0 = (bid < nkv) ? 256 : bid - nkv; ustep = G - nkv; }
            }
            for (int unit = u0; unit < 256; unit += ustep) {
                { int t0 = threadIdx.x; asm volatile("" : "+v"(t0)); rg_conv_to_lds(args, lds, l, unit, t0); }
                __syncthreads();
                { int t1 = threadIdx.x; asm volatile("" : "+v"(t1)); rg_scan_mfma<1>(args, lds, l, unit, t1); }
                __syncthreads();
            }
        }
        PHASE_END
        PHASE_BEGIN
        {
            constexpr int TB_OFF = LDSCTL_OFF + 6144;
            if (tid < 192) { const int dist = tid - 32; int bk = dist;
                if (dist >= 16) { const float v = logf((float)dist / 16.0f) / logf(8.0f) * 16.0f; bk = 16 + (int)v; if (bk > 31) bk = 31; }
                const bool ok = dist >= 0 && dist < 128;
                const float* bp = args.in[2] + (ok ? bk : 0) * 8; const f32x4 b0 = *(const f32x4*)bp, b1 = *(const f32x4*)(bp + 4);
                const float bv[8] = {b0[0], b0[1], b0[2], b0[3], b1[0], b1[1], b1[2], b1[3]};
#pragma unroll
                for (int h = 0; h < 8; ++h) ((LAS float*)(lds + TB_OFF))[h * 192 + tid] = ok ? bv[h] * LOG2E : -1.0e30f; }
            __syncthreads();
            for (int unit = bid; unit < 256; unit += G) {
                { int t1 = threadIdx.x; asm volatile("" : "+v"(t1)); rg_out_vec(args, lds, l, unit, t1); }
                { int t3 = threadIdx.x; asm volatile("" : "+v"(t3)); sc_conv_vec(args, l, unit, t3); }
                { int t2 = threadIdx.x; asm volatile("" : "+v"(t2)); swa_unit_mfma(args, lds, TB_OFF, l, unit, t2); }
            }
        }
        PHASE_END
        PHASE_BEGIN
        {
            pg8::Gemm g{(const bf16*)(ws + WS_MIXED), (const bf16*)(ws + WS_WOUT) + (size_t)l * 1024 * 1024, M, D, 1024}; pg8::StaticOrder S; S.init(M, D, G, bid);
            pg8::EpiResid E{xb, rowsq + (size_t)(3 * l + 1) * M * 4, (LAS float*)(lds + RED_OFF), (unsigned char*)(ws + WS_X8), 1.0f};
            pg8::gemm_phase<pg8::EpiResid, pg8::StaticOrder, true, true>(lds + RING_OFF, g, S, E);
        }
        PHASE_END
        PHASE_BEGIN
        {
            pg8::Gemm g{(const bf16*)(ws + WS_X8), (const bf16*)(ws + WS_WXQ + (size_t)l * 512 * 1024), M, 512, 1024}; pg8::StaticOrder S; S.init(M, 512, G, bid);
            pg8::EpiScaleBf16 E{(bf16*)(ws + WS_QXA), 512, rowsq + (size_t)(3 * l + 1) * M * 4, 1.0f / W8_SCALE};
            pg8::gemm_phase<pg8::EpiScaleBf16, pg8::StaticOrder, true, true, true>(lds + RING_OFF, g, S, E);
        }
        PHASE_END
        PHASE_BEGIN
        {
            for (int unit = bid; unit < 256; unit += G) xa_unit_mfma(args, lds, l, unit, tid);
        }
        PHASE_END
        PHASE_BEGIN
        {
            pg8::Gemm g{(const bf16*)(ws + WS_XO), (const bf16*)(ws + WS_WXO + (size_t)l * 1024 * 512), M, D, 512}; pg8::StaticOrder S; S.init(M, D, G, bid);
            pg8::EpiResid E{xb, rowsq + (size_t)(3 * l + 2) * M * 4, (LAS float*)(lds + RED_OFF), l == 1 ? (unsigned char*)(ws + WS_X8) : nullptr, 1.0f / W8_SCALE};
            pg8::gemm_phase<pg8::EpiResid, pg8::StaticOrder, true, true, true>(lds + RING_OFF, g, S, E);
        }
        PHASE_END
        if (l == 0) {
            PHASE_BEGIN
            {
                pg8::Gemm g{xb, (const bf16*)(ws + WS_WDGU), M, 2 * FFD, 1024}; pg8::StaticOrder S; S.init(M, 2 * FFD, G, bid);
                pg8::EpiSwiglu<false> E{(bf16*)(ws + WS_HD), FFD, rowsq + (size_t)2 * M * 4, 0, 2 * FFD / 256};
                pg8::gemm_phase<pg8::EpiSwiglu<false>, pg8::StaticOrder, true, true>(lds + RING_OFF, g, S, E);
            }
            PHASE_END
            PHASE_BEGIN
            {
                pg8::Gemm g{(const bf16*)(ws + WS_HD), (const bf16*)(ws + WS_WDD), M, D, FFD}; pg8::StaticOrder S; S.init(M, D, G, bid);
                pg8::EpiResid E{xb, rowsq + (size_t)3 * M * 4, (LAS float*)(lds + RED_OFF), nullptr, 1.0f};
                pg8::gemm_phase<pg8::EpiResid, pg8::StaticOrder, true, true>(lds + RING_OFF, g, S, E);
            }
            PHASE_END
        } else {
            int* tok_e = (int*)(ws + WS_TOKE); float* tok_w = (float*)(ws + WS_TOKW); int* tok_p = (int*)(ws + WS_TOKP); float* tok_r = (float*)(ws + WS_TOKR);
            int* slot_tok = (int*)(ws + WS_SLOTT); float* slot_gate = (float*)(ws + WS_SLOTG); float* slot_rstd = (float*)(ws + WS_SLOTR);
            int* tile_e = (int*)(ws + WS_TILEE); int* wgcnt = (int*)(ws + WS_WGCNT); int* wvbase = (int*)(ws + WS_WVCNT);
            PHASE_BEGIN
            {
                LAS unsigned char* Rt = lds;
                LAS float* Dl = (LAS float*)(lds + 32768);
                LAS int* wcnt = (LAS int*)(lds + 32768 + 8192);
                { const float* rp = args.in[26]; const float* gp = args.in[22] + 1024;
#pragma unroll
                  for (int i = 0; i < 16; ++i) { const int q = tid + i * NWAVES * 64, k = q >> 3, e = q & 7; const float v = rp[q] * gp[k];
                      const unsigned hb = f2bf(v); const unsigned lb = f2bf(v - __builtin_bit_cast(float, hb << 16));
                      *(LAS unsigned short*)(Rt + e * 2048 + (((k >> 3) ^ e) << 4) + (k & 7) * 2) = (unsigned short)hb;
                      *(LAS unsigned short*)(Rt + (8 + e) * 2048 + (((k >> 3) ^ (8 + e)) << 4) + (k & 7) * 2) = (unsigned short)lb; } }
                for (int tb = bid; tb < 256; tb += G) {
                    __syncthreads();
                    if (tid < 64) wcnt[tid] = 0;
                    __syncthreads();
                    if (wave < 4) {
                        const int r32 = lane & 31, hi = lane >> 5; const int t = tb * 128 + wave * 32 + r32;
                        const bf16* xp = xb + (size_t)t * D + hi * 8;
                        f32x16 acc;
#pragma unroll
                        for (int r = 0; r < 16; ++r) acc[r] = 0.f;
#pragma unroll 1
                        for (int ks0 = 0; ks0 < 64; ks0 += 8) {
                            bf16x8v a[8];
#pragma unroll
                            for (int j = 0; j < 8; ++j) a[j] = *(const bf16x8v*)(xp + (ks0 + j) * 16);
#pragma unroll
                            for (int j = 0; j < 8; ++j) { const int ks = ks0 + j; v4u bz = (v4u){0u, 0u, 0u, 0u};
                                if (r32 < 16) bz = *(const LAS v4u*)(Rt + r32 * 2048 + (((2 * ks + hi) ^ r32) << 4));
                                acc = __builtin_amdgcn_mfma_f32_32x32x16_bf16(a[j], __builtin_bit_cast(bf16x8v, bz), acc, 0, 0, 0); }
                        }
                        LAS float* dw = Dl + wave * 512;
                        if (r32 < 16) {
#pragma unroll
                            for (int r = 0; r < 16; ++r) dw[((r & 3) + 8 * (r >> 2) + 4 * hi) * 16 + r32] = acc[r]; }
                        LDS_WAIT();
                        int e1 = -1, e2 = -1; float w1 = 0.f, w2 = 0.f, rs = 0.f;
                        if (lane < 32) {
                            const f32x4 pq = *(const f32x4*)(rowsq + ((size_t)5 * M + t) * 4);
                            rs = pg8::rstd_of((pq[0] + pq[1]) + (pq[2] + pq[3]));
                            float lg[8];
#pragma unroll
                            for (int e = 0; e < 8; ++e) lg[e] = (dw[lane * 16 + e] + dw[lane * 16 + 8 + e]) * rs;
                            e1 = 0; float l1 = lg[0];
#pragma unroll
                            for (int e = 1; e < 8; ++e) if (lg[e] > l1) { l1 = lg[e]; e1 = e; }
                            float l2 = -3.0e38f;
#pragma unroll
                            for (int e = 0; e < 8; ++e) if (e != e1 && lg[e] > l2) { l2 = lg[e]; e2 = e; }
                            w2 = 1.0f / (1.0f + expf(l1 - l2)); w1 = 1.0f - w2;
                        }
                        int p1 = 0, p2 = 0, cnt_e = 0;
#pragma unroll
                        for (int e = 0; e < 8; ++e) { const unsigned long long m = __ballot((e1 == e) || (e2 == e)); const int rk = __popcll(m & ((1ull << lane) - 1ull));
                            if (e1 == e) p1 = rk; if (e2 == e) p2 = rk; if (lane == e) cnt_e = __popcll(m); }
                        if (lane < 8) wcnt[wave * 8 + lane] = cnt_e;
                        if (lane < 32) { tok_e[2 * t] = e1; tok_e[2 * t + 1] = e2; tok_w[2 * t] = w1; tok_w[2 * t + 1] = w2; tok_p[2 * t] = p1; tok_p[2 * t + 1] = p2; tok_r[t] = rs; }
                    }
                    __syncthreads();
                    if (tid < 8) { int s = 0; for (int w = 0; w < 8; ++w) { const int c = wcnt[w * 8 + tid]; wvbase[(tb * 8 + w) * 8 + tid] = s; s += c; } wgcnt[tb * 8 + tid] = s; }
                }
            }
            PHASE_END
            PHASE_BEGIN
            {
                LAS int* tot = (LAS int*)lds; LAS int* offs = (LAS int*)(lds + 64); LAS int* base = (LAS int*)(lds + 128);
                LAS int* cl = (LAS int*)(lds + 1024);
                LAS int* ps = (LAS int*)(lds + 1024 + 8192);
                LAS int* pb = (LAS int*)(lds + 1024 + 8192 + 2048);
                for (int i = tid; i < 2048; i += NWAVES * 64) cl[i] = wgcnt[i];
                __syncthreads();
                for (int tb = bid; tb < 256; tb += G) {
                    { const int e = tid & 7, part = tid >> 3; int s = 0, sb = 0;
#pragma unroll
                      for (int j = 0; j < 4; ++j) { const int w = part * 4 + j; const int c = cl[w * 8 + e]; s += c; sb += (w < tb) ? c : 0; }
                      ps[tid] = s; pb[tid] = sb; }
                    __syncthreads();
                    if (tid < 8) { int s = 0, sb = 0;
#pragma unroll 8
                        for (int part = 0; part < 64; ++part) { s += ps[part * 8 + tid]; sb += pb[part * 8 + tid]; }
                        tot[tid] = s; base[tid] = sb; }
                    __syncthreads();
                    if (tid == 0) { int o = 0; for (int e = 0; e < 8; ++e) { offs[e] = o; o += (tot[e] + 255) & ~255; } offs[8] = o; }
                    __syncthreads();
                    if (tb == 0) {
                        if (tid == 0) { int nt = 0; for (int e = 0; e < 8; ++e) { const int k = (offs[e + 1] - offs[e]) >> 8; for (int j = 0; j < k; ++j) tile_e[nt++] = e; } tile_e[300] = nt; }
                        for (int e = 0; e < 8; ++e) for (int s = offs[e] + tot[e] + tid; s < offs[e + 1]; s += NWAVES * 64) slot_tok[s] = -1;
                    }
                    if (tid < 256) {
                        const int p = tid, t = tb * 128 + (p >> 1), k = p & 1;
                        const int e = tok_e[2 * t + k]; const int slot = offs[e] + base[e] + wvbase[(tb * 8 + (p >> 6)) * 8 + e] + tok_p[2 * t + k];
                        slot_tok[slot] = t | (k << 24); slot_gate[slot] = tok_w[2 * t + k]; slot_rstd[slot] = tok_r[t];
                    }
                    __syncthreads();
                }
            }
            PHASE_END
            PHASE_BEGIN
            {
                const int nt = __builtin_amdgcn_readfirstlane(__hip_atomic_load(tile_e + 300, RLX_AGENT)); const int ntA = nt - GTILES;
                LAS int* te_lds = (LAS int*)(lds + LDSCTL_OFF + 6144);
                for (int i = tid; i < nt; i += NWAVES * 64) te_lds[i] = __hip_atomic_load(tile_e + i, RLX_AGENT);
                __syncthreads();
                pg8::Gemm g{(const bf16*)(ws + WS_X8), (const bf16*)(ws + WS_WMGU), 0, 0, 1024}; pg8::MoeGatherOrder S; S.init(ntA, 2 * FFE / 256, G, bid, 0, 0, te_lds); S.slot_tok = slot_tok;
                pg8::EpiSwigluF8<true> E{(unsigned char*)(ws + WS_HG), FFE, slot_rstd, 0, 2 * FFE / 256, 1.0f / W8_SCALE};
                pg8::gemm_phase<pg8::EpiSwigluF8<true>, pg8::MoeGatherOrder, true, true, true>(lds + RING_OFF, g, S, E);
            }
            PHASE_END
            PHASE_BEGIN
            {
                const int nt = __builtin_amdgcn_readfirstlane(__hip_atomic_load(tile_e + 300, RLX_AGENT)); const int ntA = nt - GTILES;
                LAS int* te_lds = (LAS int*)(lds + LDSCTL_OFF + 6144);
                for (int i = tid; i < nt; i += NWAVES * 64) te_lds[i] = __hip_atomic_load(tile_e + i, RLX_AGENT);
                __syncthreads();
                {
                    pg8::Gemm g{(const bf16*)(ws + WS_HG), (const bf16*)(ws + WS_WMD), 0, 0, FFE}; pg8::MoeOrder S; S.init(ntA, D / 256, G, bid, 0, 0, te_lds);
                    pg8::EpiMoeDown E{(unsigned char*)(ws + WS_Y0), (unsigned char*)(ws + WS_Y1), slot_tok, slot_gate, 0, D / 256, 1.0f / W8_SCALE};
                    pg8::gemm_phase<pg8::EpiMoeDown, pg8::MoeOrder, true, true, true>(lds + RING_OFF, g, S, E);
                }
                __syncthreads();
                {
                    const int nmd = ntA * (D / 256);
                    pg8::Gemm g{(const bf16*)(ws + WS_X8), (const bf16*)(ws + WS_WMGU), 0, 0, 1024}; pg8::MoeGatherSkipOrder S; S.init(GTILES, 2 * FFE / 256, G, bid, ntA, ntA, te_lds + ntA); S.slot_tok = slot_tok;
                    S.rem = nmd % G; S.skip = (S.rem == 0) ? 0 : MD_SKIP;
                    pg8::EpiSwigluF8<true> E{(unsigned char*)(ws + WS_HGB), FFE, slot_rstd, ntA, 2 * FFE / 256, 1.0f / W8_SCALE};
                    pg8::gemm_phase<pg8::EpiSwigluF8<true>, pg8::MoeGatherSkipOrder, true, true, true>(lds + RING_OFF, g, S, E);
                }
            }
            PHASE_END
            PHASE_BEGIN
            {
                const int nt = __builtin_amdgcn_readfirstlane(__hip_atomic_load(tile_e + 300, RLX_AGENT)); const int ntA = nt - GTILES;
                LAS int* te_lds = (LAS int*)(lds + LDSCTL_OFF + 6144);
                for (int i = tid; i < nt; i += NWAVES * 64) te_lds[i] = __hip_atomic_load(tile_e + i, RLX_AGENT);
                __syncthreads();
                pg8::Gemm g{(const bf16*)(ws + WS_HGB), (const bf16*)(ws + WS_WMD), 0, 0, FFE}; pg8::MoeOrder S; S.init(GTILES, D / 256, G, bid, 0, ntA, te_lds + ntA);
                pg8::EpiMoeDown E{(unsigned char*)(ws + WS_Y0), (unsigned char*)(ws + WS_Y1), slot_tok, slot_gate, ntA, D / 256, 1.0f / W8_SCALE};
                pg8::gemm_phase<pg8::EpiMoeDown, pg8::MoeOrder, true, true, true>(lds + RING_OFF, g, S, E);
            }
            PHASE_END
        }
    }
    PHASE_BEGIN
    {
        const int gw = bid * NWAVES + wave, NGW = G * NWAVES; const unsigned char* Y0 = (const unsigned char*)(ws + WS_Y0); const unsigned char* Y1 = (const unsigned char*)(ws + WS_Y1);
        f32x4 gg[4];
        { const GAS f32x4* gr = (const GAS f32x4*)args.in[30]; gg[0] = gr[2 * lane]; gg[1] = gr[2 * lane + 1]; gg[2] = gr[128 + 2 * lane]; gg[3] = gr[128 + 2 * lane + 1]; }
        for (int m0 = gw; m0 < M; m0 += 4 * NGW) {
            v4u a[4][2]; v2u b0[4][2], b1[4][2];
#pragma unroll
            for (int u = 0; u < 4; ++u) { const size_t m = (size_t)(m0 + u * NGW);
                const GAS v4u* xr = (const GAS v4u*)(xb + m * D) + lane; const GAS v2u* y0 = (const GAS v2u*)(Y0 + m * D) + lane; const GAS v2u* y1 = (const GAS v2u*)(Y1 + m * D) + lane;
                a[u][0] = xr[0]; a[u][1] = xr[64]; b0[u][0] = y0[0]; b0[u][1] = y0[64]; b1[u][0] = y1[0]; b1[u][1] = y1[64]; }
#pragma unroll
            for (int u = 0; u < 4; ++u) { const size_t m = (size_t)(m0 + u * NGW); f32x4 v[4]; float s = 0.f;
#pragma unroll
                for (int h = 0; h < 2; ++h) { const v4u xa = a[u][h]; const v2u ya = b0[u][h], yb = b1[u][h];
                    const f32x2 p0 = __builtin_amdgcn_cvt_pk_f32_fp8((int)ya.x, false), p1 = __builtin_amdgcn_cvt_pk_f32_fp8((int)ya.x, true), p2 = __builtin_amdgcn_cvt_pk_f32_fp8((int)ya.y, false), p3 = __builtin_amdgcn_cvt_pk_f32_fp8((int)ya.y, true);
                    const f32x2 r0 = __builtin_amdgcn_cvt_pk_f32_fp8((int)yb.x, false), r1 = __builtin_amdgcn_cvt_pk_f32_fp8((int)yb.x, true), r2 = __builtin_amdgcn_cvt_pk_f32_fp8((int)yb.y, false), r3 = __builtin_amdgcn_cvt_pk_f32_fp8((int)yb.y, true);
                    v[2 * h] = (f32x4){bflo(xa.x) + p0.x + r0.x, bfhi(xa.x) + p0.y + r0.y, bflo(xa.y) + p1.x + r1.x, bfhi(xa.y) + p1.y + r1.y};
                    v[2 * h + 1] = (f32x4){bflo(xa.z) + p2.x + r2.x, bfhi(xa.z) + p2.y + r2.y, bflo(xa.w) + p3.x + r3.x, bfhi(xa.w) + p3.y + r3.y}; }
#pragma unroll
                for (int j = 0; j < 4; ++j) s += (v[j].x * v[j].x + v[j].y * v[j].y) + (v[j].z * v[j].z + v[j].w * v[j].w);
                const float rs = pg8::rstd_of(wave_sum(s));
                GAS f32x4* orow = (GAS f32x4*)(xres + m * D);
                orow[2 * lane] = v[0] * rs * gg[0]; orow[2 * lane + 1] = v[1] * rs * gg[1]; orow[128 + 2 * lane] = v[2] * rs * gg[2]; orow[128 + 2 * lane + 1] = v[3] * rs * gg[3]; }
        }
    }
    PHASE_END
#undef PHASE_BEGIN
#undef PHASE_END
#undef ws
#undef xres
#undef rowsq
#undef xb
}

extern "C" void kernel_launch(void* const* d_in, const int* in_sizes, int n_in, void* d_out, int out_size, void* d_ws, size_t ws_size, hipStream_t stream) {
    static int grid = 0;
    if (grid == 0) {
        if (n_in != 31 || in_sizes[0] != M * D || out_size != M * D || ws_size < WS_END) { fprintf(stderr, "kernel_launch: unexpected shapes / workspace (n_in %d, ws %zu, need %zu)\n", n_in, ws_size, (size_t)WS_END); grid = -1; return; }
        int dev = 0, cus = 0, per_cu = 0;
        if (hipGetDevice(&dev) != hipSuccess || hipDeviceGetAttribute(&cus, hipDeviceAttributeMultiprocessorCount, dev) != hipSuccess) { grid = -1; return; }
        if (hipFuncSetAttribute((const void*)hymba_fwd, hipFuncAttributeMaxDynamicSharedMemorySize, LDS_BYTES) != hipSuccess) { fprintf(stderr, "kernel_launch: hipFuncSetAttribute failed\n"); grid = -1; return; }
        if (hipOccupancyMaxActiveBlocksPerMultiprocessor(&per_cu, (const void*)hymba_fwd, NWAVES * 64, LDS_BYTES) != hipSuccess || per_cu < 1) fprintf(stderr, "kernel_launch: occupancy query reports %d\n", per_cu);
        (void)hipGetLastError();
        grid = cus;
    }
    if (grid < 0) return;
    if (hipMemsetAsync((char*)d_ws + WS_CTL, 0, CTL_ZERO_BYTES, stream) != hipSuccess) return;
    Args a{};
    for (int i = 0; i < 31; ++i) a.in[i] = (const float*)d_in[i];
    a.out = (float*)d_out; a.ws = (unsigned char*)d_ws;
#if MK_ONE_LAUNCH
    a.ph_lo = 0; a.ph_hi = 1000;
    hipLaunchKernelGGL(hymba_fwd, dim3(grid), dim3(NWAVES * 64), LDS_BYTES, stream, a);
#else
    for (int p = 0; p < NPHASES; ++p) { a.ph_lo = p; a.ph_hi = p + 1; hipLaunchKernelGGL(hymba_fwd, dim3(grid), dim3(NWAVES * 64), LDS_BYTES, stream, a); }
#endif
}
```

```cpp
#include <hip/hip_runtime.h>
#include <cstdio>
#include <cstdint>
#define MK_ONE_LAUNCH 1
namespace pg8 {
#define PG8_LAS __attribute__((address_space(3)))
typedef unsigned short bf16_t;
typedef short bf16x8 __attribute__((ext_vector_type(8)));
typedef float f32x4 __attribute__((ext_vector_type(4)));
typedef unsigned u32x4 __attribute__((ext_vector_type(4)));
constexpr int BM = 256, BK = 64, HALF = 128, HTB = HALF * BK * 2  , STAGE_BYTES = 8 * HTB, NXCD = 8, WGM = 4;

__host__ __device__ __forceinline__ int lds_byte(int r, int c) { const int st = (r >> 4) * 2 + (c >> 5), rr = r & 15, cc = c & 31, ob = rr * 64 + cc * 2; return st * 1024 + (ob ^ (((ob >> 9) & 1) << 5)); }
__host__ __device__ __forceinline__ void stage_rc(int b, int& R, int& C) { const int st = b / 1024, sb = b % 1024, swz = sb ^ (((sb >> 9) & 1) << 5); R = (st >> 1) * 16 + swz / 64; C = (st & 1) * 32 + (swz % 64) / 2; }
__host__ __device__ __forceinline__ int perm32(int rho) { const int n = rho >> 4, i = rho & 15; return 8 * (i >> 2) + 4 * n + (i & 3); }

struct Unit { int pm, pn; };
struct Gemm { const bf16_t* A; const bf16_t* Bt; int M, N, K; };

struct StaticOrder {
    int nM, nN, nwg, G, c;
    __host__ __device__ void init(int M, int N, int G_, int c_) { nM = M / BM; nN = N / BM; nwg = nM * nN; G = G_; c = c_; }
    __host__ __device__ bool next(int i, Unit& u) const {
        const long L = (long)i * G + c; if (L >= nwg) return false;
        int wgid = (int)L; { const int q = nwg / NXCD, r = nwg % NXCD, xcd = wgid % NXCD, off = wgid / NXCD; wgid = (xcd < r ? xcd * (q + 1) : r * (q + 1) + (xcd - r) * q) + off; }
        const int nig = WGM * nN, gid = wgid / nig, fm = gid * WGM, gsz = (nM - fm) < WGM ? (nM - fm) : WGM;
        u.pm = fm + ((wgid % nig) % gsz); u.pn = (wgid % nig) / gsz; return true;
    }
    __device__ __forceinline__ void a_ready(const Unit&) const {}
    __device__ __forceinline__ void done(const Unit&) const {}
    static constexpr bool GATHER = false; __device__ __forceinline__ int arow_raw(const Unit&, int) const { return 0; } __device__ __forceinline__ int arow_fix(int) const { return 0; }
};

__device__ __forceinline__ unsigned cvt_pk_bf16(float lo, float hi) { unsigned r; asm volatile("v_cvt_pk_bf16_f32 %0, %1, %2" : "=v"(r) : "v"(lo), "v"(hi)); return r; }
typedef float f32x2 __attribute__((ext_vector_type(2)));
__device__ __forceinline__ void plswap32(unsigned& a, unsigned& b) { auto r = __builtin_amdgcn_permlane32_swap(a, b, false, false); a = r[0]; b = r[1]; }
__device__ __forceinline__ void plswap16(unsigned& a, unsigned& b) { auto r = __builtin_amdgcn_permlane16_swap(a, b, false, false); a = r[0]; b = r[1]; }
__device__ __forceinline__ void swap32_pair(float x, float& r0, float& r1) { unsigned a = __builtin_bit_cast(unsigned, x), b = a; asm volatile("" : "+v"(b)); auto r = __builtin_amdgcn_permlane32_swap(a, b, false, false);
    unsigned q0 = r[0], q1 = r[1]; asm volatile("" : "+v"(q0), "+v"(q1)); r0 = __builtin_bit_cast(float, q0); r1 = __builtin_bit_cast(float, q1); }
__device__ __forceinline__ void swap16_pair(float x, float& r0, float& r1) { unsigned a = __builtin_bit_cast(unsigned, x), b = a; asm volatile("" : "+v"(b)); auto r = __builtin_amdgcn_permlane16_swap(a, b, false, false);
    unsigned q0 = r[0], q1 = r[1]; asm volatile("" : "+v"(q0), "+v"(q1)); r0 = __builtin_bit_cast(float, q0); r1 = __builtin_bit_cast(float, q1); }
__device__ __forceinline__ float xor32_sum(float x) { float a, b; swap32_pair(x, a, b); return a + b; }
__device__ __forceinline__ float xor32_max(float x) { float a, b; swap32_pair(x, a, b); return fmaxf(a, b); }
__device__ __forceinline__ float xor16_sum(float x) { float a, b; swap16_pair(x, a, b); return a + b; }
__device__ __forceinline__ float xor32_other(float x, int hi) { float a, b; swap32_pair(x, a, b); return hi ? a : b; }
typedef float f32x2 __attribute__((ext_vector_type(2)));
typedef unsigned u32x2 __attribute__((ext_vector_type(2)));
constexpr float RMS_EPS = 1e-6f;
__device__ __forceinline__ float rstd_of(float sumsq) { return __builtin_amdgcn_rsqf(sumsq * (1.0f / 1024.0f) + RMS_EPS); }
__device__ __forceinline__ unsigned pk4_fp8(float a, float b, float c, float d) { int w = __builtin_amdgcn_cvt_pk_fp8_f32(a, b, 0, false); w = __builtin_amdgcn_cvt_pk_fp8_f32(c, d, w, true); return (unsigned)w; }
__device__ __forceinline__ float silu_f(float g) { return g * __builtin_amdgcn_rcpf(1.0f + __expf(-g)); }

struct EpiScaleBf16 {
    static constexpr bool PERM = true, AFTER_DRAIN = false; static constexpr int VMOPS = 16;
    bf16_t* O; int ldc; const float* rowsq; float cs;
    __device__ __forceinline__ void operator()(const f32x4 (&acc)[2][2][4][2], const Unit& u, int wr, int wc, int fr, int fq) const {
        const int row0 = u.pm * BM + wr * 64 + fr, col0 = u.pn * BM + wc * 32 + 8 * fq;
        f32x4 pqv[2][4];
#pragma unroll
        for (int ai = 0; ai < 2; ++ai)
#pragma unroll
            for (int m = 0; m < 4; ++m) pqv[ai][m] = *(const f32x4*)(rowsq + (size_t)(row0 + ai * HALF + m * 16) * 4);
#pragma unroll
        for (int ai = 0; ai < 2; ++ai)
#pragma unroll
            for (int m = 0; m < 4; ++m) { const int row = row0 + ai * HALF + m * 16; const f32x4 pq = pqv[ai][m]; const float rs = rstd_of((pq[0] + pq[1]) + (pq[2] + pq[3])) * cs; bf16_t* rowp = O + (size_t)row * ldc + col0;
#pragma unroll
                for (int bj = 0; bj < 2; ++bj) { const f32x4 v0 = acc[ai][bj][m][0] * rs, v1 = acc[ai][bj][m][1] * rs;
                    u32x4 w; w.x = cvt_pk_bf16(v0[0], v0[1]); w.y = cvt_pk_bf16(v0[2], v0[3]); w.z = cvt_pk_bf16(v1[0], v1[1]); w.w = cvt_pk_bf16(v1[2], v1[3]);
                    *(u32x4*)(rowp + bj * HALF) = w; } }
    }
};
struct EpiResid {
    static constexpr bool PERM = true, AFTER_DRAIN = false; static constexpr int VMOPS = 24;
    bf16_t* xb; float* rowsq4; PG8_LAS float* red; unsigned char* x8; float ws;
    __device__ __forceinline__ void operator()(const f32x4 (&acc)[2][2][4][2], const Unit& u, int wr, int wc, int fr, int fq) const {
        const int row0 = u.pm * BM + wr * 64 + fr, col0 = u.pn * BM + wc * 32 + 8 * fq;
        u32x4 xiv[2][4][2];
#pragma unroll
        for (int ai = 0; ai < 2; ++ai)
#pragma unroll
            for (int m = 0; m < 4; ++m)
#pragma unroll
                for (int bj = 0; bj < 2; ++bj) xiv[ai][m][bj] = *(const u32x4*)(xb + (size_t)(row0 + ai * HALF + m * 16) * 1024 + col0 + bj * HALF);
#pragma unroll
        for (int ai = 0; ai < 2; ++ai)
#pragma unroll
            for (int mp = 0; mp < 2; ++mp) { unsigned qx[2][2], qy[2][2];
#pragma unroll
              for (int mm = 0; mm < 2; ++mm) { const int m = 2 * mp + mm; const int row = row0 + ai * HALF + m * 16; bf16_t* rowp = xb + (size_t)row * 1024 + col0; float ss = 0.f;
#pragma unroll
                for (int bj = 0; bj < 2; ++bj) { const u32x4 xi = xiv[ai][m][bj];
                    f32x4 o0 = acc[ai][bj][m][0] * ws, o1 = acc[ai][bj][m][1] * ws;
                    o0[0] += __builtin_bit_cast(float, xi.x << 16); o0[1] += __builtin_bit_cast(float, xi.x & 0xffff0000u); o0[2] += __builtin_bit_cast(float, xi.y << 16); o0[3] += __builtin_bit_cast(float, xi.y & 0xffff0000u);
                    o1[0] += __builtin_bit_cast(float, xi.z << 16); o1[1] += __builtin_bit_cast(float, xi.z & 0xffff0000u); o1[2] += __builtin_bit_cast(float, xi.w << 16); o1[3] += __builtin_bit_cast(float, xi.w & 0xffff0000u);
                    ss += ((o0[0] * o0[0] + o0[1] * o0[1]) + (o0[2] * o0[2] + o0[3] * o0[3])) + ((o1[0] * o1[0] + o1[1] * o1[1]) + (o1[2] * o1[2] + o1[3] * o1[3]));
                    u32x4 w; w.x = cvt_pk_bf16(o0[0], o0[1]); w.y = cvt_pk_bf16(o0[2], o0[3]); w.z = cvt_pk_bf16(o1[0], o1[1]); w.w = cvt_pk_bf16(o1[2], o1[3]);
                    *(u32x4*)(rowp + bj * HALF) = w;
                    if (x8) { qx[mm][bj] = pk4_fp8(o0[0], o0[1], o0[2], o0[3]); qy[mm][bj] = pk4_fp8(o1[0], o1[1], o1[2], o1[3]); } }
                ss = xor16_sum(ss); ss = xor32_sum(ss);
                if (fq == 0) red[(ai * HALF + wr * 64 + m * 16 + fr) * 4 + wc] = ss; }
              if (x8) { unsigned char* xp = x8 + (size_t)(row0 + ai * HALF + (2 * mp + (fq & 1)) * 16) * 1024 + u.pn * BM + wc * 32 + 16 * (fq >> 1);
#pragma unroll
                for (int bj = 0; bj < 2; ++bj) { plswap16(qx[0][bj], qx[1][bj]); plswap16(qy[0][bj], qy[1][bj]);
                    u32x4 w; w.x = qx[0][bj]; w.y = qy[0][bj]; w.z = qx[1][bj]; w.w = qy[1][bj]; *(u32x4*)(xp + bj * HALF) = w; } } }
        asm volatile("s_waitcnt lgkmcnt(0)" ::: "memory"); __builtin_amdgcn_s_barrier(); asm volatile("" ::: "memory");
        const int t = (wr * 4 + wc) * 64 + fq * 16 + fr;
        if (t < 256) { const f32x4 p = *(const PG8_LAS f32x4*)(red + t * 4); rowsq4[(size_t)(u.pm * BM + t) * 4 + u.pn] = (p[0] + p[1]) + (p[2] + p[3]); }
    }
};
template <bool DIRECT_RSTD> struct EpiSwiglu {
    static constexpr bool PERM = true, AFTER_DRAIN = false; static constexpr int VMOPS = 12;
    bf16_t* H; int ldh; const float* rs_src; int tile0, nct;
    __device__ __forceinline__ void operator()(const f32x4 (&acc)[2][2][4][2], const Unit& u, int wr, int wc, int fr, int fq) const {
        const int prow0 = u.pm * BM + wr * 64 + fr, orow0 = (u.pm - tile0) * BM + wr * 64 + fr, col0 = (u.pn % nct) * HALF + wc * 32 + 8 * fq;
        float rsv[2][4];
        if (DIRECT_RSTD) {
#pragma unroll
            for (int ai = 0; ai < 2; ++ai)
#pragma unroll
                for (int m = 0; m < 4; ++m) rsv[ai][m] = rs_src[prow0 + ai * HALF + m * 16];
        } else { f32x4 pqv[2][4];
#pragma unroll
            for (int ai = 0; ai < 2; ++ai)
#pragma unroll
                for (int m = 0; m < 4; ++m) pqv[ai][m] = *(const f32x4*)(rs_src + (size_t)(prow0 + ai * HALF + m * 16) * 4);
#pragma unroll
            for (int ai = 0; ai < 2; ++ai)
#pragma unroll
                for (int m = 0; m < 4; ++m) rsv[ai][m] = rstd_of((pqv[ai][m][0] + pqv[ai][m][1]) + (pqv[ai][m][2] + pqv[ai][m][3])); }
#pragma unroll
        for (int ai = 0; ai < 2; ++ai)
#pragma unroll
            for (int m = 0; m < 4; ++m) { const float rs = rsv[ai][m];
                const f32x4 g0 = acc[ai][0][m][0] * rs, g1 = acc[ai][0][m][1] * rs, u0 = acc[ai][1][m][0] * rs, u1 = acc[ai][1][m][1] * rs;
                u32x4 w; w.x = cvt_pk_bf16(silu_f(g0[0]) * u0[0], silu_f(g0[1]) * u0[1]); w.y = cvt_pk_bf16(silu_f(g0[2]) * u0[2], silu_f(g0[3]) * u0[3]);
                w.z = cvt_pk_bf16(silu_f(g1[0]) * u1[0], silu_f(g1[1]) * u1[1]); w.w = cvt_pk_bf16(silu_f(g1[2]) * u1[2], silu_f(g1[3]) * u1[3]);
                *(u32x4*)(H + (size_t)(orow0 + ai * HALF + m * 16) * ldh + col0) = w; }
    }
};
template <bool DIRECT_RSTD> struct EpiSwigluF8 {
    static constexpr bool PERM = true, AFTER_DRAIN = false; static constexpr int VMOPS = 10;
    unsigned char* H; int ldh; const float* rs_src; int tile0, nct; float ws;
    __device__ __forceinline__ void operator()(const f32x4 (&acc)[2][2][4][2], const Unit& u, int wr, int wc, int fr, int fq) const {
        const int prow0 = u.pm * BM + wr * 64 + fr, orow0 = (u.pm - tile0) * BM + wr * 64 + fr, colw = (u.pn % nct) * HALF + wc * 32 + 16 * (fq >> 1);
        float rsv[2][4];
        if (DIRECT_RSTD) {
#pragma unroll
            for (int ai = 0; ai < 2; ++ai)
#pragma unroll
                for (int m = 0; m < 4; ++m) rsv[ai][m] = rs_src[prow0 + ai * HALF + m * 16];
        } else { f32x4 pqv[2][4];
#pragma unroll
            for (int ai = 0; ai < 2; ++ai)
#pragma unroll
                for (int m = 0; m < 4; ++m) pqv[ai][m] = *(const f32x4*)(rs_src + (size_t)(prow0 + ai * HALF + m * 16) * 4);
#pragma unroll
            for (int ai = 0; ai < 2; ++ai)
#pragma unroll
                for (int m = 0; m < 4; ++m) rsv[ai][m] = rstd_of((pqv[ai][m][0] + pqv[ai][m][1]) + (pqv[ai][m][2] + pqv[ai][m][3])); }
#pragma unroll
        for (int ai = 0; ai < 2; ++ai)
#pragma unroll
            for (int mp = 0; mp < 2; ++mp) { unsigned qx[2], qy[2];
#pragma unroll
                for (int mm = 0; mm < 2; ++mm) { const int m = 2 * mp + mm;
                    const float rs = rsv[ai][m] * ws;
                    const f32x4 g0 = acc[ai][0][m][0] * rs, g1 = acc[ai][0][m][1] * rs, u0 = acc[ai][1][m][0] * rs, u1 = acc[ai][1][m][1] * rs;
                    qx[mm] = pk4_fp8(silu_f(g0[0]) * u0[0], silu_f(g0[1]) * u0[1], silu_f(g0[2]) * u0[2], silu_f(g0[3]) * u0[3]);
                    qy[mm] = pk4_fp8(silu_f(g1[0]) * u1[0], silu_f(g1[1]) * u1[1], silu_f(g1[2]) * u1[2], silu_f(g1[3]) * u1[3]); }
                plswap16(qx[0], qx[1]); plswap16(qy[0], qy[1]);
                u32x4 w; w.x = qx[0]; w.y = qy[0]; w.z = qx[1]; w.w = qy[1];
                *(u32x4*)(H + (size_t)(orow0 + ai * HALF + (2 * mp + (fq & 1)) * 16) * ldh + colw) = w; }
    }
};
struct EpiMoeDown {
    static constexpr bool PERM = true, AFTER_DRAIN = false; static constexpr int VMOPS = 8;
    unsigned char* Y0; unsigned char* Y1; const int* slot_tok; const float* slot_gate; int tile0, nct; float ws;
    __device__ __forceinline__ void operator()(const f32x4 (&acc)[2][2][4][2], const Unit& u, int wr, int wc, int fr, int fq) const {
        const int srow0 = (u.pm + tile0) * BM + wr * 64 + fr, colw = (u.pn % nct) * BM + wc * 32 + 16 * (fq >> 1);
        int tkv[2][4]; float gtv[2][4];
#pragma unroll
        for (int ai = 0; ai < 2; ++ai)
#pragma unroll
            for (int m = 0; m < 4; ++m) { tkv[ai][m] = slot_tok[srow0 + ai * HALF + m * 16]; gtv[ai][m] = slot_gate[srow0 + ai * HALF + m * 16]; }
#pragma unroll
        for (int ai = 0; ai < 2; ++ai)
#pragma unroll
            for (int mp = 0; mp < 2; ++mp) { const int tka = tkv[ai][2 * mp], tkb = tkv[ai][2 * mp + 1]; const float gta = gtv[ai][2 * mp] * ws, gtb = gtv[ai][2 * mp + 1] * ws;
                const int tk = (fq & 1) ? tkb : tka; unsigned char* yp = ((tk >> 24) ? Y1 : Y0) + (size_t)(tk & 0xffffff) * 1024 + colw;
#pragma unroll
                for (int bj = 0; bj < 2; ++bj) { const f32x4 a0 = acc[ai][bj][2 * mp][0] * gta, a1 = acc[ai][bj][2 * mp][1] * gta, b0 = acc[ai][bj][2 * mp + 1][0] * gtb, b1 = acc[ai][bj][2 * mp + 1][1] * gtb;
                    unsigned ax = pk4_fp8(a0[0], a0[1], a0[2], a0[3]), ay = pk4_fp8(a1[0], a1[1], a1[2], a1[3]), bx = pk4_fp8(b0[0], b0[1], b0[2], b0[3]), by = pk4_fp8(b1[0], b1[1], b1[2], b1[3]);
                    plswap16(ax, bx); plswap16(ay, by);
                    u32x4 w; w.x = ax; w.y = ay; w.z = bx; w.w = by;
                    if (tk >= 0) *(u32x4*)(yp + bj * HALF) = w; } }
    }
};
struct MoeOrder {
    int nM, nN, nwg, G, c, pm_base, tile0; const PG8_LAS int* tile_e;
    __device__ void init(int nM_, int nN_, int G_, int c_, int pm_base_, int tile0_, const PG8_LAS int* te) { nM = nM_; nN = nN_; nwg = nM * nN; G = G_; c = c_; pm_base = pm_base_; tile0 = tile0_; tile_e = te; }
    __device__ bool next(int i, Unit& u) const { return at((long)i * G + c, u); }
    __device__ bool at(long L, Unit& u) const {
        if (L >= nwg) return false;
        int wgid = (int)L; { const int q = nwg / NXCD, r = nwg % NXCD, xcd = wgid % NXCD, off = wgid / NXCD; wgid = (xcd < r ? xcd * (q + 1) : r * (q + 1) + (xcd - r) * q) + off; }
        const int nig = WGM * nN, gid = wgid / nig, fm = gid * WGM, gsz = (nM - fm) < WGM ? (nM - fm) : WGM;
        const int lm = fm + ((wgid % nig) % gsz), ln = (wgid % nig) / gsz;
        const int e = __builtin_amdgcn_readfirstlane(tile_e[lm]);
        u.pm = pm_base + lm; u.pn = e * nN + ln; return true;
    }
    __device__ __forceinline__ void a_ready(const Unit&) const {}
    __device__ __forceinline__ void done(const Unit&) const {}
    static constexpr bool GATHER = false; __device__ __forceinline__ int arow_raw(const Unit&, int) const { return 0; } __device__ __forceinline__ int arow_fix(int) const { return 0; }
};
struct MoeGatherOrder : MoeOrder {
    static constexpr bool GATHER = true; const int* slot_tok;
    __device__ __forceinline__ int arow_raw(const Unit& u, int r) const { return slot_tok[u.pm * BM + r]; }
    __device__ __forceinline__ int arow_fix(int tk) const { return tk < 0 ? 0 : (tk & 0xffffff); }
};
struct MoeGatherSkipOrder : MoeGatherOrder {
    int rem, skip;
    __device__ bool next(int i, Unit& u) const {
        long L;
        if (c < rem) L = (long)skip * (G - rem) + (long)i * G + c;
        else L = (i < skip) ? (long)i * (G - rem) + (c - rem) : (long)skip * (G - rem) + (long)(i - skip) * G + c;
        return at(L, u);
    }
};
typedef int i32x8 __attribute__((ext_vector_type(8)));
typedef int i32x4 __attribute__((ext_vector_type(4)));
__device__ __forceinline__ void mfma_f8_inplace(f32x4& acc, const i32x8& a, const i32x8& b, int sc) {
    asm volatile("v_mfma_scale_f32_16x16x128_f8f6f4 %0, %1, %2, %0, %3, %3 op_sel_hi:[0,0,0]" : "+v"(acc) : "v"(a), "v"(b), "v"(sc));
}
__device__ __forceinline__ i32x8 cat8(bf16x8 lo, bf16x8 hi) { const i32x4 a = __builtin_bit_cast(i32x4, lo), b = __builtin_bit_cast(i32x4, hi); return (i32x8){a.x, a.y, a.z, a.w, b.x, b.y, b.z, b.w}; }
template <class Epi, class Sched, bool ALIGN_EPI = false, bool SP2 = false, bool F8 = false>
__device__ __forceinline__ void gemm_phase(PG8_LAS unsigned char* lds, const Gemm g, const Sched& S, const Epi& E) {
    int tid_ = threadIdx.x; asm volatile("" : "+v"(tid_));
    const int tid = tid_, wid = __builtin_amdgcn_readfirstlane(tid >> 6), lane = tid & 63, wr = wid >> 2, wc = wid & 3, fr = lane & 15, fq = lane >> 4;
    constexpr int EB = F8 ? 1 : 2;
    const int K = g.K, nt = K * EB / (BK * 2);
    unsigned voffA[2], voffB[2];
#pragma unroll
    for (int i = 0; i < 2; ++i) { int R, C; stage_rc(tid * 16 + i * 8192, R, C); const int Rb = Epi::PERM ? ((R & ~31) + perm32(R & 31)) : R;
        voffA[i] = (unsigned)(R * K * EB + C * 2); voffB[i] = (unsigned)(Rb * K * EB + C * 2); }
    constexpr bool GATHER = Sched::GATHER;
    unsigned gvC[2][2], gvN[2][2], gvNN[2][2];
    int rawN[2][2];
#define PG8_RAW(dst, un) do { _Pragma("unroll") for (int h_ = 0; h_ < 2; ++h_) _Pragma("unroll") for (int i_ = 0; i_ < 2; ++i_) { int R_, C_; stage_rc(tid * 16 + i_ * 8192, R_, C_); dst[h_][i_] = S.arow_raw(un, h_ * HALF + R_); } } while (0)
#define PG8_GVR(dst, raw) do { _Pragma("unroll") for (int h_ = 0; h_ < 2; ++h_) _Pragma("unroll") for (int i_ = 0; i_ < 2; ++i_) { int R_, C_; stage_rc(tid * 16 + i_ * 8192, R_, C_); \
        dst[h_][i_] = (unsigned)S.arow_fix(raw[h_][i_]) * (unsigned)(K * EB) + (unsigned)(C_ * 2); } } while (0)
    const size_t kstep = (size_t)(BK * 2);
    const size_t hstep = (size_t)HALF * K * EB;
    const size_t tstep = 2 * hstep;
    const unsigned ldsw = (unsigned)wid * 1024u;
    const int aoff = lds_byte(wr * 64 + fr, fq * 8), boff = lds_byte(wc * 32 + fr, fq * 8);
#define PG8_SA(b, h) (((b) * 2 + (h)) * HTB)
#define PG8_SB(b, h) ((4 + (b) * 2 + (h)) * HTB)
#define PG8_STAGE(bufoff, gbase, voff) do { _Pragma("unroll") for (int _i = 0; _i < 2; ++_i) \
        __builtin_amdgcn_global_load_lds((const unsigned*)((const char*)(gbase) + (voff)[_i]), (PG8_LAS unsigned*)(lds + (bufoff) + ldsw + _i * 8192), 16, 0, 0); } while (0)
#define PG8_STA(bufoff, ptr, NX, H, KO) do { if constexpr (GATHER) { const unsigned g0_ = (NX) ? gvN[H][0] : gvC[H][0], g1_ = (NX) ? gvN[H][1] : gvC[H][1]; const char* gb_ = (const char*)g.A + (KO); \
        __builtin_amdgcn_global_load_lds((const unsigned*)(gb_ + g0_), (PG8_LAS unsigned*)(lds + (bufoff) + ldsw), 16, 0, 0); \
        __builtin_amdgcn_global_load_lds((const unsigned*)(gb_ + g1_), (PG8_LAS unsigned*)(lds + (bufoff) + ldsw + 8192), 16, 0, 0); } else { PG8_STAGE(bufoff, ptr, voffA); } } while (0)
#define PG8_LDF(dst8, dst, idx, addr) do { if constexpr (F8) { const i32x4 lo_ = *(const PG8_LAS i32x4*)(addr), hi_ = *(const PG8_LAS i32x4*)((addr) + 1024); dst8[idx] = __builtin_shufflevector(lo_, hi_, 0, 1, 2, 3, 4, 5, 6, 7); } \
        else { dst[idx][0] = *(const PG8_LAS bf16x8*)(addr); dst[idx][1] = *(const PG8_LAS bf16x8*)((addr) + 1024); } } while (0)
#define PG8_LDA(dst, b, h) do { _Pragma("unroll") for (int m = 0; m < 4; ++m) PG8_LDF(dst##8, dst, m, lds + PG8_SA(b, h) + aoff + m * 2048); } while (0)
#define PG8_LDB(dst, b, h) do { _Pragma("unroll") for (int n = 0; n < 2; ++n) PG8_LDF(dst##8, dst, n, lds + PG8_SB(b, h) + boff + n * 2048); } while (0)
#define PG8_MMA(ai, bj, At, Bt) do { __builtin_amdgcn_s_setprio(1); if constexpr (F8) { _Pragma("unroll") for (int m = 0; m < 4; ++m) _Pragma("unroll") for (int n = 0; n < 2; ++n) \
        mfma_f8_inplace(acc[ai][bj][m][n], Bt##8[n], At##8[m], one_scale); } else { \
        _Pragma("unroll") for (int m = 0; m < 4; ++m) _Pragma("unroll") for (int n = 0; n < 2; ++n) _Pragma("unroll") for (int k = 0; k < 2; ++k) \
        acc[ai][bj][m][n] = __builtin_amdgcn_mfma_f32_16x16x32_bf16(Bt[n][k], At[m][k], acc[ai][bj][m][n], 0, 0, 0); } __builtin_amdgcn_s_setprio(0); } while (0)
#define PG8_WAIT_V(n) asm volatile("s_waitcnt vmcnt(" #n ")" ::: "memory")
#define PG8_WAIT_L(n) asm volatile("s_waitcnt lgkmcnt(" #n ")" ::: "memory")
#define PG8_BAR __builtin_amdgcn_s_barrier()
#define PG8_SCHED __builtin_amdgcn_sched_barrier(0)
    Unit cur, nxt; int ui = 0;
    if (!S.next(0, cur)) return;
    f32x4 acc[2][2][4][2];
#pragma unroll
    for (int a = 0; a < 2; ++a)
#pragma unroll
        for (int b = 0; b < 2; ++b)
#pragma unroll
            for (int m = 0; m < 4; ++m)
#pragma unroll
                for (int n = 0; n < 2; ++n) acc[a][b][m][n] = (f32x4){0.f, 0.f, 0.f, 0.f};
    int one_scale = 0x7F7F7F7F; asm volatile("" : "+v"(one_scale));
    bf16x8 At[4][2], B0[2][2], B1[2][2]; i32x8 At8[4], B08[2], B18[2];
    const char* cA = (const char*)g.A + (size_t)cur.pm * tstep; const char* cB = (const char*)g.Bt + (size_t)cur.pn * tstep;
    S.a_ready(cur);
    if constexpr (GATHER) { PG8_RAW(rawN, cur); PG8_GVR(gvC, rawN); Unit n1_; if (S.next(1, n1_)) { PG8_RAW(rawN, n1_); } PG8_GVR(gvNN, rawN); }
    if constexpr (SP2) {
        PG8_STAGE(PG8_SB(0, 0), cB, voffB); PG8_STAGE(PG8_SB(0, 1), cB + hstep, voffB); PG8_STA(PG8_SA(0, 0), cA, false, 0, 0); PG8_STA(PG8_SA(0, 1), cA + hstep, false, 1, 0);
        if (wr == 1) PG8_BAR;
        PG8_WAIT_V(2); PG8_BAR;
        PG8_STAGE(PG8_SB(1, 0), cB + kstep, voffB); PG8_STA(PG8_SA(1, 0), cA + kstep, false, 0, kstep); PG8_STAGE(PG8_SB(1, 1), cB + hstep + kstep, voffB);
        PG8_WAIT_V(6); PG8_BAR;
    } else {
        PG8_STAGE(PG8_SB(0, 0), cB, voffB); PG8_STAGE(PG8_SA(0, 0), cA, voffA); PG8_STAGE(PG8_SB(0, 1), cB + hstep, voffB); PG8_STAGE(PG8_SA(0, 1), cA + hstep, voffA);
        if (wr == 1) PG8_BAR;
        PG8_WAIT_V(4); PG8_BAR;
        PG8_STAGE(PG8_SB(1, 0), cB + kstep, voffB); PG8_STAGE(PG8_SA(1, 0), cA + kstep, voffA); PG8_STAGE(PG8_SB(1, 1), cB + hstep + kstep, voffB);
        PG8_WAIT_V(6); PG8_BAR;
    }
    for (;;) {
        const bool has_next = S.next(ui + 1, nxt);
        if constexpr (GATHER) { if (has_next) { _Pragma("unroll") for (int h_ = 0; h_ < 2; ++h_) _Pragma("unroll") for (int i_ = 0; i_ < 2; ++i_) gvN[h_][i_] = gvNN[h_][i_]; }
                                else { _Pragma("unroll") for (int h_ = 0; h_ < 2; ++h_) _Pragma("unroll") for (int i_ = 0; i_ < 2; ++i_) gvN[h_][i_] = gvC[h_][i_]; } }
        const char* nA = has_next ? (const char*)g.A + (size_t)nxt.pm * tstep : cA; const char* nB = has_next ? (const char*)g.Bt + (size_t)nxt.pn * tstep : cB;
#pragma unroll 1
        for (int t = 0; t < nt; t += 2) {
            const bool last = (t == nt - 2);
            const char* a1 = cA + (size_t)(t + 1) * kstep;
            const char* a2 = last ? nA : cA + (size_t)(t + 2) * kstep; const char* b2 = last ? nB : cB + (size_t)(t + 2) * kstep;
            const char* a3 = a2 + kstep; const char* b3 = b2 + kstep; const size_t ko2 = last ? (size_t)0 : (size_t)(t + 2) * kstep; (void)ko2;
            if (last && has_next) S.a_ready(nxt);
            if constexpr (SP2) {
            PG8_LDB(B0, 0, 0); PG8_LDB(B1, 0, 1); PG8_SCHED; PG8_LDA(At, 0, 0); PG8_STA(PG8_SA(1, 1), a1 + hstep, false, 1, (size_t)(t + 1) * kstep);
            const bool relax = (t == 0 && ui > 0);
            if (relax) { asm volatile("s_waitcnt vmcnt(%0)" :: "n"(8 + Epi::VMOPS) : "memory"); } else { PG8_WAIT_V(8); }
            PG8_WAIT_L(0); PG8_BAR; PG8_MMA(0, 0, At, B0); PG8_MMA(0, 1, At, B1); PG8_BAR; PG8_SCHED;
            PG8_LDA(At, 0, 1); PG8_STAGE(PG8_SB(0, 0), b2, voffB); PG8_STAGE(PG8_SB(0, 1), b2 + hstep, voffB); PG8_STA(PG8_SA(0, 0), a2, last, 0, ko2);
            if (relax) { asm volatile("s_waitcnt vmcnt(%0)" :: "n"(8 + Epi::VMOPS) : "memory"); } else { PG8_WAIT_V(8); }
            PG8_WAIT_L(0); PG8_BAR; PG8_MMA(1, 0, At, B0); PG8_MMA(1, 1, At, B1); PG8_BAR; PG8_SCHED;
            PG8_LDB(B0, 1, 0); PG8_LDB(B1, 1, 1); PG8_SCHED; PG8_LDA(At, 1, 0); PG8_STA(PG8_SA(0, 1), a2 + hstep, last, 1, ko2);
            PG8_WAIT_V(8); PG8_WAIT_L(0); PG8_BAR; PG8_MMA(0, 0, At, B0); PG8_MMA(0, 1, At, B1); PG8_BAR; PG8_SCHED;
            PG8_LDA(At, 1, 1); PG8_STAGE(PG8_SB(1, 0), b3, voffB); PG8_STAGE(PG8_SB(1, 1), b3 + hstep, voffB); PG8_STA(PG8_SA(1, 0), a3, last, 0, ko2 + kstep);
            PG8_WAIT_V(8); PG8_WAIT_L(0); PG8_BAR; PG8_MMA(1, 0, At, B0); PG8_MMA(1, 1, At, B1); PG8_BAR; PG8_SCHED;
            } else {
            PG8_LDB(B0, 0, 0); PG8_SCHED; PG8_LDA(At, 0, 0); PG8_STAGE(PG8_SA(1, 1), a1 + hstep, voffA);
            PG8_WAIT_L(8); PG8_BAR; PG8_WAIT_L(0); PG8_MMA(0, 0, At, B0); PG8_BAR; PG8_SCHED;
            PG8_LDB(B1, 0, 1); PG8_STAGE(PG8_SB(0, 0), b2, voffB);
            PG8_BAR; PG8_WAIT_L(0); PG8_MMA(0, 1, At, B1); PG8_BAR;
            PG8_LDA(At, 0, 1); PG8_STAGE(PG8_SA(0, 0), a2, voffA);
            PG8_BAR; PG8_WAIT_L(0); PG8_MMA(1, 0, At, B0); PG8_BAR; PG8_SCHED;
            PG8_STAGE(PG8_SB(0, 1), b2 + hstep, voffB);
            PG8_WAIT_V(6); PG8_BAR; PG8_MMA(1, 1, At, B1); PG8_BAR;
            PG8_LDB(B0, 1, 0); PG8_SCHED; PG8_LDA(At, 1, 0); PG8_STAGE(PG8_SA(0, 1), a2 + hstep, voffA);
            PG8_WAIT_L(8); PG8_BAR; PG8_WAIT_L(0); PG8_MMA(0, 0, At, B0); PG8_BAR; PG8_SCHED;
            PG8_LDB(B1, 1, 1); PG8_STAGE(PG8_SB(1, 0), b3, voffB);
            PG8_BAR; PG8_WAIT_L(0); PG8_MMA(0, 1, At, B1); PG8_BAR;
            PG8_LDA(At, 1, 1); PG8_STAGE(PG8_SA(1, 0), a3, voffA);
            PG8_BAR; PG8_WAIT_L(0); PG8_MMA(1, 0, At, B0); PG8_BAR; PG8_SCHED;
            PG8_STAGE(PG8_SB(1, 1), b3 + hstep, voffB);
            PG8_WAIT_V(6); PG8_BAR; PG8_MMA(1, 1, At, B1); PG8_BAR;
            }
        }
        if constexpr (ALIGN_EPI) { if (wr == 0) PG8_BAR; }
        if constexpr (GATHER) { Unit n2_; if (has_next && S.next(ui + 2, n2_)) { PG8_RAW(rawN, n2_); } }
        if constexpr (F8) { asm volatile("s_nop 15\n\ts_nop 7" ::: "memory"); }
        if constexpr (!Epi::AFTER_DRAIN) { int fr_e = fr, fq_e = fq; asm volatile("" : "+v"(fr_e), "+v"(fq_e)); E(acc, cur, wr, wc, fr_e, fq_e); S.done(cur); }
        if constexpr (GATHER) { PG8_GVR(gvNN, rawN); }
        if (!has_next) break;
#pragma unroll
        for (int a = 0; a < 2; ++a)
#pragma unroll
            for (int b = 0; b < 2; ++b)
#pragma unroll
                for (int m = 0; m < 4; ++m)
#pragma unroll
                    for (int n = 0; n < 2; ++n) acc[a][b][m][n] = (f32x4){0.f, 0.f, 0.f, 0.f};
        cur = nxt; cA = nA; cB = nB; ++ui;
        if constexpr (GATHER) { _Pragma("unroll") for (int h_ = 0; h_ < 2; ++h_) _Pragma("unroll") for (int i_ = 0; i_ < 2; ++i_) gvC[h_][i_] = gvN[h_][i_]; }
        if constexpr (ALIGN_EPI) { if (wr == 1) PG8_BAR; }
    }
    PG8_WAIT_V(0);
    if constexpr (!ALIGN_EPI) { if (wr == 0) PG8_BAR; }
    PG8_BAR;
    if constexpr (Epi::AFTER_DRAIN) { E.fused(acc, cur, wr, wc, fr, fq, lds, wid, lane); S.done(cur); }
#undef PG8_SA
#undef PG8_SB
#undef PG8_STAGE
#undef PG8_STA
#undef PG8_RAW
#undef PG8_GVR
#undef PG8_LDF
#undef PG8_LDA
#undef PG8_LDB
#undef PG8_MMA
#undef PG8_WAIT_V
#undef PG8_WAIT_L
#undef PG8_BAR
#undef PG8_SCHED
}
}

constexpr int NWAVES = 8;
constexpr int BATCH = 8, SEQ = 4096, D = 1024, M = BATCH * SEQ, MEMLEN = 256, MROWS = BATCH * MEMLEN;
constexpr int INCOLS = 2048, FFD = 2816, FFE = 3584, NEXP = 8;
constexpr int NSLOT = 2 * M + NEXP * 256;
constexpr int MAXTILES = NSLOT / 256;
constexpr int NGROUPS = 2, GTILES = 128, GTILES_MAX = 136, MD_SKIP = 3;
constexpr float W8_SCALE = 64.0f;
constexpr float EPS = 1e-6f;
#ifndef MK_ONE_LAUNCH
#define MK_ONE_LAUNCH 0
#endif
constexpr size_t MiB = 1u << 20;
constexpr size_t WS_CTL = 0, CTL_ZERO_BYTES = 64 * 1024;
constexpr size_t WS_RGSUM = 2 * MiB, WS_TOKE = WS_RGSUM + 512 * 1024, WS_TOKW = WS_TOKE + 256 * 1024, WS_TOKP = WS_TOKW + 256 * 1024, WS_TOKR = WS_TOKP + 256 * 1024;
constexpr size_t WS_SLOTT = 3 * MiB + 512 * 1024, WS_SLOTG = 4 * MiB, WS_SLOTR = 4 * MiB + 512 * 1024, WS_TILEE = 5 * MiB, WS_WGCNT = 5 * MiB + 256 * 1024, WS_WVCNT = 5 * MiB + 384 * 1024, WS_MEMSQ = 5 * MiB + 512 * 1024;
constexpr size_t WS_WMGU = 8 * MiB, WS_WMD = 64 * MiB, WS_X8 = 92 * MiB, WS_XB = 176 * MiB;
constexpr size_t WS_WIN = 240 * MiB, WS_WOUT = 248 * MiB, WS_WXQ = 252 * MiB, WS_WKV = 254 * MiB, WS_WXO = 258 * MiB, WS_RGW = 260 * MiB;
constexpr size_t WS_WDGU = 261 * MiB, WS_WDD = 272 * MiB, WS_KVMEM = 278 * MiB, WS_MEMB = 286 * MiB, WS_PROJ = 290 * MiB, WS_MIXED = 418 * MiB;
constexpr size_t WS_RGC = 124 * MiB;
constexpr size_t WS_QXA = 290 * MiB, WS_XO = 322 * MiB, WS_HD = 290 * MiB, WS_HG = 240 * MiB, WS_HGB = 359 * MiB, WS_Y0 = 124 * MiB, WS_Y1 = 471 * MiB, WS_ROWSQ = 504 * MiB, WS_END = 508 * MiB;
static_assert(WS_TOKR + 128 * 1024 <= WS_SLOTT && WS_SLOTT + (size_t)NSLOT * 4 <= WS_SLOTG && WS_SLOTG + (size_t)NSLOT * 4 <= WS_SLOTR && WS_SLOTR + (size_t)NSLOT * 4 <= WS_TILEE, "small map");
static_assert(WS_WMGU + (size_t)NEXP * 2 * FFE * D <= WS_WMD && WS_WMD + (size_t)NEXP * D * FFE <= WS_X8 && WS_X8 + (size_t)M * D <= WS_XB && WS_XB + (size_t)M * D * 2 <= WS_WIN, "map1");
static_assert(WS_WDGU + (size_t)2 * FFD * D * 2 <= WS_WDD && WS_WDD + (size_t)D * FFD * 2 <= WS_KVMEM && WS_KVMEM + (size_t)MROWS * 2048 * 2 <= WS_MEMB && WS_MEMB + (size_t)MROWS * D * 2 <= WS_PROJ, "map2");
static_assert(WS_PROJ + (size_t)M * INCOLS * 2 <= WS_MIXED && WS_MIXED + (size_t)M * D * 2 <= WS_ROWSQ && WS_HD + (size_t)M * FFD * 2 <= WS_ROWSQ && WS_ROWSQ + (size_t)6 * M * 16 <= WS_END, "map3");
static_assert(WS_HG + (size_t)GTILES_MAX * 256 * FFE <= WS_HGB && WS_HGB + (size_t)GTILES * 256 * FFE <= WS_Y1 && WS_X8 + (size_t)M * D <= WS_Y0 && WS_Y0 + (size_t)M * D <= WS_XB && WS_Y1 + (size_t)M * D <= WS_ROWSQ, "map4");
constexpr int CW_TMO = 0, CW_CODE = 1, CW_BAR = 4096;
constexpr int RING_OFF = 0, RING_BYTES = 131072, LDSCTL_OFF = RING_BYTES, MISC_OFF = LDSCTL_OFF + 320, RED_OFF = LDSCTL_OFF + 1024, LDS_BYTES = 147456;

#define GAS __attribute__((address_space(1)))
#define LAS __attribute__((address_space(3)))
typedef unsigned short bf16;
typedef unsigned v4u __attribute__((ext_vector_type(4)));
typedef unsigned v2u __attribute__((ext_vector_type(2)));
typedef float f32x4 __attribute__((ext_vector_type(4)));
typedef GAS unsigned gu32;
#define RLX_AGENT __ATOMIC_RELAXED, __HIP_MEMORY_SCOPE_AGENT
#define LDS_WAIT() asm volatile("s_waitcnt lgkmcnt(0)" ::: "memory")
#define VM_WAIT() asm volatile("s_waitcnt vmcnt(0)" ::: "memory")
__device__ __forceinline__ unsigned f2bf(float f) { unsigned u = __builtin_bit_cast(unsigned, f); return (u + 0x7fffu + ((u >> 16) & 1u)) >> 16; }
__device__ __forceinline__ unsigned pk2(float lo, float hi) { return f2bf(lo) | (f2bf(hi) << 16); }
__device__ __forceinline__ float bf2f(unsigned short h) { return __builtin_bit_cast(float, (unsigned)h << 16); }
__device__ __forceinline__ float bflo(unsigned w) { return __builtin_bit_cast(float, w << 16); }
__device__ __forceinline__ float bfhi(unsigned w) { return __builtin_bit_cast(float, w & 0xffff0000u); }
#define XB_TMO      128
#define XB_XCNT(j)  (256  + 64 * (j))
#define XB_XSUB(j)  (1280 + 64 * (j))
#define XB_XGEN(j)  (2304 + 64 * (j))
#define XB_TOP      3328
#define XB_TOPGEN   3392
#define XCD_BAR_WORDS 3456
#define XB_SPIN_CAP (1u << 18)

__device__ __forceinline__ unsigned xb_ld(unsigned* p)              { return __hip_atomic_load(p, __ATOMIC_RELAXED, __HIP_MEMORY_SCOPE_AGENT); }
__device__ __forceinline__ unsigned xb_add(unsigned* p, unsigned v) { return __hip_atomic_fetch_add(p, v, __ATOMIC_RELAXED, __HIP_MEMORY_SCOPE_AGENT); }
__device__ __forceinline__ unsigned xb_xcc_id() { return (unsigned)__builtin_amdgcn_s_getreg((3 << 11) | 20) & 0xFu; }
#define XB_SPIN(cond, bar) do { unsigned _sp = 0; while (cond) { __builtin_amdgcn_s_sleep(1); \
    if ((++_sp & 255u) == 0u) { if (xb_ld(&(bar)[XB_TMO])) break; if (_sp > XB_SPIN_CAP) { atomicAdd(&(bar)[XB_TMO], 1u); break; } } } } while (0)

struct XcdBarrier {
    unsigned* bar; unsigned x;
    volatile LAS unsigned* st;
};

__device__ __forceinline__ XcdBarrier xcd_barrier_post(unsigned* bar, volatile LAS unsigned* st) {
    XcdBarrier b; b.bar = bar; b.x = xb_xcc_id(); b.st = st;
    if (threadIdx.x == 0) (void)xb_add(&bar[XB_XCNT(b.x)], 1u);
    return b;
}
__device__ __forceinline__ void xcd_barrier_complete(unsigned* bar, unsigned x, unsigned& nloc, unsigned& nx) {
    const unsigned G = gridDim.x * gridDim.y * gridDim.z;
    unsigned sum, cnt, mine, sp = 0u;
    for (;;) {
        sum = 0u; cnt = 0u; mine = 0u;
#pragma unroll
        for (unsigned j = 0; j < 16; ++j) { const unsigned c = xb_ld(&bar[XB_XCNT(j)]); sum += c; cnt += (c > 0u) ? 1u : 0u; mine = (j == x) ? c : mine; }
        if (sum == G) break;
        __builtin_amdgcn_s_sleep(1);
        if ((++sp & 255u) == 0u) { if (xb_ld(&bar[XB_TMO])) break; if (sp > XB_SPIN_CAP) { atomicAdd(&bar[XB_TMO], 1u); break; } }
    }
    nloc = mine > 0u ? mine : 1u; nx = cnt > 0u ? cnt : 1u;
}

__device__ __forceinline__ void xcd_barrier(const XcdBarrier& b) {
    asm volatile("s_waitcnt vmcnt(0)" ::: "memory");
    __syncthreads();
    if (threadIdx.x == 0) {
        unsigned* bar = b.bar;
        __builtin_amdgcn_s_waitcnt(0);
        unsigned nloc = b.st[0], nx = b.st[1];
        if (nloc == 0u) { xcd_barrier_complete(bar, b.x, nloc, nx); b.st[0] = nloc; b.st[1] = nx; }
        const unsigned old = xb_add(&bar[XB_XSUB(b.x)], 1u);
        const unsigned gen = old / nloc;
        if (old + 1u == (gen + 1u) * nloc) {
            __builtin_amdgcn_fence(__ATOMIC_RELEASE, "agent");
            asm volatile("s_waitcnt vmcnt(0)" ::: "memory");
            const unsigned og = xb_add(&bar[XB_TOP], 1u);
            const unsigned tg = og / nx;
            if (og + 1u == (tg + 1u) * nx) xb_add(&bar[XB_TOPGEN], 1u);
            else XB_SPIN(xb_ld(&bar[XB_TOPGEN]) == tg, bar);
            __builtin_amdgcn_fence(__ATOMIC_ACQUIRE, "agent");
            xb_add(&bar[XB_XGEN(b.x)], 1u);
            asm volatile("s_waitcnt vmcnt(0)" ::: "memory");
        } else {
            XB_SPIN(xb_ld(&bar[XB_XGEN(b.x)]) == gen, bar);
            __builtin_amdgcn_fence(__ATOMIC_ACQUIRE, "agent");
            asm volatile("s_waitcnt vmcnt(0)" ::: "memory");
        }
    }
    __syncthreads();
}

typedef float f32x2 __attribute__((ext_vector_type(2)));
struct Args { const float* in[31]; float* out; unsigned char* ws; int ph_lo, ph_hi; };
typedef const volatile __attribute__((address_space(4))) unsigned long long* karg_ptr;
__device__ __forceinline__ unsigned long long ldkarg(int i) { return ((karg_ptr)__builtin_amdgcn_kernarg_segment_ptr())[i]; }
struct KIn { __device__ __forceinline__ const float* operator[](int i) const { return (const float*)(const GAS float*)ldkarg(i); } };
struct KArgs { KIn in; __device__ __forceinline__ unsigned char* ws() const { return (unsigned char*)(GAS unsigned char*)ldkarg(32); } __device__ __forceinline__ float* out() const { return (float*)(GAS float*)ldkarg(31); } };
struct Frame {
    LAS unsigned char* lds;
    int tid, lane, wave, G, bid;
    const float* const* in;
};
__device__ __forceinline__ float wave_sum(float v) {
#pragma unroll
    for (int o = 1; o < 64; o <<= 1) v += __shfl_xor(v, o);
    return v;
}
__device__ __forceinline__ float gelu_tanh(float x) {
    const float y = 0.7978845608028654f * (x + 0.044715f * x * x * x);
    const float e = __expf(2.0f * y);
    const float th = 1.0f - 2.0f * __builtin_amdgcn_rcpf(e + 1.0f);
    return 0.5f * x * (1.0f + th);
}
__device__ __forceinline__ float sigmoid_f(float z) { return __builtin_amdgcn_rcpf(1.0f + __expf(-z)); }

__device__ __forceinline__ void transpose_tile(const float* Wt, int N, bf16* dst, int K, const float* gk, LAS float* scr, int lane) {
    float v[32];
#pragma unroll
    for (int i = 0; i < 32; ++i) v[i] = Wt[(size_t)(2 * i + (lane >> 5)) * N + (lane & 31)];
    if (gk) {
#pragma unroll
        for (int i = 0; i < 32; ++i) v[i] *= gk[2 * i + (lane >> 5)]; }
#pragma unroll
    for (int i = 0; i < 32; ++i) scr[(2 * i + (lane >> 5)) * 33 + (lane & 31)] = v[i];
    LDS_WAIT(); asm volatile("" ::: "memory");
    const int c = lane & 7;
#pragma unroll
    for (int j = 0; j < 4; ++j) { const int n = (lane >> 3) + 8 * j; const LAS float* s = scr + (8 * c) * 33 + n;
        v4u o; o.x = pg8::cvt_pk_bf16(s[0 * 33], s[1 * 33]); o.y = pg8::cvt_pk_bf16(s[2 * 33], s[3 * 33]); o.z = pg8::cvt_pk_bf16(s[4 * 33], s[5 * 33]); o.w = pg8::cvt_pk_bf16(s[6 * 33], s[7 * 33]);
        *(GAS v4u*)(dst + (size_t)n * K + 8 * c) = o; }
    LDS_WAIT(); asm volatile("" ::: "memory");
}
__device__ __forceinline__ void transpose_tile8(const float* Wt, int N, unsigned char* dst, int K, const float* gk, float scl, LAS float* scr, int lane) {
    float v[32];
#pragma unroll
    for (int i = 0; i < 32; ++i) v[i] = Wt[(size_t)(2 * i + (lane >> 5)) * N + (lane & 31)];
#pragma unroll
    for (int i = 0; i < 32; ++i) v[i] *= gk ? gk[2 * i + (lane >> 5)] * scl : scl;
#pragma unroll
    for (int i = 0; i < 32; ++i) scr[(2 * i + (lane >> 5)) * 33 + (lane & 31)] = v[i];
    LDS_WAIT(); asm volatile("" ::: "memory");
    const int c = lane & 7;
#pragma unroll
    for (int j = 0; j < 4; ++j) { const int n = (lane >> 3) + 8 * j; const LAS float* s = scr + (8 * c) * 33 + n;
        v2u o; o.x = pg8::pk4_fp8(s[0 * 33], s[1 * 33], s[2 * 33], s[3 * 33]); o.y = pg8::pk4_fp8(s[4 * 33], s[5 * 33], s[6 * 33], s[7 * 33]);
        *(GAS v2u*)(dst + (size_t)n * K + 8 * c) = o; }
    LDS_WAIT(); asm volatile("" ::: "memory");
}
__device__ __forceinline__ void conv_plain8(const float* W, int K, int N, int sub, unsigned char* WT, int drow0, const float* gain, float scl, LAS float* scr, int lane) {
    const int nblk = N / 32, kb = sub / nblk, nb = sub % nblk;
    transpose_tile8(W + (size_t)(64 * kb) * N + 32 * nb, N, WT + (size_t)(drow0 + 32 * nb) * K + 64 * kb, K, gain ? gain + 64 * kb : nullptr, scl, scr, lane);
}
__device__ __forceinline__ void conv_gu8(const float* W, int K, int N, int sub, unsigned char* WT, int up, const float* gain, float scl, LAS float* scr, int lane) {
    const int nblk = N / 32, kb = sub / nblk, nb = sub % nblk, n0 = 32 * nb, drow = (n0 >> 7) * 256 + (n0 & 127) + up * 128;
    transpose_tile8(W + (size_t)(64 * kb) * N + n0, N, WT + (size_t)drow * K + 64 * kb, K, gain ? gain + 64 * kb : nullptr, scl, scr, lane);
}
__device__ __forceinline__ void conv_plain(const float* W, int K, int N, int sub, bf16* WT, int drow0, const float* gain, LAS float* scr, int lane) {
    const int nblk = N / 32, kb = sub / nblk, nb = sub % nblk;
    transpose_tile(W + (size_t)(64 * kb) * N + 32 * nb, N, WT + (size_t)(drow0 + 32 * nb) * K + 64 * kb, K, gain ? gain + 64 * kb : nullptr, scr, lane);
}
__device__ __forceinline__ void conv_gu(const float* W, int K, int N, int sub, bf16* WT, int up, const float* gain, LAS float* scr, int lane) {
    const int nblk = N / 32, kb = sub / nblk, nb = sub % nblk, n0 = 32 * nb, drow = (n0 >> 7) * 256 + (n0 & 127) + up * 128;
    transpose_tile(W + (size_t)(64 * kb) * N + n0, N, WT + (size_t)drow * K + 64 * kb, K, gain ? gain + 64 * kb : nullptr, scr, lane);
}

struct ConvItem { const float* src; const float* gk; unsigned char* dst; int N, K; float scl; int f8; };
__device__ __forceinline__ void conv_load(const ConvItem& d, float (&v)[64], int lane) {
#pragma unroll
    for (int i = 0; i < 64; ++i) v[i] = d.src[(size_t)i * d.N + lane];
}
__device__ __forceinline__ void conv_finish(const ConvItem& d, float (&v)[64], int lane) {
    if (d.gk) {
#pragma unroll
        for (int i = 0; i < 64; ++i) v[i] *= d.gk[i] * d.scl;
    } else {
#pragma unroll
        for (int i = 0; i < 64; ++i) v[i] *= d.scl;
    }
    if (d.f8) { GAS v4u* o = (GAS v4u*)(d.dst + (size_t)lane * d.K);
#pragma unroll
        for (int c = 0; c < 4; ++c) { v4u w; w.x = pg8::pk4_fp8(v[16 * c], v[16 * c + 1], v[16 * c + 2], v[16 * c + 3]); w.y = pg8::pk4_fp8(v[16 * c + 4], v[16 * c + 5], v[16 * c + 6], v[16 * c + 7]);
            w.z = pg8::pk4_fp8(v[16 * c + 8], v[16 * c + 9], v[16 * c + 10], v[16 * c + 11]); w.w = pg8::pk4_fp8(v[16 * c + 12], v[16 * c + 13], v[16 * c + 14], v[16 * c + 15]); o[c] = w; } }
    else { GAS v4u* o = (GAS v4u*)(d.dst + (size_t)lane * d.K * 2);
#pragma unroll
        for (int c = 0; c < 8; ++c) { v4u w; w.x = pg8::cvt_pk_bf16(v[8 * c], v[8 * c + 1]); w.y = pg8::cvt_pk_bf16(v[8 * c + 2], v[8 * c + 3]); w.z = pg8::cvt_pk_bf16(v[8 * c + 4], v[8 * c + 5]); w.w = pg8::cvt_pk_bf16(v[8 * c + 6], v[8 * c + 7]); o[c] = w; } }
}
constexpr int N_CONV_ITEMS = 26192;
__device__ __forceinline__ ConvItem conv_decode(const KArgs& args, int it) {
    unsigned char* ws = args.ws();
    const float* W; const float* gain = nullptr; unsigned char* WT; int K, N, sub, drow0 = 0, gu = -1, f8 = 0; float scl = 1.0f; int r = it;
    if (r < 1024) { const int l = r >> 9; sub = r & 511; W = args.in[4] + (size_t)l * 1024 * 2048; K = 1024; N = 2048; WT = ws + WS_WIN + (size_t)l * 2048 * 1024 * 2; gain = args.in[3] + l * 1024; }
    else if ((r -= 1024) < 512) { const int l = r >> 8; sub = r & 255; W = args.in[15] + (size_t)l * 1024 * 1024; K = 1024; N = 1024; WT = ws + WS_WOUT + (size_t)l * 1024 * 1024 * 2; }
    else if ((r -= 512) < 256) { const int l = r >> 7; sub = r & 127; W = args.in[18] + (size_t)l * 1024 * 512; K = 1024; N = 512; WT = ws + WS_WXQ + (size_t)l * 512 * 1024; gain = args.in[16] + l * 1024; f8 = 1; scl = W8_SCALE; }
    else if ((r -= 256) < 256) { const int l = r >> 7; sub = r & 127; W = args.in[19] + (size_t)l * 1024 * 512; K = 1024; N = 512; WT = ws + WS_WKV + (size_t)l * 1024 * 1024 * 2; gain = args.in[17] + l * 1024; }
    else if ((r -= 256) < 256) { const int l = r >> 7; sub = r & 127; W = args.in[20] + (size_t)l * 1024 * 512; K = 1024; N = 512; WT = ws + WS_WKV + (size_t)l * 1024 * 1024 * 2; gain = args.in[17] + l * 1024; drow0 = 512; }
    else if ((r -= 256) < 256) { const int l = r >> 7; sub = r & 127; W = args.in[21] + (size_t)l * 512 * 1024; K = 512; N = 1024; WT = ws + WS_WXO + (size_t)l * 1024 * 512; f8 = 1; scl = W8_SCALE; }
    else if ((r -= 256) < 704) { sub = r; W = args.in[23]; K = 1024; N = FFD; WT = ws + WS_WDGU; gain = args.in[22]; gu = 0; }
    else if ((r -= 704) < 704) { sub = r; W = args.in[24]; K = 1024; N = FFD; WT = ws + WS_WDGU; gain = args.in[22]; gu = 1; }
    else if ((r -= 704) < 704) { sub = r; W = args.in[25]; K = FFD; N = 1024; WT = ws + WS_WDD; f8 = 1; scl = W8_SCALE; }
    else if ((r -= 704) < 7168) { const int e = r / 896; sub = r % 896; W = args.in[27] + (size_t)e * 1024 * FFE; K = 1024; N = FFE; WT = ws + WS_WMGU + (size_t)e * 2 * FFE * 1024; gain = args.in[22] + 1024; gu = 0; f8 = 1; scl = W8_SCALE; }
    else if ((r -= 7168) < 7168) { const int e = r / 896; sub = r % 896; W = args.in[28] + (size_t)e * 1024 * FFE; K = 1024; N = FFE; WT = ws + WS_WMGU + (size_t)e * 2 * FFE * 1024; gain = args.in[22] + 1024; gu = 1; f8 = 1; scl = W8_SCALE; }
    else if ((r -= 7168) < 7168) { const int e = r / 896; sub = r % 896; W = args.in[29] + (size_t)e * FFE * 1024; K = FFE; N = 1024; WT = ws + WS_WMD + (size_t)e * 1024 * FFE; f8 = 1; scl = W8_SCALE; }
    else { r -= 7168; const int q = r, l = q >> 3, mat = (q >> 2) & 1, hh = q & 3; sub = 0; W = args.in[mat ? 12 : 10] + (size_t)(l * 4 + hh) * 4096; K = 64; N = 64; WT = ws + WS_RGW + (size_t)q * 4096 * 2; }
    const int nkb = K / 64, kb = sub % nkb, nb = sub / nkb, n0 = 64 * nb;
    const int drow = (gu < 0) ? drow0 + n0 : (n0 >> 7) * 256 + (n0 & 127) + gu * 128;
    ConvItem d; d.src = W + (size_t)(64 * kb) * N + n0; d.gk = gain ? gain + 64 * kb : nullptr; d.dst = WT + ((size_t)drow * K + 64 * kb) * (f8 ? 1 : 2); d.N = N; d.K = K; d.scl = scl; d.f8 = f8;
    return d;
}


typedef short bf16x8v __attribute__((ext_vector_type(8)));
typedef float f32x16 __attribute__((ext_vector_type(16)));
constexpr float LOG2E = 1.4426950408889634f;
__device__ __forceinline__ bf16x8v pack8(const f32x16& p, int b) {
    v4u w; w.x = pg8::cvt_pk_bf16(p[b + 0], p[b + 1]); w.y = pg8::cvt_pk_bf16(p[b + 2], p[b + 3]); w.z = pg8::cvt_pk_bf16(p[b + 4], p[b + 5]); w.w = pg8::cvt_pk_bf16(p[b + 6], p[b + 7]);
    return __builtin_bit_cast(bf16x8v, w);
}
__device__ __forceinline__ void xa_unit_mfma(const KArgs& args, LAS unsigned char* lds, int l, int unit, int tid) {
    asm volatile("" : "+v"(tid));
    const int lane = tid & 63, wave = __builtin_amdgcn_readfirstlane(tid >> 6), r32 = lane & 31, hi = lane >> 5;
    const int b = unit >> 5, hh = (unit >> 3) & 3, tc = unit & 7;
    const bf16* kv = (const bf16*)(args.ws() + WS_KVMEM) + (size_t)(b * 256) * 2048 + l * 1024 + hh * 128;
    const bf16* qxa = (const bf16*)(args.ws() + WS_QXA); unsigned char* xo = (unsigned char*)(args.ws() + WS_XO);
    v4u kq[8], vq[8];
#pragma unroll
    for (int i = 0; i < 8; ++i) { const int piece = tid + 512 * i, r = piece >> 4, c = piece & 15; kq[i] = *(const v4u*)(kv + (size_t)r * 2048 + c * 8); }
#pragma unroll
    for (int i = 0; i < 8; ++i) { const int piece = tid + 512 * i, key = piece & 255, dc = piece >> 8; vq[i] = *(const v4u*)(kv + (size_t)key * 2048 + 512 + dc * 8); }
    asm volatile("" : "+v"(vq[0]), "+v"(vq[1]), "+v"(vq[2]), "+v"(vq[3]), "+v"(vq[4]), "+v"(vq[5]), "+v"(vq[6]), "+v"(vq[7]));
#pragma unroll
    for (int i = 0; i < 8; ++i) { const int piece = tid + 512 * i, r = piece >> 4, c = piece & 15;
        *(LAS v4u*)(lds + r * 256 + ((c ^ (r & 15)) << 4)) = kq[i]; }
#pragma unroll
    for (int i = 0; i < 8; ++i) { const int piece = tid + 512 * i, key = piece & 255, dc = piece >> 8;
        const v4u v = vq[i]; const unsigned w[4] = {v.x, v.y, v.z, v.w};
#pragma unroll
        for (int j = 0; j < 8; ++j) { const int d = dc * 8 + j; const unsigned short val = (unsigned short)((j & 1) ? (w[j >> 1] >> 16) : (w[j >> 1] & 0xffffu));
            *(LAS unsigned short*)(lds + 65536 + d * 512 + (((key >> 2) ^ (d & 31)) << 3) + (key & 3) * 2) = val; } }
    __syncthreads();
    const float sc = 0.08838834764831845f * LOG2E;
    int kb[8], vb[8];
#pragma unroll
    for (int ks = 0; ks < 8; ++ks) kb[ks] = r32 * 256 + (((2 * ks + hi) ^ (r32 & 15)) << 4);
#pragma unroll
    for (int c = 0; c < 8; ++c) vb[c] = 65536 + r32 * 512 + ((((c >> 1) * 8 + (c & 1) * 4 + hi) ^ r32) << 3);
#pragma unroll 1
    for (int qb = 0; qb < 2; ++qb) {
        const size_t tok = (size_t)b * SEQ + tc * 512 + wave * 64 + qb * 32 + r32;
        const bf16* qp = qxa + tok * 512 + hh * 128 + hi * 8;
        f32x16 o[4];
#pragma unroll
        for (int db = 0; db < 4; ++db)
#pragma unroll
            for (int r = 0; r < 16; ++r) o[db][r] = 0.f;
        float mrun = 0.f, sum = 0.f;
#pragma unroll
        for (int pass = 0; pass < 4; ++pass) {
            asm volatile("" ::: "memory");
            bf16x8v qf[8];
#pragma unroll
            for (int ks = 0; ks < 8; ++ks) qf[ks] = *(const bf16x8v*)(qp + ks * 16);
            f32x16 s[2];
#pragma unroll
            for (int k2 = 0; k2 < 2; ++k2) { const int kt = 2 * pass + k2;
#pragma unroll
                for (int r = 0; r < 16; ++r) s[k2][r] = 0.f;
#pragma unroll
                for (int ks = 0; ks < 8; ++ks) { const bf16x8v kf = *(const LAS bf16x8v*)(lds + kb[ks] + kt * 8192); s[k2] = __builtin_amdgcn_mfma_f32_32x32x16_bf16(kf, qf[ks], s[k2], 0, 0, 0); }
            }
            float mx = -3.0e38f;
#pragma unroll
            for (int k2 = 0; k2 < 2; ++k2)
#pragma unroll
                for (int r = 0; r < 16; ++r) mx = fmaxf(mx, s[k2][r]);
            mx = pg8::xor32_max(mx);
            if (pass > 0) {
                if (__any((mx - mrun) * sc > 8.0f)) {
                    const float mn = fmaxf(mrun, mx); const float f = __builtin_amdgcn_exp2f((mrun - mn) * sc); mx = mn; sum *= f;
#pragma unroll
                    for (int db = 0; db < 4; ++db)
#pragma unroll
                        for (int r = 0; r < 16; ++r) o[db][r] *= f;
                } else mx = mrun; }
            mrun = mx;
            const float mb = mx * sc;
            bf16x8v pf[4];
#pragma unroll
            for (int k2 = 0; k2 < 2; ++k2) {
#pragma unroll
                for (int r = 0; r < 16; ++r) { const float p = __builtin_amdgcn_exp2f(s[k2][r] * sc - mb); s[k2][r] = p; sum += p; }
                pf[2 * k2] = pack8(s[k2], 0); pf[2 * k2 + 1] = pack8(s[k2], 8);
            }
#pragma unroll
            for (int k2 = 0; k2 < 2; ++k2)
#pragma unroll
                for (int s2 = 0; s2 < 2; ++s2) {
#pragma unroll
                    for (int db = 0; db < 4; ++db) { const int kt = 2 * pass + k2, c = (kt & 3) * 2 + s2, off = (kt >> 2) * 256 + db * 16384;
                        const v2u lo = *(const LAS v2u*)(lds + vb[c] + off), hi2 = *(const LAS v2u*)(lds + (vb[c] ^ 16) + off);
                        v4u vv; vv.x = lo.x; vv.y = lo.y; vv.z = hi2.x; vv.w = hi2.y;
                        o[db] = __builtin_amdgcn_mfma_f32_32x32x16_bf16(__builtin_bit_cast(bf16x8v, vv), pf[2 * k2 + s2], o[db], 0, 0, 0); } }
        }
        sum = pg8::xor32_sum(sum);
        const float inv = 1.0f / sum; unsigned char* op = xo + tok * 512 + hh * 128 + 16 * hi;
#pragma unroll
        for (int db = 0; db < 4; ++db) {
            unsigned w[4];
#pragma unroll
            for (int g = 0; g < 4; ++g) w[g] = pg8::pk4_fp8(o[db][4 * g] * inv, o[db][4 * g + 1] * inv, o[db][4 * g + 2] * inv, o[db][4 * g + 3] * inv);
            pg8::plswap32(w[0], w[1]); pg8::plswap32(w[2], w[3]);
            pg8::plswap32(w[0], w[2]); pg8::plswap32(w[1], w[3]);
            *(v4u*)(op + db * 32) = (v4u){w[0], w[1], w[2], w[3]}; }
    }
    __syncthreads();
}
__device__ __forceinline__ void swa_unit_mfma(const KArgs& args, LAS unsigned char* lds, int tb_off, int l, int unit, int tid) {
    asm volatile("" : "+v"(tid));
    const int lane = tid & 63, wave = __builtin_amdgcn_readfirstlane(tid >> 6), r32 = lane & 31, hi = lane >> 5;
    const int b = unit >> 5, n = unit & 31; const size_t row0 = (size_t)b * SEQ + (size_t)n * 128;
    const bf16* proj = (const bf16*)(args.ws() + WS_PROJ); bf16* mixed = (bf16*)(args.ws() + WS_MIXED);
    v4u kq[8], vq[8];
#pragma unroll
    for (int i = 0; i < 8; ++i) { const int piece = tid + 512 * i, c = piece & 7, key = (piece >> 3) & 255, kvh = piece >> 11; const bool ok = n > 0 || key >= 128;
        kq[i] = *(const v4u*)(proj + (ok ? row0 - 128 + key : row0) * INCOLS + 512 + kvh * 64 + c * 8); }
#pragma unroll
    for (int i = 0; i < 8; ++i) { const int piece = tid + 512 * i, key = piece & 255, dc = (piece >> 8) & 7, kvh = piece >> 11; const bool ok = n > 0 || key >= 128;
        vq[i] = *(const v4u*)(proj + (ok ? row0 - 128 + key : row0) * INCOLS + 640 + kvh * 64 + dc * 8); }
#pragma unroll
    for (int i = 0; i < 8; ++i) { const int piece = tid + 512 * i, c = piece & 7, key = (piece >> 3) & 255, kvh = piece >> 11;
        v4u v = kq[i]; if (!(n > 0 || key >= 128)) v = (v4u){0u, 0u, 0u, 0u};
        *(LAS v4u*)(lds + kvh * 32768 + key * 128 + ((c ^ ((key >> 1) & 7)) << 4)) = v; }
#pragma unroll
    for (int i = 0; i < 8; ++i) { const int piece = tid + 512 * i, key = piece & 255, dc = (piece >> 8) & 7, kvh = piece >> 11;
        v4u v = vq[i]; if (!(n > 0 || key >= 128)) v = (v4u){0u, 0u, 0u, 0u};
        const unsigned w[4] = {v.x, v.y, v.z, v.w};
#pragma unroll
        for (int j = 0; j < 8; ++j) { const int d = dc * 8 + j; const unsigned short val = (unsigned short)((j & 1) ? (w[j >> 1] >> 16) : (w[j >> 1] & 0xffffu));
            *(LAS unsigned short*)(lds + 65536 + kvh * 32768 + d * 512 + (((key >> 2) ^ (d & 31)) << 3) + (key & 3) * 2) = val; } }
    __syncthreads();
    const int kvh = wave >> 2, hq = wave;
    const float sink2 = args.in[5][l * 8 + hq] * LOG2E;
    const LAS float* T = (const LAS float*)(lds + tb_off) + hq * 192 + (r32 + 160 - 4 * hi);
    const float sc = 0.125f * LOG2E;
    bf16x8v qf[4];
    { const bf16* qp = proj + (row0 + r32) * INCOLS + hq * 64 + hi * 8;
#pragma unroll
      for (int ks = 0; ks < 4; ++ks) qf[ks] = *(const bf16x8v*)(qp + ks * 16); }
#pragma unroll
    for (int j = 0; j < 4; ++j) {
        const size_t tok = row0 + j * 32 + r32;
        f32x16 s[5];
#pragma unroll
        for (int tt = 0; tt < 5; ++tt) {
            const int key = (j + tt) * 32 + r32; const LAS unsigned char* kp = lds + kvh * 32768 + key * 128;
#pragma unroll
            for (int r = 0; r < 16; ++r) s[tt][r] = 0.f;
#pragma unroll
            for (int ks = 0; ks < 4; ++ks) { const bf16x8v kf = *(const LAS bf16x8v*)(kp + (((2 * ks + hi) ^ ((key >> 1) & 7)) << 4)); s[tt] = __builtin_amdgcn_mfma_f32_32x32x16_bf16(kf, qf[ks], s[tt], 0, 0, 0); }
        }
        if (j < 3) { const bf16* qp = proj + (tok + 32) * INCOLS + hq * 64 + hi * 8;
#pragma unroll
            for (int ks = 0; ks < 4; ++ks) qf[ks] = *(const bf16x8v*)(qp + ks * 16); }
        float mx = sink2;
#pragma unroll
        for (int tt = 0; tt < 5; ++tt) { const bool dead = (n == 0) && (j + tt < 4);
#pragma unroll
            for (int r = 0; r < 16; ++r) { float v = s[tt][r] * sc + T[-(32 * tt + (r & 3) + 8 * (r >> 2))]; v = dead ? -1.0e30f : v; s[tt][r] = v; mx = fmaxf(mx, v); } }
        mx = pg8::xor32_max(mx);
        float sum = 0.f;
#pragma unroll
        for (int tt = 0; tt < 5; ++tt)
#pragma unroll
            for (int r = 0; r < 16; ++r) { const float p = __builtin_amdgcn_exp2f(s[tt][r] - mx); s[tt][r] = p; sum += p; }
        sum = pg8::xor32_sum(sum);
        sum += __builtin_amdgcn_exp2f(sink2 - mx);
        f32x16 o[2];
#pragma unroll
        for (int db = 0; db < 2; ++db)
#pragma unroll
            for (int r = 0; r < 16; ++r) o[db][r] = 0.f;
#pragma unroll
        for (int tt = 0; tt < 5; ++tt)
#pragma unroll
            for (int s2 = 0; s2 < 2; ++s2) { const bf16x8v pf = pack8(s[tt], 8 * s2); const int q0 = 8 * (j + tt) + 4 * s2 + hi;
#pragma unroll
                for (int db = 0; db < 2; ++db) { const LAS unsigned char* vp = lds + 65536 + kvh * 32768 + (db * 32 + r32) * 512;
                    const v2u lo = *(const LAS v2u*)(vp + ((q0 ^ r32) << 3)), hi2 = *(const LAS v2u*)(vp + (((q0 + 2) ^ r32) << 3));
                    v4u vv; vv.x = lo.x; vv.y = lo.y; vv.z = hi2.x; vv.w = hi2.y;
                    o[db] = __builtin_amdgcn_mfma_f32_32x32x16_bf16(__builtin_bit_cast(bf16x8v, vv), pf, o[db], 0, 0, 0); } }
        const float inv = 1.0f / sum; bf16* op = mixed + tok * D + hq * 64 + 8 * hi;
#pragma unroll
        for (int db = 0; db < 2; ++db)
#pragma unroll
            for (int g = 0; g < 4; g += 2) { unsigned a0 = pg8::cvt_pk_bf16(o[db][4 * g] * inv, o[db][4 * g + 1] * inv), a1 = pg8::cvt_pk_bf16(o[db][4 * g + 2] * inv, o[db][4 * g + 3] * inv);
                unsigned b0 = pg8::cvt_pk_bf16(o[db][4 * g + 4] * inv, o[db][4 * g + 5] * inv), b1 = pg8::cvt_pk_bf16(o[db][4 * g + 6] * inv, o[db][4 * g + 7] * inv);
                pg8::plswap32(a0, b0); pg8::plswap32(a1, b1);
                *(v4u*)(op + db * 32 + 8 * g) = (v4u){a0, a1, b0, b1}; }
    }
    __syncthreads();
}

__device__ __forceinline__ int rg_sw(int t) { return ((t >> 4) & 1) * 8 + (t & 7); }
__device__ __forceinline__ void rg_conv_to_lds(const KArgs& args, LAS unsigned char* lds, int l, int unit, int tid) {
    const int b = unit >> 5, n = unit & 31, ch = tid & 31, c0 = ch * 8; const size_t row0 = (size_t)b * SEQ + (size_t)n * 128;
    const bf16* proj = (const bf16*)(args.ws() + WS_PROJ);
    float cw[4][8], cb[8];
    { const float* w = args.in[8] + (size_t)l * 4 * 256 + c0; const float* bb = args.in[9] + l * 256 + c0;
#pragma unroll
      for (int k = 0; k < 4; ++k) { const f32x4 a = *(const f32x4*)(w + k * 256), c = *(const f32x4*)(w + k * 256 + 4); cw[k][0] = a[0]; cw[k][1] = a[1]; cw[k][2] = a[2]; cw[k][3] = a[3]; cw[k][4] = c[0]; cw[k][5] = c[1]; cw[k][6] = c[2]; cw[k][7] = c[3]; }
      const f32x4 a = *(const f32x4*)bb, c = *(const f32x4*)(bb + 4); cb[0] = a[0]; cb[1] = a[1]; cb[2] = a[2]; cb[3] = a[3]; cb[4] = c[0]; cb[5] = c[1]; cb[6] = c[2]; cb[7] = c[3]; }
    const int t0 = (tid >> 5) * 8;
    v4u xr[11];
#pragma unroll
    for (int r = 0; r < 11; ++r) { const int tt = t0 - 3 + r; xr[r] = (v4u){0u, 0u, 0u, 0u}; if (n > 0 || tt >= 0) xr[r] = *(const v4u*)(proj + (row0 + tt) * INCOLS + 1536 + c0); }
#pragma unroll
    for (int i = 0; i < 8; ++i) {
        const int t = t0 + i;
        float acc[8];
#pragma unroll
        for (int j = 0; j < 8; ++j) acc[j] = cb[j];
#pragma unroll
        for (int k = 0; k < 4; ++k) { const v4u v = xr[i + k];
            acc[0] += cw[k][0] * bflo(v.x); acc[1] += cw[k][1] * bfhi(v.x); acc[2] += cw[k][2] * bflo(v.y); acc[3] += cw[k][3] * bfhi(v.y);
            acc[4] += cw[k][4] * bflo(v.z); acc[5] += cw[k][5] * bfhi(v.z); acc[6] += cw[k][6] * bflo(v.w); acc[7] += cw[k][7] * bfhi(v.w); }
        v4u o; o.x = pg8::cvt_pk_bf16(acc[0], acc[1]); o.y = pg8::cvt_pk_bf16(acc[2], acc[3]); o.z = pg8::cvt_pk_bf16(acc[4], acc[5]); o.w = pg8::cvt_pk_bf16(acc[6], acc[7]);
        *(LAS v4u*)(lds + t * 512 + ((ch ^ rg_sw(t & 31)) << 4)) = o;
    }
}
template <int PASS> __device__ __forceinline__ void rg_scan_mfma(const KArgs& args, LAS unsigned char* lds, int l, int unit, int tid) {
    const int lane = tid & 63, wave = __builtin_amdgcn_readfirstlane(tid >> 6), r32 = lane & 31, hi = lane >> 5;
    const int hh = wave >> 1, nb = wave & 1, c = hh * 64 + nb * 32 + r32, b = unit >> 5, n = unit & 31; const size_t row0 = (size_t)b * SEQ + (size_t)n * 128;
    const bf16* rgw = (const bf16*)(args.ws() + WS_RGW) + (size_t)(l * 2) * 4 * 4096 + (size_t)hh * 4096 + (size_t)(nb * 32 + r32) * 64 + hi * 8;
    bf16x8v waf[4], wxf[4];
#pragma unroll
    for (int ks = 0; ks < 4; ++ks) { waf[ks] = *(const bf16x8v*)(rgw + ks * 16); wxf[ks] = *(const bf16x8v*)(rgw + 4 * 4096 + ks * 16); }
    const float ba = args.in[11][l * 256 + c], bx = args.in[13][l * 256 + c], lam = args.in[14][l * 256 + c];
    const float c8 = -8.0f * log1pf(expf(-lam)) * LOG2E;
    float* rgsum = (float*)(args.ws() + WS_RGSUM);
    float carry = 0.f, Atot = 1.f;
    if (PASS == 2) { for (int j = 0; j < n; ++j) { const float aj = rgsum[(size_t)(b * 32 + j) * 512 + c], hj = rgsum[(size_t)(b * 32 + j) * 512 + 256 + c]; carry = aj * carry + hj; } }
    const int atok = 16 * ((r32 >> 2) & 1) + (r32 & 3) + 4 * (r32 >> 3);
    const bf16* proj = (const bf16*)(args.ws() + WS_PROJ); bf16* mixed = (bf16*)(args.ws() + WS_MIXED);
#pragma unroll 1
    for (int sc = 0; sc < 4; ++sc) {
        f32x16 rp, ip;
        unsigned short gq[16];
        if (PASS == 2) {
#pragma unroll
            for (int r = 0; r < 16; ++r) gq[r] = proj[(row0 + sc * 32 + 16 * hi + r) * INCOLS + 1792 + c]; }
#pragma unroll
        for (int r = 0; r < 16; ++r) { rp[r] = 0.f; ip[r] = 0.f; }
        { const int t = sc * 32 + atok; const LAS unsigned char* ap = lds + t * 512; const int sw = rg_sw(atok);
#pragma unroll
          for (int ks = 0; ks < 4; ++ks) { const bf16x8v af = *(const LAS bf16x8v*)(ap + (((8 * hh + 2 * ks + hi) ^ sw) << 4));
              rp = __builtin_amdgcn_mfma_f32_32x32x16_bf16(af, waf[ks], rp, 0, 0, 0); ip = __builtin_amdgcn_mfma_f32_32x32x16_bf16(af, wxf[ks], ip, 0, 0, 0); } }
        float hl[16], ac[16]; float hrun = 0.f, arun = 1.f;
#pragma unroll
        for (int r = 0; r < 16; ++r) { const int tl = 16 * hi + r, t = sc * 32 + tl;
            const float xin = bf2f(*(const LAS unsigned short*)(lds + t * 512 + ((((c >> 3)) ^ rg_sw(tl)) << 4) + (c & 7) * 2));
            const float rg = sigmoid_f(rp[r] + ba), ig = sigmoid_f(ip[r] + bx);
            const float a = __builtin_amdgcn_exp2f(c8 * rg);
            const float u = sqrtf(fmaxf(1.0f - a * a, 0.f)) * (ig * xin);
            hrun = a * hrun + u; arun *= a; hl[r] = hrun; ac[r] = arun; }
        const float a_o = pg8::xor32_other(arun, hi), h_o = pg8::xor32_other(hrun, hi);
        const float hin = hi ? (a_o * carry + h_o) : carry;
        const float hend = hl[15] + ac[15] * hin;
        const float hend_hi = __shfl(hend, r32 + 32);
        if (PASS == 1) {
            const float Ag = hi ? Atot * a_o : Atot;
            unsigned* rgc = (unsigned*)(args.ws() + WS_RGC) + (row0 + sc * 32 + 16 * hi) * 256 + c;
#pragma unroll
            for (int r = 0; r < 16; ++r) rgc[r * 256] = pg8::cvt_pk_bf16(hl[r] + ac[r] * hin, ac[r] * Ag);
            Atot *= arun * a_o; }
        if (PASS == 2) {
#pragma unroll
            for (int r = 0; r < 16; ++r) { const size_t row = row0 + sc * 32 + 16 * hi + r; const float h = hl[r] + ac[r] * hin;
                const float g = bf2f(gq[r]); mixed[row * D + 768 + c] = (bf16)f2bf(h * gelu_tanh(g)); } }
        carry = hend_hi;
    }
    if (PASS == 1 && hi == 0) { rgsum[(size_t)unit * 512 + c] = Atot; rgsum[(size_t)unit * 512 + 256 + c] = carry; }
}
__device__ __forceinline__ void sc_conv_vec(const KArgs& args, int l, int unit, int tid) {
    const int b = unit >> 5, n = unit & 31, c0 = (tid & 31) * 8; const size_t row0 = (size_t)b * SEQ + (size_t)n * 128;
    const bf16* proj = (const bf16*)(args.ws() + WS_PROJ); bf16* mixed = (bf16*)(args.ws() + WS_MIXED);
    float cw[3][8], cb[8];
    { const float* w = args.in[6] + (size_t)l * 3 * 256 + c0; const float* bb = args.in[7] + l * 256 + c0;
#pragma unroll
      for (int k = 0; k < 3; ++k) { const f32x4 a = *(const f32x4*)(w + k * 256), c = *(const f32x4*)(w + k * 256 + 4); cw[k][0] = a[0]; cw[k][1] = a[1]; cw[k][2] = a[2]; cw[k][3] = a[3]; cw[k][4] = c[0]; cw[k][5] = c[1]; cw[k][6] = c[2]; cw[k][7] = c[3]; }
      const f32x4 a = *(const f32x4*)bb, c = *(const f32x4*)(bb + 4); cb[0] = a[0]; cb[1] = a[1]; cb[2] = a[2]; cb[3] = a[3]; cb[4] = c[0]; cb[5] = c[1]; cb[6] = c[2]; cb[7] = c[3]; }
    const int t0 = (tid >> 5) * 8;
    v4u cr[10], xr[10], br[8];
#pragma unroll
    for (int r = 0; r < 10; ++r) { const int tt = t0 - 2 + r; cr[r] = (v4u){0u, 0u, 0u, 0u}; xr[r] = cr[r];
        if (n > 0 || tt >= 0) { const bf16* p = proj + (row0 + tt) * INCOLS + 1024 + c0; cr[r] = *(const v4u*)p; xr[r] = *(const v4u*)(p + 256); } }
#pragma unroll
    for (int i = 0; i < 8; ++i) br[i] = *(const v4u*)(proj + (row0 + t0 + i) * INCOLS + 768 + c0);
    float u[10][8];
#pragma unroll
    for (int r = 0; r < 10; ++r) { u[r][0] = bflo(cr[r].x) * bflo(xr[r].x); u[r][1] = bfhi(cr[r].x) * bfhi(xr[r].x); u[r][2] = bflo(cr[r].y) * bflo(xr[r].y); u[r][3] = bfhi(cr[r].y) * bfhi(xr[r].y);
        u[r][4] = bflo(cr[r].z) * bflo(xr[r].z); u[r][5] = bfhi(cr[r].z) * bfhi(xr[r].z); u[r][6] = bflo(cr[r].w) * bflo(xr[r].w); u[r][7] = bfhi(cr[r].w) * bfhi(xr[r].w); }
#pragma unroll
    for (int i = 0; i < 8; ++i) {
        float acc[8];
#pragma unroll
        for (int j = 0; j < 8; ++j) acc[j] = cb[j] + cw[0][j] * u[i][j] + cw[1][j] * u[i + 1][j] + cw[2][j] * u[i + 2][j];
        const v4u vb = br[i];
        v4u o; o.x = pg8::cvt_pk_bf16(acc[0] * bflo(vb.x), acc[1] * bfhi(vb.x)); o.y = pg8::cvt_pk_bf16(acc[2] * bflo(vb.y), acc[3] * bfhi(vb.y));
        o.z = pg8::cvt_pk_bf16(acc[4] * bflo(vb.z), acc[5] * bfhi(vb.z)); o.w = pg8::cvt_pk_bf16(acc[6] * bflo(vb.w), acc[7] * bfhi(vb.w));
        *(v4u*)(mixed + (row0 + t0 + i) * D + 512 + c0) = o;
    }
}
__device__ __forceinline__ void rg_out_vec(const KArgs& args, int l, int unit, int tid) {
    (void)l;
    const int b = unit >> 5, n = unit & 31, c0 = (tid & 31) * 8, t0 = (tid >> 5) * 8; const size_t row0 = (size_t)b * SEQ + (size_t)n * 128;
    const bf16* proj = (const bf16*)(args.ws() + WS_PROJ); bf16* mixed = (bf16*)(args.ws() + WS_MIXED); const unsigned* rgc = (const unsigned*)(args.ws() + WS_RGC);
    v4u q0[8], q1[8], gq[8];
#pragma unroll
    for (int i = 0; i < 8; ++i) { const size_t row = row0 + t0 + i; q0[i] = *(const v4u*)(rgc + row * 256 + c0); q1[i] = *(const v4u*)(rgc + row * 256 + c0 + 4); gq[i] = *(const v4u*)(proj + row * INCOLS + 1792 + c0); }
    float carry[8];
#pragma unroll
    for (int k = 0; k < 8; ++k) carry[k] = 0.f;
    const float* rgsum = (const float*)(args.ws() + WS_RGSUM) + (size_t)(b * 32) * 512 + c0;
#pragma unroll 4
    for (int j = 0; j < n; ++j) { const f32x4 a0 = *(const f32x4*)(rgsum + j * 512), a1 = *(const f32x4*)(rgsum + j * 512 + 4), h0 = *(const f32x4*)(rgsum + j * 512 + 256), h1 = *(const f32x4*)(rgsum + j * 512 + 260);
#pragma unroll
        for (int k = 0; k < 4; ++k) { carry[k] = a0[k] * carry[k] + h0[k]; carry[4 + k] = a1[k] * carry[4 + k] + h1[k]; } }
#pragma unroll
    for (int i = 0; i < 8; ++i) { const unsigned w[8] = {q0[i].x, q0[i].y, q0[i].z, q0[i].w, q1[i].x, q1[i].y, q1[i].z, q1[i].w}; const unsigned gw[4] = {gq[i].x, gq[i].y, gq[i].z, gq[i].w};
        float o[8];
#pragma unroll
        for (int k = 0; k < 8; ++k) { const float g = (k & 1) ? bfhi(gw[k >> 1]) : bflo(gw[k >> 1]); o[k] = (bflo(w[k]) + bfhi(w[k]) * carry[k]) * gelu_tanh(g); }
        v4u ov; ov.x = pg8::cvt_pk_bf16(o[0], o[1]); ov.y = pg8::cvt_pk_bf16(o[2], o[3]); ov.z = pg8::cvt_pk_bf16(o[4], o[5]); ov.w = pg8::cvt_pk_bf16(o[6], o[7]);
        *(v4u*)(mixed + (row0 + t0 + i) * D + 768 + c0) = ov; }
}

constexpr int NPHASES = 24;
__global__ void __launch_bounds__(NWAVES * 64, 2) hymba_fwd(Args kernarg_block) {
    KArgs args; int lo, hi; { const unsigned long long pp = ldkarg(33); lo = (int)(unsigned)pp; hi = (int)(unsigned)(pp >> 32); }
    extern __shared__ __attribute__((aligned(16))) unsigned char lds_raw[];
    LAS unsigned char* lds = (LAS unsigned char*)lds_raw;
    volatile LAS unsigned* MISC = (volatile LAS unsigned*)(lds + MISC_OFF);
    const int G = gridDim.x, bid = blockIdx.x;
#define ws (args.ws())
#define xres (args.out())
#define rowsq ((float*)(ws + WS_ROWSQ))
#define xb ((bf16*)(ws + WS_XB))
    gu32* ctl = (gu32*)(ws + WS_CTL);
    for (int u = threadIdx.x; u < (LDS_BYTES - LDSCTL_OFF) / 4; u += NWAVES * 64) ((LAS unsigned*)(lds + LDSCTL_OFF))[u] = 0u;
    __syncthreads();
#if MK_ONE_LAUNCH
    XcdBarrier bar = xcd_barrier_post((unsigned*)(ctl + CW_BAR), MISC + 8);
#define GRID_BAR() xcd_barrier(bar)
#else
    (void)MISC;
#define GRID_BAR() do { } while (0)
#endif
    int ph = 0;
#define PHASE_BEGIN if (lo <= ph && ph < hi) { int tid_p = threadIdx.x; asm volatile("" : "+v"(tid_p)); const int tid = tid_p, lane = tid & 63, wave = __builtin_amdgcn_readfirstlane(tid >> 6); (void)lane; (void)wave;
#define PHASE_END if (ph + 1 < hi) { GRID_BAR(); } else { VM_WAIT(); __syncthreads(); } } ++ph;

    PHASE_BEGIN
    {
        const int gw = bid * NWAVES + wave, NGW = G * NWAVES;
        if (gw < N_CONV_ITEMS) {
            ConvItem d0 = conv_decode(args, gw); float va[64]; conv_load(d0, va, lane);
#pragma unroll 1
            for (int it = gw; it < N_CONV_ITEMS; it += NGW) {
                const int itn = it + NGW; const bool hn = itn < N_CONV_ITEMS;
                ConvItem d1 = d0; float vb[64];
                if (hn) { d1 = conv_decode(args, itn); conv_load(d1, vb, lane); }
                conv_finish(d0, va, lane);
                if (hn) {
#pragma unroll
                    for (int i = 0; i < 64; ++i) va[i] = vb[i];
                    d0 = d1; }
            }
        }
        float* memsq = (float*)(ws + WS_MEMSQ); bf16* memb = (bf16*)(ws + WS_MEMB);
        for (int m0 = gw; m0 < M + MROWS; m0 += 2 * NGW) {
            f32x4 v[2][4]; bool ok[2]; int mm[2]; bool isx[2];
#pragma unroll
            for (int u = 0; u < 2; ++u) { const int m = m0 + u * NGW; ok[u] = m < M + MROWS; isx[u] = m < M; mm[u] = isx[u] ? m : m - M;
                if (ok[u]) { const GAS f32x4* src = (const GAS f32x4*)((isx[u] ? args.in[0] : args.in[1]) + (size_t)mm[u] * D) + lane;
#pragma unroll
                    for (int j = 0; j < 4; ++j) v[u][j] = src[64 * j]; } }
#pragma unroll
            for (int u = 0; u < 2; ++u) if (ok[u]) { float s = 0.f;
#pragma unroll
                for (int j = 0; j < 4; ++j) s += (v[u][j].x * v[u][j].x + v[u][j].y * v[u][j].y) + (v[u][j].z * v[u][j].z + v[u][j].w * v[u][j].w);
                s = wave_sum(s);
                if (lane == 0) { *(f32x4*)((isx[u] ? rowsq : memsq) + (size_t)mm[u] * 4) = (f32x4){s, 0.f, 0.f, 0.f}; }
                GAS v2u* o8 = (GAS v2u*)((isx[u] ? xb : memb) + (size_t)mm[u] * D) + lane;
#pragma unroll
                for (int j = 0; j < 4; ++j) { v2u w; w.x = pg8::cvt_pk_bf16(v[u][j].x, v[u][j].y); w.y = pg8::cvt_pk_bf16(v[u][j].z, v[u][j].w); o8[64 * j] = w; } }
        }
    }
    PHASE_END

    {
        constexpr int l = 0;
        PHASE_BEGIN
        {
            pg8::Gemm g{xb, (const bf16*)(ws + WS_WIN) + (size_t)l * 2048 * 1024, M, INCOLS, 1024}; pg8::StaticOrder S; S.init(M, INCOLS, G, bid);
            pg8::EpiScaleBf16 E{(bf16*)(ws + WS_PROJ), INCOLS, rowsq + (size_t)(3 * l) * M * 4, 1.0f};
            pg8::gemm_phase<pg8::EpiScaleBf16, pg8::StaticOrder, true, true>(lds + RING_OFF, g, S, E);
        }
        PHASE_END
        PHASE_BEGIN
        {
            int u0 = bid, ustep = G;
            if (l == 0) {
                const int nkv = (G >= 128) ? 64 : G;
                if (bid < nkv) {
                    pg8::Gemm g{(const bf16*)(ws + WS_MEMB), (const bf16*)(ws + WS_WKV), MROWS, 2048, 1024}; pg8::StaticOrder S; S.init(MROWS, 2048, nkv, bid);
                    pg8::EpiScaleBf16 E{(bf16*)(ws + WS_KVMEM), 2048, (const float*)(ws + WS_MEMSQ), 1.0f};
                    pg8::gemm_phase<pg8::EpiScaleBf16, pg8::StaticOrder, true, true>(lds + RING_OFF, g, S, E);
                    __syncthreads();
                }
                if (G >= 128) { u0 = (bid < nkv) ? 256 : bid - nkv; ustep = G - nkv; }
            }
            for (int unit = u0; unit < 256; unit += ustep) {
                { int t0 = threadIdx.x; asm volatile("" : "+v"(t0)); rg_conv_to_lds(args, lds, l, unit, t0); }
                __syncthreads();
                { int t1 = threadIdx.x; asm volatile("" : "+v"(t1)); rg_scan_mfma<1>(args, lds, l, unit, t1); }
                __syncthreads();
            }
        }
        PHASE_END
        PHASE_BEGIN
        {
            constexpr int TB_OFF = LDSCTL_OFF + 6144;
            if (tid < 192) { const int dist = tid - 32; int bk = dist;
                if (dist >= 16) { const float v = logf((float)dist / 16.0f) / logf(8.0f) * 16.0f; bk = 16 + (int)v; if (bk > 31) bk = 31; }
                const bool ok = dist >= 0 && dist < 128;
                const float* bp = args.in[2] + (ok ? bk : 0) * 8; const f32x4 b0 = *(const f32x4*)bp, b1 = *(const f32x4*)(bp + 4);
                const float bv[8] = {b0[0], b0[1], b0[2], b0[3], b1[0], b1[1], b1[2], b1[3]};
#pragma unroll
                for (int h = 0; h < 8; ++h) ((LAS float*)(lds + TB_OFF))[h * 192 + tid] = ok ? bv[h] * LOG2E : -1.0e30f; }
            __syncthreads();
            for (int unit = bid; unit < 256; unit += G) {
                { int t1 = threadIdx.x; asm volatile("" : "+v"(t1)); rg_out_vec(args, l, unit, t1); }
                { int t3 = threadIdx.x; asm volatile("" : "+v"(t3)); sc_conv_vec(args, l, unit, t3); }
                { int t2 = threadIdx.x; asm volatile("" : "+v"(t2)); swa_unit_mfma(args, lds, TB_OFF, l, unit, t2); }
            }
        }
        PHASE_END
        PHASE_BEGIN
        {
            pg8::Gemm g{(const bf16*)(ws + WS_MIXED), (const bf16*)(ws + WS_WOUT) + (size_t)l * 1024 * 1024, M, D, 1024}; pg8::StaticOrder S; S.init(M, D, G, bid);
            pg8::EpiResid E{xb, rowsq + (size_t)(3 * l + 1) * M * 4, (LAS float*)(lds + RED_OFF), (unsigned char*)(ws + WS_X8), 1.0f};
            pg8::gemm_phase<pg8::EpiResid, pg8::StaticOrder, true, true>(lds + RING_OFF, g, S, E);
        }
        PHASE_END
        PHASE_BEGIN
        {
            pg8::Gemm g{(const bf16*)(ws + WS_X8), (const bf16*)(ws + WS_WXQ + (size_t)l * 512 * 1024), M, 512, 1024}; pg8::StaticOrder S; S.init(M, 512, G, bid);
            pg8::EpiScaleBf16 E{(bf16*)(ws + WS_QXA), 512, rowsq + (size_t)(3 * l + 1) * M * 4, 1.0f / W8_SCALE};
            pg8::gemm_phase<pg8::EpiScaleBf16, pg8::StaticOrder, true, true, true>(lds + RING_OFF, g, S, E);
        }
        PHASE_END
        PHASE_BEGIN
        {
            for (int unit = bid; unit < 256; unit += G) xa_unit_mfma(args, lds, l, unit, tid);
        }
        PHASE_END
        PHASE_BEGIN
        {
            pg8::Gemm g{(const bf16*)(ws + WS_XO), (const bf16*)(ws + WS_WXO + (size_t)l * 1024 * 512), M, D, 512}; pg8::StaticOrder S; S.init(M, D, G, bid);
            pg8::EpiResid E{xb, rowsq + (size_t)(3 * l + 2) * M * 4, (LAS float*)(lds + RED_OFF), l == 1 ? (unsigned char*)(ws + WS_X8) : nullptr, 1.0f / W8_SCALE};
            pg8::gemm_phase<pg8::EpiResid, pg8::StaticOrder, true, true, true>(lds + RING_OFF, g, S, E);
        }
        PHASE_END
        if (l == 0) {
            PHASE_BEGIN
            {
                pg8::Gemm g{xb, (const bf16*)(ws + WS_WDGU), M, 2 * FFD, 1024}; pg8::StaticOrder S; S.init(M, 2 * FFD, G, bid);
                pg8::EpiSwigluF8<false> E{(unsigned char*)(ws + WS_HD), FFD, rowsq + (size_t)2 * M * 4, 0, 2 * FFD / 256, 1.0f};
                pg8::gemm_phase<pg8::EpiSwigluF8<false>, pg8::StaticOrder, true, true>(lds + RING_OFF, g, S, E);
            }
            PHASE_END
            PHASE_BEGIN
            {
                pg8::Gemm g{(const bf16*)(ws + WS_HD), (const bf16*)(ws + WS_WDD), M, D, FFD}; pg8::StaticOrder S; S.init(M, D, G, bid);
                pg8::EpiResid E{xb, rowsq + (size_t)3 * M * 4, (LAS float*)(lds + RED_OFF), nullptr, 1.0f / W8_SCALE};
                pg8::gemm_phase<pg8::EpiResid, pg8::StaticOrder, true, true, true>(lds + RING_OFF, g, S, E);
            }
            PHASE_END
        } else {
            int* tok_e = (int*)(ws + WS_TOKE); float* tok_w = (float*)(ws + WS_TOKW); int* tok_p = (int*)(ws + WS_TOKP); float* tok_r = (float*)(ws + WS_TOKR);
            int* slot_tok = (int*)(ws + WS_SLOTT); float* slot_gate = (float*)(ws + WS_SLOTG); float* slot_rstd = (float*)(ws + WS_SLOTR);
            int* tile_e = (int*)(ws + WS_TILEE); int* wgcnt = (int*)(ws + WS_WGCNT); int* wvbase = (int*)(ws + WS_WVCNT);
            PHASE_BEGIN
            {
                LAS unsigned char* Rt = lds;
                LAS float* Dl = (LAS float*)(lds + 32768);
                LAS int* wcnt = (LAS int*)(lds + 32768 + 8192);
                { const float* rp = args.in[26]; const float* gp = args.in[22] + 1024;
#pragma unroll
                  for (int i = 0; i < 16; ++i) { const int q = tid + i * NWAVES * 64, k = q >> 3, e = q & 7; const float v = rp[q] * gp[k];
                      const unsigned hb = f2bf(v); const unsigned lb = f2bf(v - __builtin_bit_cast(float, hb << 16));
                      *(LAS unsigned short*)(Rt + e * 2048 + (((k >> 3) ^ e) << 4) + (k & 7) * 2) = (unsigned short)hb;
                      *(LAS unsigned short*)(Rt + (8 + e) * 2048 + (((k >> 3) ^ (8 + e)) << 4) + (k & 7) * 2) = (unsigned short)lb; } }
                for (int tb = bid; tb < 256; tb += G) {
                    __syncthreads();
                    if (tid < 64) wcnt[tid] = 0;
                    __syncthreads();
                    if (wave < 4) {
                        const int r32 = lane & 31, hi = lane >> 5; const int t = tb * 128 + wave * 32 + r32;
                        const bf16* xp = xb + (size_t)t * D + hi * 8;
                        f32x16 acc;
#pragma unroll
                        for (int r = 0; r < 16; ++r) acc[r] = 0.f;
#pragma unroll 1
                        for (int ks0 = 0; ks0 < 64; ks0 += 8) {
                            bf16x8v a[8];
#pragma unroll
                            for (int j = 0; j < 8; ++j) a[j] = *(const bf16x8v*)(xp + (ks0 + j) * 16);
#pragma unroll
                            for (int j = 0; j < 8; ++j) { const int ks = ks0 + j; v4u bz = (v4u){0u, 0u, 0u, 0u};
                                if (r32 < 16) bz = *(const LAS v4u*)(Rt + r32 * 2048 + (((2 * ks + hi) ^ r32) << 4));
                                acc = __builtin_amdgcn_mfma_f32_32x32x16_bf16(a[j], __builtin_bit_cast(bf16x8v, bz), acc, 0, 0, 0); }
                        }
                        LAS float* dw = Dl + wave * 512;
                        if (r32 < 16) {
#pragma unroll
                            for (int r = 0; r < 16; ++r) dw[((r & 3) + 8 * (r >> 2) + 4 * hi) * 16 + r32] = acc[r]; }
                        LDS_WAIT();
                        int e1 = -1, e2 = -1; float w1 = 0.f, w2 = 0.f, rs = 0.f;
                        if (lane < 32) {
                            const f32x4 pq = *(const f32x4*)(rowsq + ((size_t)5 * M + t) * 4);
                            rs = pg8::rstd_of((pq[0] + pq[1]) + (pq[2] + pq[3]));
                            float lg[8];
#pragma unroll
                            for (int e = 0; e < 8; ++e) lg[e] = (dw[lane * 16 + e] + dw[lane * 16 + 8 + e]) * rs;
                            e1 = 0; float l1 = lg[0];
#pragma unroll
                            for (int e = 1; e < 8; ++e) if (lg[e] > l1) { l1 = lg[e]; e1 = e; }
                            float l2 = -3.0e38f;
#pragma unroll
                            for (int e = 0; e < 8; ++e) if (e != e1 && lg[e] > l2) { l2 = lg[e]; e2 = e; }
                            w2 = 1.0f / (1.0f + expf(l1 - l2)); w1 = 1.0f - w2;
                        }
                        int p1 = 0, p2 = 0, cnt_e = 0;
#pragma unroll
                        for (int e = 0; e < 8; ++e) { const unsigned long long m = __ballot((e1 == e) || (e2 == e)); const int rk = __popcll(m & ((1ull << lane) - 1ull));
                            if (e1 == e) p1 = rk; if (e2 == e) p2 = rk; if (lane == e) cnt_e = __popcll(m); }
                        if (lane < 8) wcnt[wave * 8 + lane] = cnt_e;
                        if (lane < 32) { tok_e[2 * t] = e1; tok_e[2 * t + 1] = e2; tok_w[2 * t] = w1; tok_w[2 * t + 1] = w2; tok_p[2 * t] = p1; tok_p[2 * t + 1] = p2; tok_r[t] = rs; }
                    }
                    __syncthreads();
                    if (tid < 8) { int s = 0; for (int w = 0; w < 8; ++w) { const int c = wcnt[w * 8 + tid]; wvbase[(tb * 8 + w) * 8 + tid] = s; s += c; } wgcnt[tb * 8 + tid] = s; }
                }
            }
            PHASE_END
            PHASE_BEGIN
            {
                LAS int* tot = (LAS int*)lds; LAS int* offs = (LAS int*)(lds + 64); LAS int* base = (LAS int*)(lds + 128);
                LAS int* cl = (LAS int*)(lds + 1024);
                LAS int* ps = (LAS int*)(lds + 1024 + 8192);
                LAS int* pb = (LAS int*)(lds + 1024 + 8192 + 2048);
                for (int i = tid; i < 2048; i += NWAVES * 64) cl[i] = wgcnt[i];
                __syncthreads();
                for (int tb = bid; tb < 256; tb += G) {
                    { const int e = tid & 7, part = tid >> 3; int s = 0, sb = 0;
#pragma unroll
                      for (int j = 0; j < 4; ++j) { const int w = part * 4 + j; const int c = cl[w * 8 + e]; s += c; sb += (w < tb) ? c : 0; }
                      ps[tid] = s; pb[tid] = sb; }
                    __syncthreads();
                    if (tid < 8) { int s = 0, sb = 0;
#pragma unroll 8
                        for (int part = 0; part < 64; ++part) { s += ps[part * 8 + tid]; sb += pb[part * 8 + tid]; }
                        tot[tid] = s; base[tid] = sb; }
                    __syncthreads();
                    if (tid == 0) { int o = 0; for (int e = 0; e < 8; ++e) { offs[e] = o; o += (tot[e] + 255) & ~255; } offs[8] = o; }
                    __syncthreads();
                    if (tb == 0) {
                        if (tid == 0) { int nt = 0; for (int e = 0; e < 8; ++e) { const int k = (offs[e + 1] - offs[e]) >> 8; for (int j = 0; j < k; ++j) tile_e[nt++] = e; } tile_e[300] = nt; }
                        for (int e = 0; e < 8; ++e) for (int s = offs[e] + tot[e] + tid; s < offs[e + 1]; s += NWAVES * 64) slot_tok[s] = -1;
                    }
                    if (tid < 256) {
                        const int p = tid, t = tb * 128 + (p >> 1), k = p & 1;
                        const int e = tok_e[2 * t + k]; const int slot = offs[e] + base[e] + wvbase[(tb * 8 + (p >> 6)) * 8 + e] + tok_p[2 * t + k];
                        slot_tok[slot] = t | (k << 24); slot_gate[slot] = tok_w[2 * t + k]; slot_rstd[slot] = tok_r[t];
                    }
                    __syncthreads();
                }
            }
            PHASE_END
            PHASE_BEGIN
            {
                const int nt = __builtin_amdgcn_readfirstlane(__hip_atomic_load(tile_e + 300, RLX_AGENT)); const int ntA = nt - GTILES;
                LAS int* te_lds = (LAS int*)(lds + LDSCTL_OFF + 6144);
                for (int i = tid; i < nt; i += NWAVES * 64) te_lds[i] = __hip_atomic_load(tile_e + i, RLX_AGENT);
                __syncthreads();
                pg8::Gemm g{(const bf16*)(ws + WS_X8), (const bf16*)(ws + WS_WMGU), 0, 0, 1024}; pg8::MoeGatherOrder S; S.init(ntA, 2 * FFE / 256, G, bid, 0, 0, te_lds); S.slot_tok = slot_tok;
                pg8::EpiSwigluF8<true> E{(unsigned char*)(ws + WS_HG), FFE, slot_rstd, 0, 2 * FFE / 256, 1.0f / W8_SCALE};
                pg8::gemm_phase<pg8::EpiSwigluF8<true>, pg8::MoeGatherOrder, true, true, true>(lds + RING_OFF, g, S, E);
            }
            PHASE_END
            PHASE_BEGIN
            {
                const int nt = __builtin_amdgcn_readfirstlane(__hip_atomic_load(tile_e + 300, RLX_AGENT)); const int ntA = nt - GTILES;
                LAS int* te_lds = (LAS int*)(lds + LDSCTL_OFF + 6144);
                for (int i = tid; i < nt; i += NWAVES * 64) te_lds[i] = __hip_atomic_load(tile_e + i, RLX_AGENT);
                __syncthreads();
                {
                    pg8::Gemm g{(const bf16*)(ws + WS_HG), (const bf16*)(ws + WS_WMD), 0, 0, FFE}; pg8::MoeOrder S; S.init(ntA, D / 256, G, bid, 0, 0, te_lds);
                    pg8::EpiMoeDown E{(unsigned char*)(ws + WS_Y0), (unsigned char*)(ws + WS_Y1), slot_tok, slot_gate, 0, D / 256, 1.0f / W8_SCALE};
                    pg8::gemm_phase<pg8::EpiMoeDown, pg8::MoeOrder, true, true, true>(lds + RING_OFF, g, S, E);
                }
                __syncthreads();
                {
                    const int nmd = ntA * (D / 256);
                    pg8::Gemm g{(const bf16*)(ws + WS_X8), (const bf16*)(ws + WS_WMGU), 0, 0, 1024}; pg8::MoeGatherSkipOrder S; S.init(GTILES, 2 * FFE / 256, G, bid, ntA, ntA, te_lds + ntA); S.slot_tok = slot_tok;
                    S.rem = nmd % G; S.skip = (S.rem == 0) ? 0 : MD_SKIP;
                    pg8::EpiSwigluF8<true> E{(unsigned char*)(ws + WS_HGB), FFE, slot_rstd, ntA, 2 * FFE / 256, 1.0f / W8_SCALE};
                    pg8::gemm_phase<pg8::EpiSwigluF8<true>, pg8::MoeGatherSkipOrder, true, true, true>(lds + RING_OFF, g, S, E);
                }
            }
            PHASE_END
            PHASE_BEGIN
            {
                const int nt = __builtin_amdgcn_readfirstlane(__hip_atomic_load(tile_e + 300, RLX_AGENT)); const int ntA = nt - GTILES;
                LAS int* te_lds = (LAS int*)(lds + LDSCTL_OFF + 6144);
                for (int i = tid; i < nt; i += NWAVES * 64) te_lds[i] = __hip_atomic_load(tile_e + i, RLX_AGENT);
                __syncthreads();
                pg8::Gemm g{(const bf16*)(ws + WS_HGB), (const bf16*)(ws + WS_WMD), 0, 0, FFE}; pg8::MoeOrder S; S.init(GTILES, D / 256, G, bid, 0, ntA, te_lds + ntA);
                pg8::EpiMoeDown E{(unsigned char*)(ws + WS_Y0), (unsigned char*)(ws + WS_Y1), slot_tok, slot_gate, ntA, D / 256, 1.0f / W8_SCALE};
                pg8::gemm_phase<pg8::EpiMoeDown, pg8::MoeOrder, true, true, true>(lds + RING_OFF, g, S, E);
            }
            PHASE_END
        }
    }
    {
        constexpr int l = 1;
        PHASE_BEGIN
        {
            pg8::Gemm g{xb, (const bf16*)(ws + WS_WIN) + (size_t)l * 2048 * 1024, M, INCOLS, 1024}; pg8::StaticOrder S; S.init(M, INCOLS, G, bid);
            pg8::EpiScaleBf16 E{(bf16*)(ws + WS_PROJ), INCOLS, rowsq + (size_t)(3 * l) * M * 4, 1.0f};
            pg8::gemm_phase<pg8::EpiScaleBf16, pg8::StaticOrder, true, true>(lds + RING_OFF, g, S, E);
        }
        PHASE_END
        PHASE_BEGIN
        {
            int u0 = bid, ustep = G;
            if (l == 0) {
                const int nkv = (G >= 128) ? 64 : G;
                if (bid < nkv) {
                    pg8::Gemm g{(const bf16*)(ws + WS_MEMB), (const bf16*)(ws + WS_WKV), MROWS, 2048, 1024}; pg8::StaticOrder S; S.init(MROWS, 2048, nkv, bid);
                    pg8::EpiScaleBf16 E{(bf16*)(ws + WS_KVMEM), 2048, (const float*)(ws + WS_MEMSQ), 1.0f};
                    pg8::gemm_phase<pg8::EpiScaleBf16, pg8::StaticOrder, true, true>(lds + RING_OFF, g, S, E);
                    __syncthreads();
                }
                if (G >= 128) { u0 = (bid < nkv) ? 256 : bid - nkv; ustep = G - nkv; }
            }
            for (int unit = u0; unit < 256; unit += ustep) {
                { int t0 = threadIdx.x; asm volatile("" : "+v"(t0)); rg_conv_to_lds(args, lds, l, unit, t0); }
                __syncthreads();
                { int t1 = threadIdx.x; asm volatile("" : "+v"(t1)); rg_scan_mfma<1>(args, lds, l, unit, t1); }
                __syncthreads();
            }
        }
        PHASE_END
        PHASE_BEGIN
        {
            constexpr int TB_OFF = LDSCTL_OFF + 6144;
            if (tid < 192) { const int dist = tid - 32; int bk = dist;
                if (dist >= 16) { const float v = logf((float)dist / 16.0f) / logf(8.0f) * 16.0f; bk = 16 + (int)v; if (bk > 31) bk = 31; }
                const bool ok = dist >= 0 && dist < 128;
                const float* bp = args.in[2] + (ok ? bk : 0) * 8; const f32x4 b0 = *(const f32x4*)bp, b1 = *(const f32x4*)(bp + 4);
                const float bv[8] = {b0[0], b0[1], b0[2], b0[3], b1[0], b1[1], b1[2], b1[3]};
#pragma unroll
                for (int h = 0; h < 8; ++h) ((LAS float*)(lds + TB_OFF))[h * 192 + tid] = ok ? bv[h] * LOG2E : -1.0e30f; }
            __syncthreads();
            for (int unit = bid; unit < 256; unit += G) {
                { int t1 = threadIdx.x; asm volatile("" : "+v"(t1)); rg_out_vec(args, l, unit, t1); }
                { int t3 = threadIdx.x; asm volatile("" : "+v"(t3)); sc_conv_vec(args, l, unit, t3); }
                { int t2 = threadIdx.x; asm volatile("" : "+v"(t2)); swa_unit_mfma(args, lds, TB_OFF, l, unit, t2); }
            }
        }
        PHASE_END
        PHASE_BEGIN
        {
            pg8::Gemm g{(const bf16*)(ws + WS_MIXED), (const bf16*)(ws + WS_WOUT) + (size_t)l * 1024 * 1024, M, D, 1024}; pg8::StaticOrder S; S.init(M, D, G, bid);
            pg8::EpiResid E{xb, rowsq + (size_t)(3 * l + 1) * M * 4, (LAS float*)(lds + RED_OFF), (unsigned char*)(ws + WS_X8), 1.0f};
            pg8::gemm_phase<pg8::EpiResid, pg8::StaticOrder, true, true>(lds + RING_OFF, g, S, E);
        }
        PHASE_END
        PHASE_BEGIN
        {
            pg8::Gemm g{(const bf16*)(ws + WS_X8), (const bf16*)(ws + WS_WXQ + (size_t)l * 512 * 1024), M, 512, 1024}; pg8::StaticOrder S; S.init(M, 512, G, bid);
            pg8::EpiScaleBf16 E{(bf16*)(ws + WS_QXA), 512, rowsq + (size_t)(3 * l + 1) * M * 4, 1.0f / W8_SCALE};
            pg8::gemm_phase<pg8::EpiScaleBf16, pg8::StaticOrder, true, true, true>(lds + RING_OFF, g, S, E);
        }
        PHASE_END
        PHASE_BEGIN
        {
            for (int unit = bid; unit < 256; unit += G) xa_unit_mfma(args, lds, l, unit, tid);
        }
        PHASE_END
        PHASE_BEGIN
        {
            pg8::Gemm g{(const bf16*)(ws + WS_XO), (const bf16*)(ws + WS_WXO + (size_t)l * 1024 * 512), M, D, 512}; pg8::StaticOrder S; S.init(M, D, G, bid);
            pg8::EpiResid E{xb, rowsq + (size_t)(3 * l + 2) * M * 4, (LAS float*)(lds + RED_OFF), l == 1 ? (unsigned char*)(ws + WS_X8) : nullptr, 1.0f / W8_SCALE};
            pg8::gemm_phase<pg8::EpiResid, pg8::StaticOrder, true, true, true>(lds + RING_OFF, g, S, E);
        }
        PHASE_END
        if (l == 0) {
            PHASE_BEGIN
            {
                pg8::Gemm g{xb, (const bf16*)(ws + WS_WDGU), M, 2 * FFD, 1024}; pg8::StaticOrder S; S.init(M, 2 * FFD, G, bid);
                pg8::EpiSwigluF8<false> E{(unsigned char*)(ws + WS_HD), FFD, rowsq + (size_t)2 * M * 4, 0, 2 * FFD / 256, 1.0f};
                pg8::gemm_phase<pg8::EpiSwigluF8<false>, pg8::StaticOrder, true, true>(lds + RING_OFF, g, S, E);
            }
            PHASE_END
            PHASE_BEGIN
            {
                pg8::Gemm g{(const bf16*)(ws + WS_HD), (const bf16*)(ws + WS_WDD), M, D, FFD}; pg8::StaticOrder S; S.init(M, D, G, bid);
                pg8::EpiResid E{xb, rowsq + (size_t)3 * M * 4, (LAS float*)(lds + RED_OFF), nullptr, 1.0f / W8_SCALE};
                pg8::gemm_phase<pg8::EpiResid, pg8::StaticOrder, true, true, true>(lds + RING_OFF, g, S, E);
            }
            PHASE_END
        } else {
            int* tok_e = (int*)(ws + WS_TOKE); float* tok_w = (float*)(ws + WS_TOKW); int* tok_p = (int*)(ws + WS_TOKP); float* tok_r = (float*)(ws + WS_TOKR);
            int* slot_tok = (int*)(ws + WS_SLOTT); float* slot_gate = (float*)(ws + WS_SLOTG); float* slot_rstd = (float*)(ws + WS_SLOTR);
            int* tile_e = (int*)(ws + WS_TILEE); int* wgcnt = (int*)(ws + WS_WGCNT); int* wvbase = (int*)(ws + WS_WVCNT);
            PHASE_BEGIN
            {
                LAS unsigned char* Rt = lds;
                LAS float* Dl = (LAS float*)(lds + 32768);
                LAS int* wcnt = (LAS int*)(lds + 32768 + 8192);
                { const float* rp = args.in[26]; const float* gp = args.in[22] + 1024;
#pragma unroll
                  for (int i = 0; i < 16; ++i) { const int q = tid + i * NWAVES * 64, k = q >> 3, e = q & 7; const float v = rp[q] * gp[k];
                      const unsigned hb = f2bf(v); const unsigned lb = f2bf(v - __builtin_bit_cast(float, hb << 16));
                      *(LAS unsigned short*)(Rt + e * 2048 + (((k >> 3) ^ e) << 4) + (k & 7) * 2) = (unsigned short)hb;
                      *(LAS unsigned short*)(Rt + (8 + e) * 2048 + (((k >> 3) ^ (8 + e)) << 4) + (k & 7) * 2) = (unsigned short)lb; } }
                for (int tb = bid; tb < 256; tb += G) {
                    __syncthreads();
                    if (tid < 64) wcnt[tid] = 0;
                    __syncthreads();
                    if (wave < 4) {
                        const int r32 = lane & 31, hi = lane >> 5; const int t = tb * 128 + wave * 32 + r32;
                        const bf16* xp = xb + (size_t)t * D + hi * 8;
                        f32x16 acc;
#pragma unroll
                        for (int r = 0; r < 16; ++r) acc[r] = 0.f;
#pragma unroll 1
                        for (int ks0 = 0; ks0 < 64; ks0 += 8) {
                            bf16x8v a[8];
#pragma unroll
                            for (int j = 0; j < 8; ++j) a[j] = *(const bf16x8v*)(xp + (ks0 + j) * 16);
#pragma unroll
                            for (int j = 0; j < 8; ++j) { const int ks = ks0 + j; v4u bz = (v4u){0u, 0u, 0u, 0u};
                                if (r32 < 16) bz = *(const LAS v4u*)(Rt + r32 * 2048 + (((2 * ks + hi) ^ r32) << 4));
                                acc = __builtin_amdgcn_mfma_f32_32x32x16_bf16(a[j], __builtin_bit_cast(bf16x8v, bz), acc, 0, 0, 0); }
                        }
                        LAS float* dw = Dl + wave * 512;
                        if (r32 < 16) {
#pragma unroll
                            for (int r = 0; r < 16; ++r) dw[((r & 3) + 8 * (r >> 2) + 4 * hi) * 16 + r32] = acc[r]; }
                        LDS_WAIT();
                        int e1 = -1, e2 = -1; float w1 = 0.f, w2 = 0.f, rs = 0.f;
                        if (lane < 32) {
                            const f32x4 pq = *(const f32x4*)(rowsq + ((size_t)5 * M + t) * 4);
                            rs = pg8::rstd_of((pq[0] + pq[1]) + (pq[2] + pq[3]));
                            float lg[8];
#pragma unroll
                            for (int e = 0; e < 8; ++e) lg[e] = (dw[lane * 16 + e] + dw[lane * 16 + 8 + e]) * rs;
                            e1 = 0; float l1 = lg[0];
#pragma unroll
                            for (int e = 1; e < 8; ++e) if (lg[e] > l1) { l1 = lg[e]; e1 = e; }
                            float l2 = -3.0e38f;
#pragma unroll
                            for (int e = 0; e < 8; ++e) if (e != e1 && lg[e] > l2) { l2 = lg[e]; e2 = e; }
                            w2 = 1.0f / (1.0f + expf(l1 - l2)); w1 = 1.0f - w2;
                        }
                        int p1 = 0, p2 = 0, cnt_e = 0;
#pragma unroll
                        for (int e = 0; e < 8; ++e) { const unsigned long long m = __ballot((e1 == e) || (e2 == e)); const int rk = __popcll(m & ((1ull << lane) - 1ull));
                            if (e1 == e) p1 = rk; if (e2 == e) p2 = rk; if (lane == e) cnt_e = __popcll(m); }
                        if (lane < 8) wcnt[wave * 8 + lane] = cnt_e;
                        if (lane < 32) { tok_e[2 * t] = e1; tok_e[2 * t + 1] = e2; tok_w[2 * t] = w1; tok_w[2 * t + 1] = w2; tok_p[2 * t] = p1; tok_p[2 * t + 1] = p2; tok_r[t] = rs; }
                    }
                    __syncthreads();
                    if (tid < 8) { int s = 0; for (int w = 0; w < 8; ++w) { const int c = wcnt[w * 8 + tid]; wvbase[(tb * 8 + w) * 8 + tid] = s; s += c; } wgcnt[tb * 8 + tid] = s; }
                }
            }
            PHASE_END
            PHASE_BEGIN
            {
                LAS int* tot = (LAS int*)lds; LAS int* offs = (LAS int*)(lds + 64); LAS int* base = (LAS int*)(lds + 128);
                LAS int* cl = (LAS int*)(lds + 1024);
                LAS int* ps = (LAS int*)(lds + 1024 + 8192);
                LAS int* pb = (LAS int*)(lds + 1024 + 8192 + 2048);
                for (int i = tid; i < 2048; i += NWAVES * 64) cl[i] = wgcnt[i];
                __syncthreads();
                for (int tb = bid; tb < 256; tb += G) {
                    { const int e = tid & 7, part = tid >> 3; int s = 0, sb = 0;
#pragma unroll
                      for (int j = 0; j < 4; ++j) { const int w = part * 4 + j; const int c = cl[w * 8 + e]; s += c; sb += (w < tb) ? c : 0; }
                      ps[tid] = s; pb[tid] = sb; }
                    __syncthreads();
                    if (tid < 8) { int s = 0, sb = 0;
#pragma unroll 8
                        for (int part = 0; part < 64; ++part) { s += ps[part * 8 + tid]; sb += pb[part * 8 + tid]; }
                        tot[tid] = s; base[tid] = sb; }
                    __syncthreads();
                    if (tid == 0) { int o = 0; for (int e = 0; e < 8; ++e) { offs[e] = o; o += (tot[e] + 255) & ~255; } offs[8] = o; }
                    __syncthreads();
                    if (tb == 0) {
                        if (tid == 0) { int nt = 0; for (int e = 0; e < 8; ++e) { const int k = (offs[e + 1] - offs[e]) >> 8; for (int j = 0; j < k; ++j) tile_e[nt++] = e; } tile_e[300] = nt; }
                        for (int e = 0; e < 8; ++e) for (int s = offs[e] + tot[e] + tid; s < offs[e + 1]; s += NWAVES * 64) slot_tok[s] = -1;
                    }
                    if (tid < 256) {
                        const int p = tid, t = tb * 128 + (p >> 1), k = p & 1;
                        const int e = tok_e[2 * t + k]; const int slot = offs[e] + base[e] + wvbase[(tb * 8 + (p >> 6)) * 8 + e] + tok_p[2 * t + k];
                        slot_tok[slot] = t | (k << 24); slot_gate[slot] = tok_w[2 * t + k]; slot_rstd[slot] = tok_r[t];
                    }
                    __syncthreads();
                }
            }
            PHASE_END
            PHASE_BEGIN
            {
                const int nt = __builtin_amdgcn_readfirstlane(__hip_atomic_load(tile_e + 300, RLX_AGENT)); const int ntA = nt - GTILES;
                LAS int* te_lds = (LAS int*)(lds + LDSCTL_OFF + 6144);
                for (int i = tid; i < nt; i += NWAVES * 64) te_lds[i] = __hip_atomic_load(tile_e + i, RLX_AGENT);
                __syncthreads();
                pg8::Gemm g{(const bf16*)(ws + WS_X8), (const bf16*)(ws + WS_WMGU), 0, 0, 1024}; pg8::MoeGatherOrder S; S.init(ntA, 2 * FFE / 256, G, bid, 0, 0, te_lds); S.slot_tok = slot_tok;
                pg8::EpiSwigluF8<true> E{(unsigned char*)(ws + WS_HG), FFE, slot_rstd, 0, 2 * FFE / 256, 1.0f / W8_SCALE};
                pg8::gemm_phase<pg8::EpiSwigluF8<true>, pg8::MoeGatherOrder, true, true, true>(lds + RING_OFF, g, S, E);
            }
            PHASE_END
            PHASE_BEGIN
            {
                const int nt = __builtin_amdgcn_readfirstlane(__hip_atomic_load(tile_e + 300, RLX_AGENT)); const int ntA = nt - GTILES;
                LAS int* te_lds = (LAS int*)(lds + LDSCTL_OFF + 6144);
                for (int i = tid; i < nt; i += NWAVES * 64) te_lds[i] = __hip_atomic_load(tile_e + i, RLX_AGENT);
                __syncthreads();
                {
                    pg8::Gemm g{(const bf16*)(ws + WS_HG), (const bf16*)(ws + WS_WMD), 0, 0, FFE}; pg8::MoeOrder S; S.init(ntA, D / 256, G, bid, 0, 0, te_lds);
                    pg8::EpiMoeDown E{(unsigned char*)(ws + WS_Y0), (unsigned char*)(ws + WS_Y1), slot_tok, slot_gate, 0, D / 256, 1.0f / W8_SCALE};
                    pg8::gemm_phase<pg8::EpiMoeDown, pg8::MoeOrder, true, true, true>(lds + RING_OFF, g, S, E);
                }
                __syncthreads();
                {
                    const int nmd = ntA * (D / 256);
                    pg8::Gemm g{(const bf16*)(ws + WS_X8), (const bf16*)(ws + WS_WMGU), 0, 0, 1024}; pg8::MoeGatherSkipOrder S; S.init(GTILES, 2 * FFE / 256, G, bid, ntA, ntA, te_lds + ntA); S.slot_tok = slot_tok;
                    S.rem = nmd % G; S.skip = (S.rem == 0) ? 0 : MD_SKIP;
                    pg8::EpiSwigluF8<true> E{(unsigned char*)(ws + WS_HGB), FFE, slot_rstd, ntA, 2 * FFE / 256, 1.0f / W8_SCALE};
                    pg8::gemm_phase<pg8::EpiSwigluF8<true>, pg8::MoeGatherSkipOrder, true, true, true>(lds + RING_OFF, g, S, E);
                }
            }
            PHASE_END
            PHASE_BEGIN
            {
                const int nt = __builtin_amdgcn_readfirstlane(__hip_atomic_load(tile_e + 300, RLX_AGENT)); const int ntA = nt - GTILES;
                LAS int* te_lds = (LAS int*)(lds + LDSCTL_OFF + 6144);
                for (int i = tid; i < nt; i += NWAVES * 64) te_lds[i] = __hip_atomic_load(tile_e + i, RLX_AGENT);
                __syncthreads();
                pg8::Gemm g{(const bf16*)(ws + WS_HGB), (const bf16*)(ws + WS_WMD), 0, 0, FFE}; pg8::MoeOrder S; S.init(GTILES, D / 256, G, bid, 0, ntA, te_lds + ntA);
                pg8::EpiMoeDown E{(unsigned char*)(ws + WS_Y0), (unsigned char*)(ws + WS_Y1), slot_tok, slot_gate, ntA, D / 256, 1.0f / W8_SCALE};
                pg8::gemm_phase<pg8::EpiMoeDown, pg8::MoeOrder, true, true, true>(lds + RING_OFF, g, S, E);
            }
            PHASE_END
        }
    }
    PHASE_BEGIN
    {
        const int gw = bid * NWAVES + wave, NGW = G * NWAVES; const unsigned char* Y0 = (const unsigned char*)(ws + WS_Y0); const unsigned char* Y1 = (const unsigned char*)(ws + WS_Y1);
        f32x4 gg[4];
        { const GAS f32x4* gr = (const GAS f32x4*)args.in[30]; gg[0] = gr[2 * lane]; gg[1] = gr[2 * lane + 1]; gg[2] = gr[128 + 2 * lane]; gg[3] = gr[128 + 2 * lane + 1]; }
        for (int m0 = gw; m0 < M; m0 += 4 * NGW) {
            v4u a[4][2]; v2u b0[4][2], b1[4][2];
#pragma unroll
            for (int u = 0; u < 4; ++u) { const size_t m = (size_t)(m0 + u * NGW);
                const GAS v4u* xr = (const GAS v4u*)(xb + m * D) + lane; const GAS v2u* y0 = (const GAS v2u*)(Y0 + m * D) + lane; const GAS v2u* y1 = (const GAS v2u*)(Y1 + m * D) + lane;
                a[u][0] = xr[0]; a[u][1] = xr[64]; b0[u][0] = y0[0]; b0[u][1] = y0[64]; b1[u][0] = y1[0]; b1[u][1] = y1[64]; }
#pragma unroll
            for (int u = 0; u < 4; ++u) { const size_t m = (size_t)(m0 + u * NGW); f32x4 v[4]; float s = 0.f;
#pragma unroll
                for (int h = 0; h < 2; ++h) { const v4u xa = a[u][h]; const v2u ya = b0[u][h], yb = b1[u][h];
                    const f32x2 p0 = __builtin_amdgcn_cvt_pk_f32_fp8((int)ya.x, false), p1 = __builtin_amdgcn_cvt_pk_f32_fp8((int)ya.x, true), p2 = __builtin_amdgcn_cvt_pk_f32_fp8((int)ya.y, false), p3 = __builtin_amdgcn_cvt_pk_f32_fp8((int)ya.y, true);
                    const f32x2 r0 = __builtin_amdgcn_cvt_pk_f32_fp8((int)yb.x, false), r1 = __builtin_amdgcn_cvt_pk_f32_fp8((int)yb.x, true), r2 = __builtin_amdgcn_cvt_pk_f32_fp8((int)yb.y, false), r3 = __builtin_amdgcn_cvt_pk_f32_fp8((int)yb.y, true);
                    v[2 * h] = (f32x4){bflo(xa.x) + p0.x + r0.x, bfhi(xa.x) + p0.y + r0.y, bflo(xa.y) + p1.x + r1.x, bfhi(xa.y) + p1.y + r1.y};
                    v[2 * h + 1] = (f32x4){bflo(xa.z) + p2.x + r2.x, bfhi(xa.z) + p2.y + r2.y, bflo(xa.w) + p3.x + r3.x, bfhi(xa.w) + p3.y + r3.y}; }
#pragma unroll
                for (int j = 0; j < 4; ++j) s += (v[j].x * v[j].x + v[j].y * v[j].y) + (v[j].z * v[j].z + v[j].w * v[j].w);
                const float rs = pg8::rstd_of(wave_sum(s));
                GAS f32x4* orow = (GAS f32x4*)(xres + m * D);
                orow[2 * lane] = v[0] * rs * gg[0]; orow[2 * lane + 1] = v[1] * rs * gg[1]; orow[128 + 2 * lane] = v[2] * rs * gg[2]; orow[128 + 2 * lane + 1] = v[3] * rs * gg[3]; }
        }
    }
    PHASE_END
#undef PHASE_BEGIN
#undef PHASE_END
#undef ws
#undef xres
#undef rowsq
#undef xb
}

extern "C" void kernel_launch(void* const* d_in, const int* in_sizes, int n_in, void* d_out, int out_size, void* d_ws, size_t ws_size, hipStream_t stream) {
    static int grid = 0;
    if (grid == 0) {
        if (n_in != 31 || in_sizes[0] != M * D || out_size != M * D || ws_size < WS_END) { fprintf(stderr, "kernel_launch: unexpected shapes / workspace (n_in %d, ws %zu, need %zu)\n", n_in, ws_size, (size_t)WS_END); grid = -1; return; }
        int dev = 0, cus = 0, per_cu = 0;
        if (hipGetDevice(&dev) != hipSuccess || hipDeviceGetAttribute(&cus, hipDeviceAttributeMultiprocessorCount, dev) != hipSuccess) { grid = -1; return; }
        if (hipFuncSetAttribute((const void*)hymba_fwd, hipFuncAttributeMaxDynamicSharedMemorySize, LDS_BYTES) != hipSuccess) { fprintf(stderr, "kernel_launch: hipFuncSetAttribute failed\n"); grid = -1; return; }
        if (hipOccupancyMaxActiveBlocksPerMultiprocessor(&per_cu, (const void*)hymba_fwd, NWAVES * 64, LDS_BYTES) != hipSuccess || per_cu < 1) fprintf(stderr, "kernel_launch: occupancy query reports %d\n", per_cu);
        (void)hipGetLastError();
        grid = cus;
    }
    if (grid < 0) return;
    if (hipMemsetAsync((char*)d_ws + WS_CTL, 0, CTL_ZERO_BYTES, stream) != hipSuccess) return;
    Args a{};
    for (int i = 0; i < 31; ++i) a.in[i] = (const float*)d_in[i];
    a.out = (float*)d_out; a.ws = (unsigned char*)d_ws;
#if MK_ONE_LAUNCH
    a.ph_lo = 0; a.ph_hi = 1000;
    hipLaunchKernelGGL(hymba_fwd, dim3(grid), dim3(NWAVES * 64), LDS_BYTES, stream, a);
#else
    for (int p = 0; p < NPHASES; ++p) { a.ph_lo = p; a.ph_hi = p + 1; hipLaunchKernelGGL(hymba_fwd, dim3(grid), dim3(NWAVES * 64), LDS_BYTES, stream, a); }
#endif
}
```

```cpp
#include <hip/hip_runtime.h>
#include <cstdio>
#include <cstdint>
#define MK_ONE_LAUNCH 1
namespace pg8 {
#define PG8_LAS __attribute__((address_space(3)))
typedef unsigned short bf16_t;
typedef short bf16x8 __attribute__((ext_vector_type(8)));
typedef float f32x4 __attribute__((ext_vector_type(4)));
typedef unsigned u32x4 __attribute__((ext_vector_type(4)));
constexpr int BM = 256, BK = 64, HALF = 128, HTB = HALF * BK * 2  , STAGE_BYTES = 8 * HTB, NXCD = 8, WGM = 4;

__host__ __device__ __forceinline__ int lds_byte(int r, int c) { const int st = (r >> 4) * 2 + (c >> 5), rr = r & 15, cc = c & 31, ob = rr * 64 + cc * 2; return st * 1024 + (ob ^ (((ob >> 9) & 1) << 5)); }
__host__ __device__ __forceinline__ void stage_rc(int b, int& R, int& C) { const int st = b / 1024, sb = b % 1024, swz = sb ^ (((sb >> 9) & 1) << 5); R = (st >> 1) * 16 + swz / 64; C = (st & 1) * 32 + (swz % 64) / 2; }
__host__ __device__ __forceinline__ int perm32(int rho) { const int n = rho >> 4, i = rho & 15; return 8 * (i >> 2) + 4 * n + (i & 3); }

struct Unit { int pm, pn; };
struct Gemm { const bf16_t* A; const bf16_t* Bt; int M, N, K; };

struct StaticOrder {
    int nM, nN, nwg, G, c;
    __host__ __device__ void init(int M, int N, int G_, int c_) { nM = M / BM; nN = N / BM; nwg = nM * nN; G = G_; c = c_; }
    __host__ __device__ bool next(int i, Unit& u) const {
        const long L = (long)i * G + c; if (L >= nwg) return false;
        int wgid = (int)L; { const int q = nwg / NXCD, r = nwg % NXCD, xcd = wgid % NXCD, off = wgid / NXCD; wgid = (xcd < r ? xcd * (q + 1) : r * (q + 1) + (xcd - r) * q) + off; }
        const int nig = WGM * nN, gid = wgid / nig, fm = gid * WGM, gsz = (nM - fm) < WGM ? (nM - fm) : WGM;
        u.pm = fm + ((wgid % nig) % gsz); u.pn = (wgid % nig) / gsz; return true;
    }
    __device__ __forceinline__ void a_ready(const Unit&) const {}
    __device__ __forceinline__ void done(const Unit&) const {}
    static constexpr bool GATHER = false; __device__ __forceinline__ int arow_raw(const Unit&, int) const { return 0; } __device__ __forceinline__ int arow_fix(int) const { return 0; }
};

__device__ __forceinline__ unsigned cvt_pk_bf16(float lo, float hi) { unsigned r; asm volatile("v_cvt_pk_bf16_f32 %0, %1, %2" : "=v"(r) : "v"(lo), "v"(hi)); return r; }
typedef float f32x2 __attribute__((ext_vector_type(2)));
__device__ __forceinline__ void plswap32(unsigned& a, unsigned& b) { auto r = __builtin_amdgcn_permlane32_swap(a, b, false, false); a = r[0]; b = r[1]; }
__device__ __forceinline__ void plswap16(unsigned& a, unsigned& b) { auto r = __builtin_amdgcn_permlane16_swap(a, b, false, false); a = r[0]; b = r[1]; }
__device__ __forceinline__ void swap32_pair(float x, float& r0, float& r1) { unsigned a = __builtin_bit_cast(unsigned, x), b = a; asm volatile("" : "+v"(b)); auto r = __builtin_amdgcn_permlane32_swap(a, b, false, false);
    unsigned q0 = r[0], q1 = r[1]; asm volatile("" : "+v"(q0), "+v"(q1)); r0 = __builtin_bit_cast(float, q0); r1 = __builtin_bit_cast(float, q1); }
__device__ __forceinline__ void swap16_pair(float x, float& r0, float& r1) { unsigned a = __builtin_bit_cast(unsigned, x), b = a; asm volatile("" : "+v"(b)); auto r = __builtin_amdgcn_permlane16_swap(a, b, false, false);
    unsigned q0 = r[0], q1 = r[1]; asm volatile("" : "+v"(q0), "+v"(q1)); r0 = __builtin_bit_cast(float, q0); r1 = __builtin_bit_cast(float, q1); }
__device__ __forceinline__ float xor32_sum(float x) { float a, b; swap32_pair(x, a, b); return a + b; }
__device__ __forceinline__ float xor32_max(float x) { float a, b; swap32_pair(x, a, b); return fmaxf(a, b); }
__device__ __forceinline__ float xor16_sum(float x) { float a, b; swap16_pair(x, a, b); return a + b; }
__device__ __forceinline__ float xor32_other(float x, int hi) { float a, b; swap32_pair(x, a, b); return hi ? a : b; }
typedef float f32x2 __attribute__((ext_vector_type(2)));
typedef unsigned u32x2 __attribute__((ext_vector_type(2)));
constexpr float RMS_EPS = 1e-6f;
__device__ __forceinline__ float rstd_of(float sumsq) { return __builtin_amdgcn_rsqf(sumsq * (1.0f / 1024.0f) + RMS_EPS); }
__device__ __forceinline__ unsigned pk4_fp8(float a, float b, float c, float d) { int w = __builtin_amdgcn_cvt_pk_fp8_f32(a, b, 0, false); w = __builtin_amdgcn_cvt_pk_fp8_f32(c, d, w, true); return (unsigned)w; }
__device__ __forceinline__ float silu_f(float g) { return g * __builtin_amdgcn_rcpf(1.0f + __expf(-g)); }

struct EpiScaleBf16 {
    static constexpr bool PERM = true, AFTER_DRAIN = false; static constexpr int VMOPS = 16;
    bf16_t* O; int ldc; const float* rowsq; float cs;
    __device__ __forceinline__ void operator()(const f32x4 (&acc)[2][2][4][2], const Unit& u, int wr, int wc, int fr, int fq) const {
        const int row0 = u.pm * BM + wr * 64 + fr, col0 = u.pn * BM + wc * 32 + 8 * fq;
        f32x4 pqv[2][4];
#pragma unroll
        for (int ai = 0; ai < 2; ++ai)
#pragma unroll
            for (int m = 0; m < 4; ++m) pqv[ai][m] = *(const f32x4*)(rowsq + (size_t)(row0 + ai * HALF + m * 16) * 4);
#pragma unroll
        for (int ai = 0; ai < 2; ++ai)
#pragma unroll
            for (int m = 0; m < 4; ++m) { const int row = row0 + ai * HALF + m * 16; const f32x4 pq = pqv[ai][m]; const float rs = rstd_of((pq[0] + pq[1]) + (pq[2] + pq[3])) * cs; bf16_t* rowp = O + (size_t)row * ldc + col0;
#pragma unroll
                for (int bj = 0; bj < 2; ++bj) { const f32x4 v0 = acc[ai][bj][m][0] * rs, v1 = acc[ai][bj][m][1] * rs;
                    u32x4 w; w.x = cvt_pk_bf16(v0[0], v0[1]); w.y = cvt_pk_bf16(v0[2], v0[3]); w.z = cvt_pk_bf16(v1[0], v1[1]); w.w = cvt_pk_bf16(v1[2], v1[3]);
                    *(u32x4*)(rowp + bj * HALF) = w; } }
    }
};
struct EpiResid {
    static constexpr bool PERM = true, AFTER_DRAIN = false; static constexpr int VMOPS = 24;
    bf16_t* xb; float* rowsq4; PG8_LAS float* red; unsigned char* x8; float ws;
    __device__ __forceinline__ void operator()(const f32x4 (&acc)[2][2][4][2], const Unit& u, int wr, int wc, int fr, int fq) const {
        const int row0 = u.pm * BM + wr * 64 + fr, col0 = u.pn * BM + wc * 32 + 8 * fq;
        u32x4 xiv[2][4][2];
#pragma unroll
        for (int ai = 0; ai < 2; ++ai)
#pragma unroll
            for (int m = 0; m < 4; ++m)
#pragma unroll
                for (int bj = 0; bj < 2; ++bj) xiv[ai][m][bj] = *(const u32x4*)(xb + (size_t)(row0 + ai * HALF + m * 16) * 1024 + col0 + bj * HALF);
#pragma unroll
        for (int ai = 0; ai < 2; ++ai)
#pragma unroll
            for (int mp = 0; mp < 2; ++mp) { unsigned qx[2][2], qy[2][2];
#pragma unroll
              for (int mm = 0; mm < 2; ++mm) { const int m = 2 * mp + mm; const int row = row0 + ai * HALF + m * 16; bf16_t* rowp = xb + (size_t)row * 1024 + col0; float ss = 0.f;
#pragma unroll
                for (int bj = 0; bj < 2; ++bj) { const u32x4 xi = xiv[ai][m][bj];
                    f32x4 o0 = acc[ai][bj][m][0] * ws, o1 = acc[ai][bj][m][1] * ws;
                    o0[0] += __builtin_bit_cast(float, xi.x << 16); o0[1] += __builtin_bit_cast(float, xi.x & 0xffff0000u); o0[2] += __builtin_bit_cast(float, xi.y << 16); o0[3] += __builtin_bit_cast(float, xi.y & 0xffff0000u);
                    o1[0] += __builtin_bit_cast(float, xi.z << 16); o1[1] += __builtin_bit_cast(float, xi.z & 0xffff0000u); o1[2] += __builtin_bit_cast(float, xi.w << 16); o1[3] += __builtin_bit_cast(float, xi.w & 0xffff0000u);
                    ss += ((o0[0] * o0[0] + o0[1] * o0[1]) + (o0[2] * o0[2] + o0[3] * o0[3])) + ((o1[0] * o1[0] + o1[1] * o1[1]) + (o1[2] * o1[2] + o1[3] * o1[3]));
                    u32x4 w; w.x = cvt_pk_bf16(o0[0], o0[1]); w.y = cvt_pk_bf16(o0[2], o0[3]); w.z = cvt_pk_bf16(o1[0], o1[1]); w.w = cvt_pk_bf16(o1[2], o1[3]);
                    *(u32x4*)(rowp + bj * HALF) = w;
                    if (x8) { qx[mm][bj] = pk4_fp8(o0[0], o0[1], o0[2], o0[3]); qy[mm][bj] = pk4_fp8(o1[0], o1[1], o1[2], o1[3]); } }
                ss = xor16_sum(ss); ss = xor32_sum(ss);
                if (fq == 0) red[(ai * HALF + wr * 64 + m * 16 + fr) * 4 + wc] = ss; }
              if (x8) { unsigned char* xp = x8 + (size_t)(row0 + ai * HALF + (2 * mp + (fq & 1)) * 16) * 1024 + u.pn * BM + wc * 32 + 16 * (fq >> 1);
#pragma unroll
                for (int bj = 0; bj < 2; ++bj) { plswap16(qx[0][bj], qx[1][bj]); plswap16(qy[0][bj], qy[1][bj]);
                    u32x4 w; w.x = qx[0][bj]; w.y = qy[0][bj]; w.z = qx[1][bj]; w.w = qy[1][bj]; *(u32x4*)(xp + bj * HALF) = w; } } }
        asm volatile("s_waitcnt lgkmcnt(0)" ::: "memory"); __builtin_amdgcn_s_barrier(); asm volatile("" ::: "memory");
        const int t = (wr * 4 + wc) * 64 + fq * 16 + fr;
        if (t < 256) { const f32x4 p = *(const PG8_LAS f32x4*)(red + t * 4); rowsq4[(size_t)(u.pm * BM + t) * 4 + u.pn] = (p[0] + p[1]) + (p[2] + p[3]); }
    }
};
template <bool DIRECT_RSTD> struct EpiSwiglu {
    static constexpr bool PERM = true, AFTER_DRAIN = false; static constexpr int VMOPS = 12;
    bf16_t* H; int ldh; const float* rs_src; int tile0, nct;
    __device__ __forceinline__ void operator()(const f32x4 (&acc)[2][2][4][2], const Unit& u, int wr, int wc, int fr, int fq) const {
        const int prow0 = u.pm * BM + wr * 64 + fr, orow0 = (u.pm - tile0) * BM + wr * 64 + fr, col0 = (u.pn % nct) * HALF + wc * 32 + 8 * fq;
        float rsv[2][4];
        if (DIRECT_RSTD) {
#pragma unroll
            for (int ai = 0; ai < 2; ++ai)
#pragma unroll
                for (int m = 0; m < 4; ++m) rsv[ai][m] = rs_src[prow0 + ai * HALF + m * 16];
        } else { f32x4 pqv[2][4];
#pragma unroll
            for (int ai = 0; ai < 2; ++ai)
#pragma unroll
                for (int m = 0; m < 4; ++m) pqv[ai][m] = *(const f32x4*)(rs_src + (size_t)(prow0 + ai * HALF + m * 16) * 4);
#pragma unroll
            for (int ai = 0; ai < 2; ++ai)
#pragma unroll
                for (int m = 0; m < 4; ++m) rsv[ai][m] = rstd_of((pqv[ai][m][0] + pqv[ai][m][1]) + (pqv[ai][m][2] + pqv[ai][m][3])); }
#pragma unroll
        for (int ai = 0; ai < 2; ++ai)
#pragma unroll
            for (int m = 0; m < 4; ++m) { const float rs = rsv[ai][m];
                const f32x4 g0 = acc[ai][0][m][0] * rs, g1 = acc[ai][0][m][1] * rs, u0 = acc[ai][1][m][0] * rs, u1 = acc[ai][1][m][1] * rs;
                u32x4 w; w.x = cvt_pk_bf16(silu_f(g0[0]) * u0[0], silu_f(g0[1]) * u0[1]); w.y = cvt_pk_bf16(silu_f(g0[2]) * u0[2], silu_f(g0[3]) * u0[3]);
                w.z = cvt_pk_bf16(silu_f(g1[0]) * u1[0], silu_f(g1[1]) * u1[1]); w.w = cvt_pk_bf16(silu_f(g1[2]) * u1[2], silu_f(g1[3]) * u1[3]);
                *(u32x4*)(H + (size_t)(orow0 + ai * HALF + m * 16) * ldh + col0) = w; }
    }
};
template <bool DIRECT_RSTD> struct EpiSwigluF8 {
    static constexpr bool PERM = true, AFTER_DRAIN = false; static constexpr int VMOPS = 10;
    unsigned char* H; int ldh; const float* rs_src; int tile0, nct; float ws;
    __device__ __forceinline__ void operator()(const f32x4 (&acc)[2][2][4][2], const Unit& u, int wr, int wc, int fr, int fq) const {
        const int prow0 = u.pm * BM + wr * 64 + fr, orow0 = (u.pm - tile0) * BM + wr * 64 + fr, colw = (u.pn % nct) * HALF + wc * 32 + 16 * (fq >> 1);
        float rsv[2][4];
        if (DIRECT_RSTD) {
#pragma unroll
            for (int ai = 0; ai < 2; ++ai)
#pragma unroll
                for (int m = 0; m < 4; ++m) rsv[ai][m] = rs_src[prow0 + ai * HALF + m * 16];
        } else { f32x4 pqv[2][4];
#pragma unroll
            for (int ai = 0; ai < 2; ++ai)
#pragma unroll
                for (int m = 0; m < 4; ++m) pqv[ai][m] = *(const f32x4*)(rs_src + (size_t)(prow0 + ai * HALF + m * 16) * 4);
#pragma unroll
            for (int ai = 0; ai < 2; ++ai)
#pragma unroll
                for (int m = 0; m < 4; ++m) rsv[ai][m] = rstd_of((pqv[ai][m][0] + pqv[ai][m][1]) + (pqv[ai][m][2] + pqv[ai][m][3])); }
#pragma unroll
        for (int ai = 0; ai < 2; ++ai)
#pragma unroll
            for (int mp = 0; mp < 2; ++mp) { unsigned qx[2], qy[2];
#pragma unroll
                for (int mm = 0; mm < 2; ++mm) { const int m = 2 * mp + mm;
                    const float rs = rsv[ai][m] * ws;
                    const f32x4 g0 = acc[ai][0][m][0] * rs, g1 = acc[ai][0][m][1] * rs, u0 = acc[ai][1][m][0] * rs, u1 = acc[ai][1][m][1] * rs;
                    qx[mm] = pk4_fp8(silu_f(g0[0]) * u0[0], silu_f(g0[1]) * u0[1], silu_f(g0[2]) * u0[2], silu_f(g0[3]) * u0[3]);
                    qy[mm] = pk4_fp8(silu_f(g1[0]) * u1[0], silu_f(g1[1]) * u1[1], silu_f(g1[2]) * u1[2], silu_f(g1[3]) * u1[3]); }
                plswap16(qx[0], qx[1]); plswap16(qy[0], qy[1]);
                u32x4 w; w.x = qx[0]; w.y = qy[0]; w.z = qx[1]; w.w = qy[1];
                *(u32x4*)(H + (size_t)(orow0 + ai * HALF + (2 * mp + (fq & 1)) * 16) * ldh + colw) = w; }
    }
};
struct EpiMoeDown {
    static constexpr bool PERM = true, AFTER_DRAIN = false; static constexpr int VMOPS = 8;
    unsigned char* Y0; unsigned char* Y1; const int* slot_tok; const float* slot_gate; int tile0, nct; float ws;
    __device__ __forceinline__ void operator()(const f32x4 (&acc)[2][2][4][2], const Unit& u, int wr, int wc, int fr, int fq) const {
        const int srow0 = (u.pm + tile0) * BM + wr * 64 + fr, colw = (u.pn % nct) * BM + wc * 32 + 16 * (fq >> 1);
        int tkv[2][4]; float gtv[2][4];
#pragma unroll
        for (int ai = 0; ai < 2; ++ai)
#pragma unroll
            for (int m = 0; m < 4; ++m) { tkv[ai][m] = slot_tok[srow0 + ai * HALF + m * 16]; gtv[ai][m] = slot_gate[srow0 + ai * HALF + m * 16]; }
#pragma unroll
        for (int ai = 0; ai < 2; ++ai)
#pragma unroll
            for (int mp = 0; mp < 2; ++mp) { const int tka = tkv[ai][2 * mp], tkb = tkv[ai][2 * mp + 1]; const float gta = gtv[ai][2 * mp] * ws, gtb = gtv[ai][2 * mp + 1] * ws;
                const int tk = (fq & 1) ? tkb : tka; unsigned char* yp = ((tk >> 24) ? Y1 : Y0) + (size_t)(tk & 0xffffff) * 1024 + colw;
#pragma unroll
                for (int bj = 0; bj < 2; ++bj) { const f32x4 a0 = acc[ai][bj][2 * mp][0] * gta, a1 = acc[ai][bj][2 * mp][1] * gta, b0 = acc[ai][bj][2 * mp + 1][0] * gtb, b1 = acc[ai][bj][2 * mp + 1][1] * gtb;
                    unsigned ax = pk4_fp8(a0[0], a0[1], a0[2], a0[3]), ay = pk4_fp8(a1[0], a1[1], a1[2], a1[3]), bx = pk4_fp8(b0[0], b0[1], b0[2], b0[3]), by = pk4_fp8(b1[0], b1[1], b1[2], b1[3]);
                    plswap16(ax, bx); plswap16(ay, by);
                    u32x4 w; w.x = ax; w.y = ay; w.z = bx; w.w = by;
                    if (tk >= 0) *(u32x4*)(yp + bj * HALF) = w; } }
    }
};
struct MoeOrder {
    int nM, nN, nwg, G, c, pm_base, tile0; const PG8_LAS int* tile_e;
    __device__ void init(int nM_, int nN_, int G_, int c_, int pm_base_, int tile0_, const PG8_LAS int* te) { nM = nM_; nN = nN_; nwg = nM * nN; G = G_; c = c_; pm_base = pm_base_; tile0 = tile0_; tile_e = te; }
    __device__ bool next(int i, Unit& u) const { return at((long)i * G + c, u); }
    __device__ bool at(long L, Unit& u) const {
        if (L >= nwg) return false;
        int wgid = (int)L; { const int q = nwg / NXCD, r = nwg % NXCD, xcd = wgid % NXCD, off = wgid / NXCD; wgid = (xcd < r ? xcd * (q + 1) : r * (q + 1) + (xcd - r) * q) + off; }
        const int nig = WGM * nN, gid = wgid / nig, fm = gid * WGM, gsz = (nM - fm) < WGM ? (nM - fm) : WGM;
        const int lm = fm + ((wgid % nig) % gsz), ln = (wgid % nig) / gsz;
        const int e = __builtin_amdgcn_readfirstlane(tile_e[lm]);
        u.pm = pm_base + lm; u.pn = e * nN + ln; return true;
    }
    __device__ __forceinline__ void a_ready(const Unit&) const {}
    __device__ __forceinline__ void done(const Unit&) const {}
    static constexpr bool GATHER = false; __device__ __forceinline__ int arow_raw(const Unit&, int) const { return 0; } __device__ __forceinline__ int arow_fix(int) const { return 0; }
};
struct MoeGatherOrder : MoeOrder {
    static constexpr bool GATHER = true; const int* slot_tok;
    __device__ __forceinline__ int arow_raw(const Unit& u, int r) const { return slot_tok[u.pm * BM + r]; }
    __device__ __forceinline__ int arow_fix(int tk) const { return tk < 0 ? 0 : (tk & 0xffffff); }
};
struct MoeGatherSkipOrder : MoeGatherOrder {
    int rem, skip;
    __device__ bool next(int i, Unit& u) const {
        long L;
        if (c < rem) L = (long)skip * (G - rem) + (long)i * G + c;
        else L = (i < skip) ? (long)i * (G - rem) + (c - rem) : (long)skip * (G - rem) + (long)(i - skip) * G + c;
        return at(L, u);
    }
};
typedef int i32x8 __attribute__((ext_vector_type(8)));
typedef int i32x4 __attribute__((ext_vector_type(4)));
__device__ __forceinline__ void mfma_f8_inplace(f32x4& acc, const i32x8& a, const i32x8& b, int sc) {
    asm volatile("v_mfma_scale_f32_16x16x128_f8f6f4 %0, %1, %2, %0, %3, %3 op_sel_hi:[0,0,0]" : "+v"(acc) : "v"(a), "v"(b), "v"(sc));
}
__device__ __forceinline__ i32x8 cat8(bf16x8 lo, bf16x8 hi) { const i32x4 a = __builtin_bit_cast(i32x4, lo), b = __builtin_bit_cast(i32x4, hi); return (i32x8){a.x, a.y, a.z, a.w, b.x, b.y, b.z, b.w}; }
template <class Epi, class Sched, bool ALIGN_EPI = false, bool SP2 = false, bool F8 = false>
__device__ __forceinline__ void gemm_phase(PG8_LAS unsigned char* lds, const Gemm g, const Sched& S, const Epi& E) {
    int tid_ = threadIdx.x; asm volatile("" : "+v"(tid_));
    const int tid = tid_, wid = __builtin_amdgcn_readfirstlane(tid >> 6), lane = tid & 63, wr = wid >> 2, wc = wid & 3, fr = lane & 15, fq = lane >> 4;
    constexpr int EB = F8 ? 1 : 2;
    const int K = g.K, nt = K * EB / (BK * 2);
    unsigned voffA[2], voffB[2];
#pragma unroll
    for (int i = 0; i < 2; ++i) { int R, C; stage_rc(tid * 16 + i * 8192, R, C); const int Rb = Epi::PERM ? ((R & ~31) + perm32(R & 31)) : R;
        voffA[i] = (unsigned)(R * K * EB + C * 2); voffB[i] = (unsigned)(Rb * K * EB + C * 2); }
    constexpr bool GATHER = Sched::GATHER;
    unsigned gvC[2][2], gvN[2][2], gvNN[2][2];
    int rawN[2][2];
#define PG8_RAW(dst, un) do { _Pragma("unroll") for (int h_ = 0; h_ < 2; ++h_) _Pragma("unroll") for (int i_ = 0; i_ < 2; ++i_) { int R_, C_; stage_rc(tid * 16 + i_ * 8192, R_, C_); dst[h_][i_] = S.arow_raw(un, h_ * HALF + R_); } } while (0)
#define PG8_GVR(dst, raw) do { _Pragma("unroll") for (int h_ = 0; h_ < 2; ++h_) _Pragma("unroll") for (int i_ = 0; i_ < 2; ++i_) { int R_, C_; stage_rc(tid * 16 + i_ * 8192, R_, C_); \
        dst[h_][i_] = (unsigned)S.arow_fix(raw[h_][i_]) * (unsigned)(K * EB) + (unsigned)(C_ * 2); } } while (0)
    const size_t kstep = (size_t)(BK * 2);
    const size_t hstep = (size_t)HALF * K * EB;
    const size_t tstep = 2 * hstep;
    const unsigned ldsw = (unsigned)wid * 1024u;
    const int aoff = lds_byte(wr * 64 + fr, fq * 8), boff = lds_byte(wc * 32 + fr, fq * 8);
#define PG8_SA(b, h) (((b) * 2 + (h)) * HTB)
#define PG8_SB(b, h) ((4 + (b) * 2 + (h)) * HTB)
#define PG8_STAGE(bufoff, gbase, voff) do { _Pragma("unroll") for (int _i = 0; _i < 2; ++_i) \
        __builtin_amdgcn_global_load_lds((const unsigned*)((const char*)(gbase) + (voff)[_i]), (PG8_LAS unsigned*)(lds + (bufoff) + ldsw + _i * 8192), 16, 0, 0); } while (0)
#define PG8_STA(bufoff, ptr, NX, H, KO) do { if constexpr (GATHER) { const unsigned g0_ = (NX) ? gvN[H][0] : gvC[H][0], g1_ = (NX) ? gvN[H][1] : gvC[H][1]; const char* gb_ = (const char*)g.A + (KO); \
        __builtin_amdgcn_global_load_lds((const unsigned*)(gb_ + g0_), (PG8_LAS unsigned*)(lds + (bufoff) + ldsw), 16, 0, 0); \
        __builtin_amdgcn_global_load_lds((const unsigned*)(gb_ + g1_), (PG8_LAS unsigned*)(lds + (bufoff) + ldsw + 8192), 16, 0, 0); } else { PG8_STAGE(bufoff, ptr, voffA); } } while (0)
#define PG8_LDF(dst8, dst, idx, addr) do { if constexpr (F8) { const i32x4 lo_ = *(const PG8_LAS i32x4*)(addr), hi_ = *(const PG8_LAS i32x4*)((addr) + 1024); dst8[idx] = __builtin_shufflevector(lo_, hi_, 0, 1, 2, 3, 4, 5, 6, 7); } \
        else { dst[idx][0] = *(const PG8_LAS bf16x8*)(addr); dst[idx][1] = *(const PG8_LAS bf16x8*)((addr) + 1024); } } while (0)
#define PG8_LDA(dst, b, h) do { _Pragma("unroll") for (int m = 0; m < 4; ++m) PG8_LDF(dst##8, dst, m, lds + PG8_SA(b, h) + aoff + m * 2048); } while (0)
#define PG8_LDB(dst, b, h) do { _Pragma("unroll") for (int n = 0; n < 2; ++n) PG8_LDF(dst##8, dst, n, lds + PG8_SB(b, h) + boff + n * 2048); } while (0)
#define PG8_MMA(ai, bj, At, Bt) do { __builtin_amdgcn_s_setprio(1); if constexpr (F8) { _Pragma("unroll") for (int m = 0; m < 4; ++m) _Pragma("unroll") for (int n = 0; n < 2; ++n) \
        mfma_f8_inplace(acc[ai][bj][m][n], Bt##8[n], At##8[m], one_scale); } else { \
        _Pragma("unroll") for (int m = 0; m < 4; ++m) _Pragma("unroll") for (int n = 0; n < 2; ++n) _Pragma("unroll") for (int k = 0; k < 2; ++k) \
        acc[ai][bj][m][n] = __builtin_amdgcn_mfma_f32_16x16x32_bf16(Bt[n][k], At[m][k], acc[ai][bj][m][n], 0, 0, 0); } __builtin_amdgcn_s_setprio(0); } while (0)
#define PG8_WAIT_V(n) asm volatile("s_waitcnt vmcnt(" #n ")" ::: "memory")
#define PG8_WAIT_L(n) asm volatile("s_waitcnt lgkmcnt(" #n ")" ::: "memory")
#define PG8_BAR __builtin_amdgcn_s_barrier()
#define PG8_SCHED __builtin_amdgcn_sched_barrier(0)
    Unit cur, nxt; int ui = 0;
    if (!S.next(0, cur)) return;
    f32x4 acc[2][2][4][2];
#pragma unroll
    for (int a = 0; a < 2; ++a)
#pragma unroll
        for (int b = 0; b < 2; ++b)
#pragma unroll
            for (int m = 0; m < 4; ++m)
#pragma unroll
                for (int n = 0; n < 2; ++n) acc[a][b][m][n] = (f32x4){0.f, 0.f, 0.f, 0.f};
    int one_scale = 0x7F7F7F7F; asm volatile("" : "+v"(one_scale));
    bf16x8 At[4][2], B0[2][2], B1[2][2]; i32x8 At8[4], B08[2], B18[2];
    const char* cA = (const char*)g.A + (size_t)cur.pm * tstep; const char* cB = (const char*)g.Bt + (size_t)cur.pn * tstep;
    S.a_ready(cur);
    if constexpr (GATHER) { PG8_RAW(rawN, cur); PG8_GVR(gvC, rawN); Unit n1_; if (S.next(1, n1_)) { PG8_RAW(rawN, n1_); } PG8_GVR(gvNN, rawN); }
    if constexpr (SP2) {
        PG8_STAGE(PG8_SB(0, 0), cB, voffB); PG8_STAGE(PG8_SB(0, 1), cB + hstep, voffB); PG8_STA(PG8_SA(0, 0), cA, false, 0, 0); PG8_STA(PG8_SA(0, 1), cA + hstep, false, 1, 0);
        if (wr == 1) PG8_BAR;
        PG8_WAIT_V(2); PG8_BAR;
        PG8_STAGE(PG8_SB(1, 0), cB + kstep, voffB); PG8_STA(PG8_SA(1, 0), cA + kstep, false, 0, kstep); PG8_STAGE(PG8_SB(1, 1), cB + hstep + kstep, voffB);
        PG8_WAIT_V(6); PG8_BAR;
    } else {
        PG8_STAGE(PG8_SB(0, 0), cB, voffB); PG8_STAGE(PG8_SA(0, 0), cA, voffA); PG8_STAGE(PG8_SB(0, 1), cB + hstep, voffB); PG8_STAGE(PG8_SA(0, 1), cA + hstep, voffA);
        if (wr == 1) PG8_BAR;
        PG8_WAIT_V(4); PG8_BAR;
        PG8_STAGE(PG8_SB(1, 0), cB + kstep, voffB); PG8_STAGE(PG8_SA(1, 0), cA + kstep, voffA); PG8_STAGE(PG8_SB(1, 1), cB + hstep + kstep, voffB);
        PG8_WAIT_V(6); PG8_BAR;
    }
    for (;;) {
        const bool has_next = S.next(ui + 1, nxt);
        if constexpr (GATHER) { if (has_next) { _Pragma("unroll") for (int h_ = 0; h_ < 2; ++h_) _Pragma("unroll") for (int i_ = 0; i_ < 2; ++i_) gvN[h_][i_] = gvNN[h_][i_]; }
                                else { _Pragma("unroll") for (int h_ = 0; h_ < 2; ++h_) _Pragma("unroll") for (int i_ = 0; i_ < 2; ++i_) gvN[h_][i_] = gvC[h_][i_]; } }
        const char* nA = has_next ? (const char*)g.A + (size_t)nxt.pm * tstep : cA; const char* nB = has_next ? (const char*)g.Bt + (size_t)nxt.pn * tstep : cB;
#pragma unroll 1
        for (int t = 0; t < nt; t += 2) {
            const bool last = (t == nt - 2);
            const char* a1 = cA + (size_t)(t + 1) * kstep;
            const char* a2 = last ? nA : cA + (size_t)(t + 2) * kstep; const char* b2 = last ? nB : cB + (size_t)(t + 2) * kstep;
            const char* a3 = a2 + kstep; const char* b3 = b2 + kstep; const size_t ko2 = last ? (size_t)0 : (size_t)(t + 2) * kstep; (void)ko2;
            if (last && has_next) S.a_ready(nxt);
            if constexpr (SP2) {
            PG8_LDB(B0, 0, 0); PG8_LDB(B1, 0, 1); PG8_SCHED; PG8_LDA(At, 0, 0); PG8_STA(PG8_SA(1, 1), a1 + hstep, false, 1, (size_t)(t + 1) * kstep);
            const bool relax = (t == 0 && ui > 0);
            if (relax) { asm volatile("s_waitcnt vmcnt(%0)" :: "n"(8 + Epi::VMOPS) : "memory"); } else { PG8_WAIT_V(8); }
            PG8_WAIT_L(0); PG8_BAR; PG8_MMA(0, 0, At, B0); PG8_MMA(0, 1, At, B1); PG8_BAR; PG8_SCHED;
            PG8_LDA(At, 0, 1); PG8_STAGE(PG8_SB(0, 0), b2, voffB); PG8_STAGE(PG8_SB(0, 1), b2 + hstep, voffB); PG8_STA(PG8_SA(0, 0), a2, last, 0, ko2);
            if (relax) { asm volatile("s_waitcnt vmcnt(%0)" :: "n"(8 + Epi::VMOPS) : "memory"); } else { PG8_WAIT_V(8); }
            PG8_WAIT_L(0); PG8_BAR; PG8_MMA(1, 0, At, B0); PG8_MMA(1, 1, At, B1); PG8_BAR; PG8_SCHED;
            PG8_LDB(B0, 1, 0); PG8_LDB(B1, 1, 1); PG8_SCHED; PG8_LDA(At, 1, 0); PG8_STA(PG8_SA(0, 1), a2 + hstep, last, 1, ko2);
            PG8_WAIT_V(8); PG8_WAIT_L(0); PG8_BAR; PG8_MMA(0, 0, At, B0); PG8_MMA(0, 1, At, B1); PG8_BAR; PG8_SCHED;
            PG8_LDA(At, 1, 1); PG8_STAGE(PG8_SB(1, 0), b3, voffB); PG8_STAGE(PG8_SB(1, 1), b3 + hstep, voffB); PG8_STA(PG8_SA(1, 0), a3, last, 0, ko2 + kstep);
            PG8_WAIT_V(8); PG8_WAIT_L(0); PG8_BAR; PG8_MMA(1, 0, At, B0); PG8_MMA(1, 1, At, B1); PG8_BAR; PG8_SCHED;
            } else {
            PG8_LDB(B0, 0, 0); PG8_SCHED; PG8_LDA(At, 0, 0); PG8_STAGE(PG8_SA(1, 1), a1 + hstep, voffA);
            PG8_WAIT_L(8); PG8_BAR; PG8_WAIT_L(0); PG8_MMA(0, 0, At, B0); PG8_BAR; PG8_SCHED;
            PG8_LDB(B1, 0, 1); PG8_STAGE(PG8_SB(0, 0), b2, voffB);
            PG8_BAR; PG8_WAIT_L(0); PG8_MMA(0, 1, At, B1); PG8_BAR;
            PG8_LDA(At, 0, 1); PG8_STAGE(PG8_SA(0, 0), a2, voffA);
            PG8_BAR; PG8_WAIT_L(0); PG8_MMA(1, 0, At, B0); PG8_BAR; PG8_SCHED;
            PG8_STAGE(PG8_SB(0, 1), b2 + hstep, voffB);
            PG8_WAIT_V(6); PG8_BAR; PG8_MMA(1, 1, At, B1); PG8_BAR;
            PG8_LDB(B0, 1, 0); PG8_SCHED; PG8_LDA(At, 1, 0); PG8_STAGE(PG8_SA(0, 1), a2 + hstep, voffA);
            PG8_WAIT_L(8); PG8_BAR; PG8_WAIT_L(0); PG8_MMA(0, 0, At, B0); PG8_BAR; PG8_SCHED;
            PG8_LDB(B1, 1, 1); PG8_STAGE(PG8_SB(1, 0), b3, voffB);
            PG8_BAR; PG8_WAIT_L(0); PG8_MMA(0, 1, At, B1); PG8_BAR;
            PG8_LDA(At, 1, 1); PG8_STAGE(PG8_SA(1, 0), a3, voffA);
            PG8_BAR; PG8_WAIT_L(0); PG8_MMA(1, 0, At, B0); PG8_BAR; PG8_SCHED;
            PG8_STAGE(PG8_SB(1, 1), b3 + hstep, voffB);
            PG8_WAIT_V(6); PG8_BAR; PG8_MMA(1, 1, At, B1); PG8_BAR;
            }
        }
        if constexpr (ALIGN_EPI) { if (wr == 0) PG8_BAR; }
        if constexpr (GATHER) { Unit n2_; if (has_next && S.next(ui + 2, n2_)) { PG8_RAW(rawN, n2_); } }
        if constexpr (F8) { asm volatile("s_nop 15\n\ts_nop 7" ::: "memory"); }
        if constexpr (!Epi::AFTER_DRAIN) { int fr_e = fr, fq_e = fq; asm volatile("" : "+v"(fr_e), "+v"(fq_e)); E(acc, cur, wr, wc, fr_e, fq_e); S.done(cur); }
        if constexpr (GATHER) { PG8_GVR(gvNN, rawN); }
        if (!has_next) break;
#pragma unroll
        for (int a = 0; a < 2; ++a)
#pragma unroll
            for (int b = 0; b < 2; ++b)
#pragma unroll
                for (int m = 0; m < 4; ++m)
#pragma unroll
                    for (int n = 0; n < 2; ++n) acc[a][b][m][n] = (f32x4){0.f, 0.f, 0.f, 0.f};
        cur = nxt; cA = nA; cB = nB; ++ui;
        if constexpr (GATHER) { _Pragma("unroll") for (int h_ = 0; h_ < 2; ++h_) _Pragma("unroll") for (int i_ = 0; i_ < 2; ++i_) gvC[h_][i_] = gvN[h_][i_]; }
        if constexpr (ALIGN_EPI) { if (wr == 1) PG8_BAR; }
    }
    PG8_WAIT_V(0);
    if constexpr (!ALIGN_EPI) { if (wr == 0) PG8_BAR; }
    PG8_BAR;
    if constexpr (Epi::AFTER_DRAIN) { E.fused(acc, cur, wr, wc, fr, fq, lds, wid, lane); S.done(cur); }
#undef PG8_SA
#undef PG8_SB
#undef PG8_STAGE
#undef PG8_STA
#undef PG8_RAW
#undef PG8_GVR
#undef PG8_LDF
#undef PG8_LDA
#undef PG8_LDB
#undef PG8_MMA
#undef PG8_WAIT_V
#undef PG8_WAIT_L
#undef PG8_BAR
#undef PG8_SCHED
}
}

constexpr int NWAVES = 8;
constexpr int BATCH = 8, SEQ = 4096, D = 1024, M = BATCH * SEQ, MEMLEN = 256, MROWS = BATCH * MEMLEN;
constexpr int INCOLS = 2048, FFD = 2816, FFE = 3584, NEXP = 8;
constexpr int NSLOT = 2 * M + NEXP * 256;
constexpr int MAXTILES = NSLOT / 256;
constexpr int NGROUPS = 2, GTILES = 128, GTILES_MAX = 136, MD_SKIP = 3;
constexpr float W8_SCALE = 64.0f;
constexpr float EPS = 1e-6f;
#ifndef MK_ONE_LAUNCH
#define MK_ONE_LAUNCH 0
#endif
constexpr size_t MiB = 1u << 20;
constexpr size_t WS_CTL = 0, CTL_ZERO_BYTES = 64 * 1024;
constexpr size_t WS_RGSUM = 2 * MiB, WS_TOKE = WS_RGSUM + 512 * 1024, WS_TOKW = WS_TOKE + 256 * 1024, WS_TOKP = WS_TOKW + 256 * 1024, WS_TOKR = WS_TOKP + 256 * 1024;
constexpr size_t WS_SLOTT = 3 * MiB + 512 * 1024, WS_SLOTG = 4 * MiB, WS_SLOTR = 4 * MiB + 512 * 1024, WS_TILEE = 5 * MiB, WS_WGCNT = 5 * MiB + 256 * 1024, WS_WVCNT = 5 * MiB + 384 * 1024, WS_MEMSQ = 5 * MiB + 512 * 1024;
constexpr size_t WS_WMGU = 8 * MiB, WS_WMD = 64 * MiB, WS_X8 = 92 * MiB, WS_XB = 176 * MiB;
constexpr size_t WS_WIN = 240 * MiB, WS_WOUT = 248 * MiB, WS_WXQ = 252 * MiB, WS_WKV = 254 * MiB, WS_WXO = 258 * MiB, WS_RGW = 260 * MiB;
constexpr size_t WS_WDGU = 261 * MiB, WS_WDD = 272 * MiB, WS_KVMEM = 278 * MiB, WS_MEMB = 286 * MiB, WS_PROJ = 290 * MiB, WS_MIXED = 418 * MiB;
constexpr size_t WS_RGC = 124 * MiB;
constexpr size_t WS_QXA = 290 * MiB, WS_XO = 322 * MiB, WS_HD = 290 * MiB, WS_HG = 240 * MiB, WS_HGB = 359 * MiB, WS_Y0 = 124 * MiB, WS_Y1 = 471 * MiB, WS_ROWSQ = 504 * MiB, WS_END = 508 * MiB;
static_assert(WS_TOKR + 128 * 1024 <= WS_SLOTT && WS_SLOTT + (size_t)NSLOT * 4 <= WS_SLOTG && WS_SLOTG + (size_t)NSLOT * 4 <= WS_SLOTR && WS_SLOTR + (size_t)NSLOT * 4 <= WS_TILEE, "small map");
static_assert(WS_WMGU + (size_t)NEXP * 2 * FFE * D <= WS_WMD && WS_WMD + (size_t)NEXP * D * FFE <= WS_X8 && WS_X8 + (size_t)M * D <= WS_XB && WS_XB + (size_t)M * D * 2 <= WS_WIN, "map1");
static_assert(WS_WDGU + (size_t)2 * FFD * D * 2 <= WS_WDD && WS_WDD + (size_t)D * FFD * 2 <= WS_KVMEM && WS_KVMEM + (size_t)MROWS * 2048 * 2 <= WS_MEMB && WS_MEMB + (size_t)MROWS * D * 2 <= WS_PROJ, "map2");
static_assert(WS_PROJ + (size_t)M * INCOLS * 2 <= WS_MIXED && WS_MIXED + (size_t)M * D * 2 <= WS_ROWSQ && WS_HD + (size_t)M * FFD * 2 <= WS_ROWSQ && WS_ROWSQ + (size_t)6 * M * 16 <= WS_END, "map3");
static_assert(WS_HG + (size_t)GTILES_MAX * 256 * FFE <= WS_HGB && WS_HGB + (size_t)GTILES * 256 * FFE <= WS_Y1 && WS_X8 + (size_t)M * D <= WS_Y0 && WS_Y0 + (size_t)M * D <= WS_XB && WS_Y1 + (size_t)M * D <= WS_ROWSQ, "map4");
constexpr int CW_TMO = 0, CW_CODE = 1, CW_BAR = 4096;
constexpr int RING_OFF = 0, RING_BYTES = 131072, LDSCTL_OFF = RING_BYTES, MISC_OFF = LDSCTL_OFF + 320, RED_OFF = LDSCTL_OFF + 1024, LDS_BYTES = 147456;

#define GAS __attribute__((address_space(1)))
#define LAS __attribute__((address_space(3)))
typedef unsigned short bf16;
typedef unsigned v4u __attribute__((ext_vector_type(4)));
typedef unsigned v2u __attribute__((ext_vector_type(2)));
typedef float f32x4 __attribute__((ext_vector_type(4)));
typedef GAS unsigned gu32;
#define RLX_AGENT __ATOMIC_RELAXED, __HIP_MEMORY_SCOPE_AGENT
#define LDS_WAIT() asm volatile("s_waitcnt lgkmcnt(0)" ::: "memory")
#define VM_WAIT() asm volatile("s_waitcnt vmcnt(0)" ::: "memory")
__device__ __forceinline__ unsigned f2bf(float f) { unsigned u = __builtin_bit_cast(unsigned, f); return (u + 0x7fffu + ((u >> 16) & 1u)) >> 16; }
__device__ __forceinline__ unsigned pk2(float lo, float hi) { return f2bf(lo) | (f2bf(hi) << 16); }
__device__ __forceinline__ float bf2f(unsigned short h) { return __builtin_bit_cast(float, (unsigned)h << 16); }
__device__ __forceinline__ float bflo(unsigned w) { return __builtin_bit_cast(float, w << 16); }
__device__ __forceinline__ float bfhi(unsigned w) { return __builtin_bit_cast(float, w & 0xffff0000u); }
#define XB_TMO      128
#define XB_XCNT(j)  (256  + 64 * (j))
#define XB_XSUB(j)  (1280 + 64 * (j))
#define XB_XGEN(j)  (2304 + 64 * (j))
#define XB_TOP      3328
#define XB_TOPGEN   3392
#define XCD_BAR_WORDS 3456
#define XB_SPIN_CAP (1u << 18)

__device__ __forceinline__ unsigned xb_ld(unsigned* p)              { return __hip_atomic_load(p, __ATOMIC_RELAXED, __HIP_MEMORY_SCOPE_AGENT); }
__device__ __forceinline__ unsigned xb_add(unsigned* p, unsigned v) { return __hip_atomic_fetch_add(p, v, __ATOMIC_RELAXED, __HIP_MEMORY_SCOPE_AGENT); }
__device__ __forceinline__ unsigned xb_xcc_id() { return (unsigned)__builtin_amdgcn_s_getreg((3 << 11) | 20) & 0xFu; }
#define XB_SPIN(cond, bar) do { unsigned _sp = 0; while (cond) { __builtin_amdgcn_s_sleep(1); \
    if ((++_sp & 255u) == 0u) { if (xb_ld(&(bar)[XB_TMO])) break; if (_sp > XB_SPIN_CAP) { atomicAdd(&(bar)[XB_TMO], 1u); break; } } } } while (0)

struct XcdBarrier {
    unsigned* bar; unsigned x;
    volatile LAS unsigned* st;
};

__device__ __forceinline__ XcdBarrier xcd_barrier_post(unsigned* bar, volatile LAS unsigned* st) {
    XcdBarrier b; b.bar = bar; b.x = xb_xcc_id(); b.st = st;
    if (threadIdx.x == 0) (void)xb_add(&bar[XB_XCNT(b.x)], 1u);
    return b;
}
__device__ __forceinline__ void xcd_barrier_complete(unsigned* bar, unsigned x, unsigned& nloc, unsigned& nx) {
    const unsigned G = gridDim.x * gridDim.y * gridDim.z;
    unsigned sum, cnt, mine, sp = 0u;
    for (;;) {
        sum = 0u; cnt = 0u; mine = 0u;
#pragma unroll
        for (unsigned j = 0; j < 16; ++j) { const unsigned c = xb_ld(&bar[XB_XCNT(j)]); sum += c; cnt += (c > 0u) ? 1u : 0u; mine = (j == x) ? c : mine; }
        if (sum == G) break;
        __builtin_amdgcn_s_sleep(1);
        if ((++sp & 255u) == 0u) { if (xb_ld(&bar[XB_TMO])) break; if (sp > XB_SPIN_CAP) { atomicAdd(&bar[XB_TMO], 1u); break; } }
    }
    nloc = mine > 0u ? mine : 1u; nx = cnt > 0u ? cnt : 1u;
}

__device__ __forceinline__ void xcd_barrier(const XcdBarrier& b) {
    asm volatile("s_waitcnt vmcnt(0)" ::: "memory");
    __syncthreads();
    if (threadIdx.x == 0) {
        unsigned* bar = b.bar;
        __builtin_amdgcn_s_waitcnt(0);
        unsigned nloc = b.st[0], nx = b.st[1];
        if (nloc == 0u) { xcd_barrier_complete(bar, b.x, nloc, nx); b.st[0] = nloc; b.st[1] = nx; }
        const unsigned old = xb_add(&bar[XB_XSUB(b.x)], 1u);
        const unsigned gen = old / nloc;
        if (old + 1u == (gen + 1u) * nloc) {
            __builtin_amdgcn_fence(__ATOMIC_RELEASE, "agent");
            asm volatile("s_waitcnt vmcnt(0)" ::: "memory");
            const unsigned og = xb_add(&bar[XB_TOP], 1u);
            const unsigned tg = og / nx;
            if (og + 1u == (tg + 1u) * nx) xb_add(&bar[XB_TOPGEN], 1u);
            else XB_SPIN(xb_ld(&bar[XB_TOPGEN]) == tg, bar);
            __builtin_amdgcn_fence(__ATOMIC_ACQUIRE, "agent");
            xb_add(&bar[XB_XGEN(b.x)], 1u);
            asm volatile("s_waitcnt vmcnt(0)" ::: "memory");
        } else {
            XB_SPIN(xb_ld(&bar[XB_XGEN(b.x)]) == gen, bar);
            __builtin_amdgcn_fence(__ATOMIC_ACQUIRE, "agent");
            asm volatile("s_waitcnt vmcnt(0)" ::: "memory");
        }
    }
    __syncthreads();
}

typedef float f32x2 __attribute__((ext_vector_type(2)));
struct Args { const float* in[31]; float* out; unsigned char* ws; int ph_lo, ph_hi; };
typedef const volatile __attribute__((address_space(4))) unsigned long long* karg_ptr;
__device__ __forceinline__ unsigned long long ldkarg(int i) { return ((karg_ptr)__builtin_amdgcn_kernarg_segment_ptr())[i]; }
struct KIn { __device__ __forceinline__ const float* operator[](int i) const { return (const float*)(const GAS float*)ldkarg(i); } };
struct KArgs { KIn in; __device__ __forceinline__ unsigned char* ws() const { return (unsigned char*)(GAS unsigned char*)ldkarg(32); } __device__ __forceinline__ float* out() const { return (float*)(GAS float*)ldkarg(31); } };
struct Frame {
    LAS unsigned char* lds;
    int tid, lane, wave, G, bid;
    const float* const* in;
};
__device__ __forceinline__ float wave_sum(float v) {
#pragma unroll
    for (int o = 1; o < 64; o <<= 1) v += __shfl_xor(v, o);
    return v;
}
__device__ __forceinline__ float gelu_tanh(float x) {
    const float y = 0.7978845608028654f * (x + 0.044715f * x * x * x);
    const float e = __expf(2.0f * y);
    const float th = 1.0f - 2.0f * __builtin_amdgcn_rcpf(e + 1.0f);
    return 0.5f * x * (1.0f + th);
}
__device__ __forceinline__ float sigmoid_f(float z) { return __builtin_amdgcn_rcpf(1.0f + __expf(-z)); }

__device__ __forceinline__ void transpose_tile(const float* Wt, int N, bf16* dst, int K, const float* gk, LAS float* scr, int lane) {
    float v[32];
#pragma unroll
    for (int i = 0; i < 32; ++i) v[i] = Wt[(size_t)(2 * i + (lane >> 5)) * N + (lane & 31)];
    if (gk) {
#pragma unroll
        for (int i = 0; i < 32; ++i) v[i] *= gk[2 * i + (lane >> 5)]; }
#pragma unroll
    for (int i = 0; i < 32; ++i) scr[(2 * i + (lane >> 5)) * 33 + (lane & 31)] = v[i];
    LDS_WAIT(); asm volatile("" ::: "memory");
    const int c = lane & 7;
#pragma unroll
    for (int j = 0; j < 4; ++j) { const int n = (lane >> 3) + 8 * j; const LAS float* s = scr + (8 * c) * 33 + n;
        v4u o; o.x = pg8::cvt_pk_bf16(s[0 * 33], s[1 * 33]); o.y = pg8::cvt_pk_bf16(s[2 * 33], s[3 * 33]); o.z = pg8::cvt_pk_bf16(s[4 * 33], s[5 * 33]); o.w = pg8::cvt_pk_bf16(s[6 * 33], s[7 * 33]);
        *(GAS v4u*)(dst + (size_t)n * K + 8 * c) = o; }
    LDS_WAIT(); asm volatile("" ::: "memory");
}
__device__ __forceinline__ void transpose_tile8(const float* Wt, int N, unsigned char* dst, int K, const float* gk, float scl, LAS float* scr, int lane) {
    float v[32];
#pragma unroll
    for (int i = 0; i < 32; ++i) v[i] = Wt[(size_t)(2 * i + (lane >> 5)) * N + (lane & 31)];
#pragma unroll
    for (int i = 0; i < 32; ++i) v[i] *= gk ? gk[2 * i + (lane >> 5)] * scl : scl;
#pragma unroll
    for (int i = 0; i < 32; ++i) scr[(2 * i + (lane >> 5)) * 33 + (lane & 31)] = v[i];
    LDS_WAIT(); asm volatile("" ::: "memory");
    const int c = lane & 7;
#pragma unroll
    for (int j = 0; j < 4; ++j) { const int n = (lane >> 3) + 8 * j; const LAS float* s = scr + (8 * c) * 33 + n;
        v2u o; o.x = pg8::pk4_fp8(s[0 * 33], s[1 * 33], s[2 * 33], s[3 * 33]); o.y = pg8::pk4_fp8(s[4 * 33], s[5 * 33], s[6 * 33], s[7 * 33]);
        *(GAS v2u*)(dst + (size_t)n * K + 8 * c) = o; }
    LDS_WAIT(); asm volatile("" ::: "memory");
}
__device__ __forceinline__ void conv_plain8(const float* W, int K, int N, int sub, unsigned char* WT, int drow0, const float* gain, float scl, LAS float* scr, int lane) {
    const int nblk = N / 32, kb = sub / nblk, nb = sub % nblk;
    transpose_tile8(W + (size_t)(64 * kb) * N + 32 * nb, N, WT + (size_t)(drow0 + 32 * nb) * K + 64 * kb, K, gain ? gain + 64 * kb : nullptr, scl, scr, lane);
}
__device__ __forceinline__ void conv_gu8(const float* W, int K, int N, int sub, unsigned char* WT, int up, const float* gain, float scl, LAS float* scr, int lane) {
    const int nblk = N / 32, kb = sub / nblk, nb = sub % nblk, n0 = 32 * nb, drow = (n0 >> 7) * 256 + (n0 & 127) + up * 128;
    transpose_tile8(W + (size_t)(64 * kb) * N + n0, N, WT + (size_t)drow * K + 64 * kb, K, gain ? gain + 64 * kb : nullptr, scl, scr, lane);
}
__device__ __forceinline__ void conv_plain(const float* W, int K, int N, int sub, bf16* WT, int drow0, const float* gain, LAS float* scr, int lane) {
    const int nblk = N / 32, kb = sub / nblk, nb = sub % nblk;
    transpose_tile(W + (size_t)(64 * kb) * N + 32 * nb, N, WT + (size_t)(drow0 + 32 * nb) * K + 64 * kb, K, gain ? gain + 64 * kb : nullptr, scr, lane);
}
__device__ __forceinline__ void conv_gu(const float* W, int K, int N, int sub, bf16* WT, int up, const float* gain, LAS float* scr, int lane) {
    const int nblk = N / 32, kb = sub / nblk, nb = sub % nblk, n0 = 32 * nb, drow = (n0 >> 7) * 256 + (n0 & 127) + up * 128;
    transpose_tile(W + (size_t)(64 * kb) * N + n0, N, WT + (size_t)drow * K + 64 * kb, K, gain ? gain + 64 * kb : nullptr, scr, lane);
}

struct ConvItem { const float* src; const float* gk; unsigned char* dst; int N, K; float scl; int f8; };
__device__ __forceinline__ void conv_load(const ConvItem& d, float (&v)[64], int lane) {
#pragma unroll
    for (int i = 0; i < 64; ++i) v[i] = d.src[(size_t)i * d.N + lane];
}
__device__ __forceinline__ void conv_finish(const ConvItem& d, float (&v)[64], int lane) {
    if (d.gk) {
#pragma unroll
        for (int i = 0; i < 64; ++i) v[i] *= d.gk[i] * d.scl;
    } else {
#pragma unroll
        for (int i = 0; i < 64; ++i) v[i] *= d.scl;
    }
    if (d.f8) { GAS v4u* o = (GAS v4u*)(d.dst + (size_t)lane * d.K);
#pragma unroll
        for (int c = 0; c < 4; ++c) { v4u w; w.x = pg8::pk4_fp8(v[16 * c], v[16 * c + 1], v[16 * c + 2], v[16 * c + 3]); w.y = pg8::pk4_fp8(v[16 * c + 4], v[16 * c + 5], v[16 * c + 6], v[16 * c + 7]);
            w.z = pg8::pk4_fp8(v[16 * c + 8], v[16 * c + 9], v[16 * c + 10], v[16 * c + 11]); w.w = pg8::pk4_fp8(v[16 * c + 12], v[16 * c + 13], v[16 * c + 14], v[16 * c + 15]); o[c] = w; } }
    else { GAS v4u* o = (GAS v4u*)(d.dst + (size_t)lane * d.K * 2);
#pragma unroll
        for (int c = 0; c < 8; ++c) { v4u w; w.x = pg8::cvt_pk_bf16(v[8 * c], v[8 * c + 1]); w.y = pg8::cvt_pk_bf16(v[8 * c + 2], v[8 * c + 3]); w.z = pg8::cvt_pk_bf16(v[8 * c + 4], v[8 * c + 5]); w.w = pg8::cvt_pk_bf16(v[8 * c + 6], v[8 * c + 7]); o[c] = w; } }
}
constexpr int N_CONV_ITEMS = 26192;
__device__ __forceinline__ ConvItem conv_decode(const KArgs& args, int it) {
    unsigned char* ws = args.ws();
    const float* W; const float* gain = nullptr; unsigned char* WT; int K, N, sub, drow0 = 0, gu = -1, f8 = 0; float scl = 1.0f; int r = it;
    if (r < 1024) { const int l = r >> 9; sub = r & 511; W = args.in[4] + (size_t)l * 1024 * 2048; K = 1024; N = 2048; WT = ws + WS_WIN + (size_t)l * 2048 * 1024 * 2; gain = args.in[3] + l * 1024; }
    else if ((r -= 1024) < 512) { const int l = r >> 8; sub = r & 255; W = args.in[15] + (size_t)l * 1024 * 1024; K = 1024; N = 1024; WT = ws + WS_WOUT + (size_t)l * 1024 * 1024 * 2; }
    else if ((r -= 512) < 256) { const int l = r >> 7; sub = r & 127; W = args.in[18] + (size_t)l * 1024 * 512; K = 1024; N = 512; WT = ws + WS_WXQ + (size_t)l * 512 * 1024; gain = args.in[16] + l * 1024; f8 = 1; scl = W8_SCALE; }
    else if ((r -= 256) < 256) { const int l = r >> 7; sub = r & 127; W = args.in[19] + (size_t)l * 1024 * 512; K = 1024; N = 512; WT = ws + WS_WKV + (size_t)l * 1024 * 1024 * 2; gain = args.in[17] + l * 1024; }
    else if ((r -= 256) < 256) { const int l = r >> 7; sub = r & 127; W = args.in[20] + (size_t)l * 1024 * 512; K = 1024; N = 512; WT = ws + WS_WKV + (size_t)l * 1024 * 1024 * 2; gain = args.in[17] + l * 1024; drow0 = 512; }
    else if ((r -= 256) < 256) { const int l = r >> 7; sub = r & 127; W = args.in[21] + (size_t)l * 512 * 1024; K = 512; N = 1024; WT = ws + WS_WXO + (size_t)l * 1024 * 512; f8 = 1; scl = W8_SCALE; }
    else if ((r -= 256) < 704) { sub = r; W = args.in[23]; K = 1024; N = FFD; WT = ws + WS_WDGU; gain = args.in[22]; gu = 0; }
    else if ((r -= 704) < 704) { sub = r; W = args.in[24]; K = 1024; N = FFD; WT = ws + WS_WDGU; gain = args.in[22]; gu = 1; }
    else if ((r -= 704) < 704) { sub = r; W = args.in[25]; K = FFD; N = 1024; WT = ws + WS_WDD; f8 = 1; scl = W8_SCALE; }
    else if ((r -= 704) < 7168) { const int e = r / 896; sub = r % 896; W = args.in[27] + (size_t)e * 1024 * FFE; K = 1024; N = FFE; WT = ws + WS_WMGU + (size_t)e * 2 * FFE * 1024; gain = args.in[22] + 1024; gu = 0; f8 = 1; scl = W8_SCALE; }
    else if ((r -= 7168) < 7168) { const int e = r / 896; sub = r % 896; W = args.in[28] + (size_t)e * 1024 * FFE; K = 1024; N = FFE; WT = ws + WS_WMGU + (size_t)e * 2 * FFE * 1024; gain = args.in[22] + 1024; gu = 1; f8 = 1; scl = W8_SCALE; }
    else if ((r -= 7168) < 7168) { const int e = r / 896; sub = r % 896; W = args.in[29] + (size_t)e * FFE * 1024; K = FFE; N = 1024; WT = ws + WS_WMD + (size_t)e * 1024 * FFE; f8 = 1; scl = W8_SCALE; }
    else { r -= 7168; const int q = r, l = q >> 3, mat = (q >> 2) & 1, hh = q & 3; sub = 0; W = args.in[mat ? 12 : 10] + (size_t)(l * 4 + hh) * 4096; K = 64; N = 64; WT = ws + WS_RGW + (size_t)q * 4096 * 2; scl = -1.4426950408889634f; }
    const int nkb = K / 64, kb = sub % nkb, nb = sub / nkb, n0 = 64 * nb;
    const int drow = (gu < 0) ? drow0 + n0 : (n0 >> 7) * 256 + (n0 & 127) + gu * 128;
    ConvItem d; d.src = W + (size_t)(64 * kb) * N + n0; d.gk = gain ? gain + 64 * kb : nullptr; d.dst = WT + ((size_t)drow * K + 64 * kb) * (f8 ? 1 : 2); d.N = N; d.K = K; d.scl = scl; d.f8 = f8;
    return d;
}


typedef short bf16x8v __attribute__((ext_vector_type(8)));
typedef float f32x16 __attribute__((ext_vector_type(16)));
constexpr float LOG2E = 1.4426950408889634f;
__device__ __forceinline__ bf16x8v pack8(const f32x16& p, int b) {
    v4u w; w.x = pg8::cvt_pk_bf16(p[b + 0], p[b + 1]); w.y = pg8::cvt_pk_bf16(p[b + 2], p[b + 3]); w.z = pg8::cvt_pk_bf16(p[b + 4], p[b + 5]); w.w = pg8::cvt_pk_bf16(p[b + 6], p[b + 7]);
    return __builtin_bit_cast(bf16x8v, w);
}
__device__ __forceinline__ void xa_unit_mfma(const KArgs& args, LAS unsigned char* lds, int l, int unit, int tid) {
    asm volatile("" : "+v"(tid));
    const int lane = tid & 63, wave = __builtin_amdgcn_readfirstlane(tid >> 6), r32 = lane & 31, hi = lane >> 5;
    const int b = unit >> 5, hh = (unit >> 3) & 3, tc = unit & 7;
    const bf16* kv = (const bf16*)(args.ws() + WS_KVMEM) + (size_t)(b * 256) * 2048 + l * 1024 + hh * 128;
    const bf16* qxa = (const bf16*)(args.ws() + WS_QXA); unsigned char* xo = (unsigned char*)(args.ws() + WS_XO);
    v4u kq[8], vq[8];
#pragma unroll
    for (int i = 0; i < 8; ++i) { const int piece = tid + 512 * i, r = piece >> 4, c = piece & 15; kq[i] = *(const v4u*)(kv + (size_t)r * 2048 + c * 8); }
#pragma unroll
    for (int i = 0; i < 8; ++i) { const int piece = tid + 512 * i, key = piece & 255, dc = piece >> 8; vq[i] = *(const v4u*)(kv + (size_t)key * 2048 + 512 + dc * 8); }
    asm volatile("" : "+v"(vq[0]), "+v"(vq[1]), "+v"(vq[2]), "+v"(vq[3]), "+v"(vq[4]), "+v"(vq[5]), "+v"(vq[6]), "+v"(vq[7]));
#pragma unroll
    for (int i = 0; i < 8; ++i) { const int piece = tid + 512 * i, r = piece >> 4, c = piece & 15;
        *(LAS v4u*)(lds + r * 256 + ((c ^ (r & 15)) << 4)) = kq[i]; }
#pragma unroll
    for (int i = 0; i < 8; ++i) { const int piece = tid + 512 * i, key = piece & 255, dc = piece >> 8;
        const v4u v = vq[i]; const unsigned w[4] = {v.x, v.y, v.z, v.w};
#pragma unroll
        for (int j = 0; j < 8; ++j) { const int d = dc * 8 + j; const unsigned short val = (unsigned short)((j & 1) ? (w[j >> 1] >> 16) : (w[j >> 1] & 0xffffu));
            *(LAS unsigned short*)(lds + 65536 + d * 512 + (((key >> 2) ^ (d & 31)) << 3) + (key & 3) * 2) = val; } }
    __syncthreads();
    const float sc = 0.08838834764831845f * LOG2E;
    int kb[8], vb[8];
#pragma unroll
    for (int ks = 0; ks < 8; ++ks) kb[ks] = r32 * 256 + (((2 * ks + hi) ^ (r32 & 15)) << 4);
#pragma unroll
    for (int c = 0; c < 8; ++c) vb[c] = 65536 + r32 * 512 + ((((c >> 1) * 8 + (c & 1) * 4 + hi) ^ r32) << 3);
#pragma unroll 1
    for (int qb = 0; qb < 2; ++qb) {
        const size_t tok = (size_t)b * SEQ + tc * 512 + wave * 64 + qb * 32 + r32;
        const bf16* qp = qxa + tok * 512 + hh * 128 + hi * 8;
        f32x16 o[4];
#pragma unroll
        for (int db = 0; db < 4; ++db)
#pragma unroll
            for (int r = 0; r < 16; ++r) o[db][r] = 0.f;
        float mrun = 0.f, sum = 0.f;
#pragma unroll
        for (int pass = 0; pass < 4; ++pass) {
            asm volatile("" ::: "memory");
            bf16x8v qf[8];
#pragma unroll
            for (int ks = 0; ks < 8; ++ks) qf[ks] = *(const bf16x8v*)(qp + ks * 16);
            f32x16 s[2];
#pragma unroll
            for (int k2 = 0; k2 < 2; ++k2) { const int kt = 2 * pass + k2;
#pragma unroll
                for (int r = 0; r < 16; ++r) s[k2][r] = 0.f;
#pragma unroll
                for (int ks = 0; ks < 8; ++ks) { const bf16x8v kf = *(const LAS bf16x8v*)(lds + kb[ks] + kt * 8192); s[k2] = __builtin_amdgcn_mfma_f32_32x32x16_bf16(kf, qf[ks], s[k2], 0, 0, 0); }
            }
            float mx = -3.0e38f;
#pragma unroll
            for (int k2 = 0; k2 < 2; ++k2)
#pragma unroll
                for (int r = 0; r < 16; ++r) mx = fmaxf(mx, s[k2][r]);
            mx = pg8::xor32_max(mx);
            if (pass > 0) {
                if (__any((mx - mrun) * sc > 8.0f)) {
                    const float mn = fmaxf(mrun, mx); const float f = __builtin_amdgcn_exp2f((mrun - mn) * sc); mx = mn; sum *= f;
#pragma unroll
                    for (int db = 0; db < 4; ++db)
#pragma unroll
                        for (int r = 0; r < 16; ++r) o[db][r] *= f;
                } else mx = mrun; }
            mrun = mx;
            const float mb = mx * sc;
            bf16x8v pf[4];
#pragma unroll
            for (int k2 = 0; k2 < 2; ++k2) {
#pragma unroll
                for (int r = 0; r < 16; ++r) { const float p = __builtin_amdgcn_exp2f(s[k2][r] * sc - mb); s[k2][r] = p; sum += p; }
                pf[2 * k2] = pack8(s[k2], 0); pf[2 * k2 + 1] = pack8(s[k2], 8);
            }
#pragma unroll
            for (int k2 = 0; k2 < 2; ++k2)
#pragma unroll
                for (int s2 = 0; s2 < 2; ++s2) {
#pragma unroll
                    for (int db = 0; db < 4; ++db) { const int kt = 2 * pass + k2, c = (kt & 3) * 2 + s2, off = (kt >> 2) * 256 + db * 16384;
                        const v2u lo = *(const LAS v2u*)(lds + vb[c] + off), hi2 = *(const LAS v2u*)(lds + (vb[c] ^ 16) + off);
                        v4u vv; vv.x = lo.x; vv.y = lo.y; vv.z = hi2.x; vv.w = hi2.y;
                        o[db] = __builtin_amdgcn_mfma_f32_32x32x16_bf16(__builtin_bit_cast(bf16x8v, vv), pf[2 * k2 + s2], o[db], 0, 0, 0); } }
        }
        sum = pg8::xor32_sum(sum);
        const float inv = 1.0f / sum; unsigned char* op = xo + tok * 512 + hh * 128 + 16 * hi;
#pragma unroll
        for (int db = 0; db < 4; ++db) {
            unsigned w[4];
#pragma unroll
            for (int g = 0; g < 4; ++g) w[g] = pg8::pk4_fp8(o[db][4 * g] * inv, o[db][4 * g + 1] * inv, o[db][4 * g + 2] * inv, o[db][4 * g + 3] * inv);
            pg8::plswap32(w[0], w[1]); pg8::plswap32(w[2], w[3]);
            pg8::plswap32(w[0], w[2]); pg8::plswap32(w[1], w[3]);
            *(v4u*)(op + db * 32) = (v4u){w[0], w[1], w[2], w[3]}; }
    }
    __syncthreads();
}
__device__ __forceinline__ void swa_unit_mfma(const KArgs& args, LAS unsigned char* lds, int tb_off, int l, int unit, int tid) {
    asm volatile("" : "+v"(tid));
    const int lane = tid & 63, wave = __builtin_amdgcn_readfirstlane(tid >> 6), r32 = lane & 31, hi = lane >> 5;
    const int b = unit >> 5, n = unit & 31; const size_t row0 = (size_t)b * SEQ + (size_t)n * 128;
    const bf16* proj = (const bf16*)(args.ws() + WS_PROJ); bf16* mixed = (bf16*)(args.ws() + WS_MIXED);
    v4u kq[8], vq[8];
#pragma unroll
    for (int i = 0; i < 8; ++i) { const int piece = tid + 512 * i, c = piece & 7, key = (piece >> 3) & 255, kvh = piece >> 11; const bool ok = n > 0 || key >= 128;
        kq[i] = *(const v4u*)(proj + (ok ? row0 - 128 + key : row0) * INCOLS + 512 + kvh * 64 + c * 8); }
#pragma unroll
    for (int i = 0; i < 8; ++i) { const int piece = tid + 512 * i, key = piece & 255, dc = (piece >> 8) & 7, kvh = piece >> 11; const bool ok = n > 0 || key >= 128;
        vq[i] = *(const v4u*)(proj + (ok ? row0 - 128 + key : row0) * INCOLS + 640 + kvh * 64 + dc * 8); }
#pragma unroll
    for (int i = 0; i < 8; ++i) { const int piece = tid + 512 * i, c = piece & 7, key = (piece >> 3) & 255, kvh = piece >> 11;
        v4u v = kq[i]; if (!(n > 0 || key >= 128)) v = (v4u){0u, 0u, 0u, 0u};
        *(LAS v4u*)(lds + kvh * 32768 + key * 128 + ((c ^ ((key >> 1) & 7)) << 4)) = v; }
#pragma unroll
    for (int i = 0; i < 8; ++i) { const int piece = tid + 512 * i, key = piece & 255, dc = (piece >> 8) & 7, kvh = piece >> 11;
        v4u v = vq[i]; if (!(n > 0 || key >= 128)) v = (v4u){0u, 0u, 0u, 0u};
        const unsigned w[4] = {v.x, v.y, v.z, v.w};
#pragma unroll
        for (int j = 0; j < 8; ++j) { const int d = dc * 8 + j; const unsigned short val = (unsigned short)((j & 1) ? (w[j >> 1] >> 16) : (w[j >> 1] & 0xffffu));
            *(LAS unsigned short*)(lds + 65536 + kvh * 32768 + d * 512 + (((key >> 2) ^ (d & 31)) << 3) + (key & 3) * 2) = val; } }
    __syncthreads();
    const int kvh = wave >> 2, hq = wave;
    const float sink2 = args.in[5][l * 8 + hq] * LOG2E;
    const LAS float* T = (const LAS float*)(lds + tb_off) + hq * 192 + (r32 + 160 - 4 * hi);
    const float sc = 0.125f * LOG2E;
    bf16x8v qf[4];
    { const bf16* qp = proj + (row0 + r32) * INCOLS + hq * 64 + hi * 8;
#pragma unroll
      for (int ks = 0; ks < 4; ++ks) qf[ks] = *(const bf16x8v*)(qp + ks * 16); }
#pragma unroll
    for (int j = 0; j < 4; ++j) {
        const size_t tok = row0 + j * 32 + r32;
        f32x16 s[5];
#pragma unroll
        for (int tt = 0; tt < 5; ++tt) {
            const int key = (j + tt) * 32 + r32; const LAS unsigned char* kp = lds + kvh * 32768 + key * 128;
#pragma unroll
            for (int r = 0; r < 16; ++r) s[tt][r] = 0.f;
#pragma unroll
            for (int ks = 0; ks < 4; ++ks) { const bf16x8v kf = *(const LAS bf16x8v*)(kp + (((2 * ks + hi) ^ ((key >> 1) & 7)) << 4)); s[tt] = __builtin_amdgcn_mfma_f32_32x32x16_bf16(kf, qf[ks], s[tt], 0, 0, 0); }
        }
        if (j < 3) { const bf16* qp = proj + (tok + 32) * INCOLS + hq * 64 + hi * 8;
#pragma unroll
            for (int ks = 0; ks < 4; ++ks) qf[ks] = *(const bf16x8v*)(qp + ks * 16); }
        float mx = sink2;
#pragma unroll
        for (int tt = 0; tt < 5; ++tt) { const bool dead = (n == 0) && (j + tt < 4);
#pragma unroll
            for (int r = 0; r < 16; ++r) { float v = s[tt][r] * sc + T[-(32 * tt + (r & 3) + 8 * (r >> 2))]; v = dead ? -1.0e30f : v; s[tt][r] = v; mx = fmaxf(mx, v); } }
        mx = pg8::xor32_max(mx);
        float sum = 0.f;
#pragma unroll
        for (int tt = 0; tt < 5; ++tt)
#pragma unroll
            for (int r = 0; r < 16; ++r) { const float p = __builtin_amdgcn_exp2f(s[tt][r] - mx); s[tt][r] = p; sum += p; }
        sum = pg8::xor32_sum(sum);
        sum += __builtin_amdgcn_exp2f(sink2 - mx);
        f32x16 o[2];
#pragma unroll
        for (int db = 0; db < 2; ++db)
#pragma unroll
            for (int r = 0; r < 16; ++r) o[db][r] = 0.f;
#pragma unroll
        for (int tt = 0; tt < 5; ++tt)
#pragma unroll
            for (int s2 = 0; s2 < 2; ++s2) { const bf16x8v pf = pack8(s[tt], 8 * s2); const int q0 = 8 * (j + tt) + 4 * s2 + hi;
#pragma unroll
                for (int db = 0; db < 2; ++db) { const LAS unsigned char* vp = lds + 65536 + kvh * 32768 + (db * 32 + r32) * 512;
                    const v2u lo = *(const LAS v2u*)(vp + ((q0 ^ r32) << 3)), hi2 = *(const LAS v2u*)(vp + (((q0 + 2) ^ r32) << 3));
                    v4u vv; vv.x = lo.x; vv.y = lo.y; vv.z = hi2.x; vv.w = hi2.y;
                    o[db] = __builtin_amdgcn_mfma_f32_32x32x16_bf16(__builtin_bit_cast(bf16x8v, vv), pf, o[db], 0, 0, 0); } }
        const float inv = 1.0f / sum; bf16* op = mixed + tok * D + hq * 64 + 8 * hi;
#pragma unroll
        for (int db = 0; db < 2; ++db)
#pragma unroll
            for (int g = 0; g < 4; g += 2) { unsigned a0 = pg8::cvt_pk_bf16(o[db][4 * g] * inv, o[db][4 * g + 1] * inv), a1 = pg8::cvt_pk_bf16(o[db][4 * g + 2] * inv, o[db][4 * g + 3] * inv);
                unsigned b0 = pg8::cvt_pk_bf16(o[db][4 * g + 4] * inv, o[db][4 * g + 5] * inv), b1 = pg8::cvt_pk_bf16(o[db][4 * g + 6] * inv, o[db][4 * g + 7] * inv);
                pg8::plswap32(a0, b0); pg8::plswap32(a1, b1);
                *(v4u*)(op + db * 32 + 8 * g) = (v4u){a0, a1, b0, b1}; }
    }
    __syncthreads();
}

__device__ __forceinline__ int rg_sw(int t) { return ((t >> 4) & 1) * 8 + (t & 7); }
__device__ __forceinline__ void rg_conv_to_lds(const KArgs& args, LAS unsigned char* lds, int l, int unit, int tid) {
    const int b = unit >> 5, n = unit & 31, ch = tid & 31, c0 = ch * 8; const size_t row0 = (size_t)b * SEQ + (size_t)n * 128;
    const bf16* proj = (const bf16*)(args.ws() + WS_PROJ);
    float cw[4][8], cb[8];
    { const float* w = args.in[8] + (size_t)l * 4 * 256 + c0; const float* bb = args.in[9] + l * 256 + c0;
#pragma unroll
      for (int k = 0; k < 4; ++k) { const f32x4 a = *(const f32x4*)(w + k * 256), c = *(const f32x4*)(w + k * 256 + 4); cw[k][0] = a[0]; cw[k][1] = a[1]; cw[k][2] = a[2]; cw[k][3] = a[3]; cw[k][4] = c[0]; cw[k][5] = c[1]; cw[k][6] = c[2]; cw[k][7] = c[3]; }
      const f32x4 a = *(const f32x4*)bb, c = *(const f32x4*)(bb + 4); cb[0] = a[0]; cb[1] = a[1]; cb[2] = a[2]; cb[3] = a[3]; cb[4] = c[0]; cb[5] = c[1]; cb[6] = c[2]; cb[7] = c[3]; }
    const int t0 = (tid >> 5) * 8;
    v4u xr[11];
#pragma unroll
    for (int r = 0; r < 11; ++r) { const int tt = t0 - 3 + r; xr[r] = (v4u){0u, 0u, 0u, 0u}; if (n > 0 || tt >= 0) xr[r] = *(const v4u*)(proj + (row0 + tt) * INCOLS + 1536 + c0); }
#pragma unroll
    for (int i = 0; i < 8; ++i) {
        const int t = t0 + i;
        float acc[8];
#pragma unroll
        for (int j = 0; j < 8; ++j) acc[j] = cb[j];
#pragma unroll
        for (int k = 0; k < 4; ++k) { const v4u v = xr[i + k];
            acc[0] += cw[k][0] * bflo(v.x); acc[1] += cw[k][1] * bfhi(v.x); acc[2] += cw[k][2] * bflo(v.y); acc[3] += cw[k][3] * bfhi(v.y);
            acc[4] += cw[k][4] * bflo(v.z); acc[5] += cw[k][5] * bfhi(v.z); acc[6] += cw[k][6] * bflo(v.w); acc[7] += cw[k][7] * bfhi(v.w); }
        v4u o; o.x = pg8::cvt_pk_bf16(acc[0], acc[1]); o.y = pg8::cvt_pk_bf16(acc[2], acc[3]); o.z = pg8::cvt_pk_bf16(acc[4], acc[5]); o.w = pg8::cvt_pk_bf16(acc[6], acc[7]);
        *(LAS v4u*)(lds + t * 512 + ((ch ^ rg_sw(t & 31)) << 4)) = o;
    }
}
template <int PASS> __device__ __forceinline__ void rg_scan_mfma(const KArgs& args, LAS unsigned char* lds, int l, int unit, int tid) {
    const int lane = tid & 63, wave = __builtin_amdgcn_readfirstlane(tid >> 6), r32 = lane & 31, hi = lane >> 5;
    const int hh = wave >> 1, nb = wave & 1, c = hh * 64 + nb * 32 + r32, b = unit >> 5, n = unit & 31; const size_t row0 = (size_t)b * SEQ + (size_t)n * 128;
    const bf16* rgw = (const bf16*)(args.ws() + WS_RGW) + (size_t)(l * 2) * 4 * 4096 + (size_t)hh * 4096 + (size_t)(nb * 32 + r32) * 64 + hi * 8;
    bf16x8v waf[4], wxf[4];
#pragma unroll
    for (int ks = 0; ks < 4; ++ks) { waf[ks] = *(const bf16x8v*)(rgw + ks * 16); wxf[ks] = *(const bf16x8v*)(rgw + 4 * 4096 + ks * 16); }
    const float ba = args.in[11][l * 256 + c], bx = args.in[13][l * 256 + c], lam = args.in[14][l * 256 + c];
    const float c8 = -8.0f * log1pf(expf(-lam)) * LOG2E;
    const float ba2 = -ba * LOG2E, bx2 = -bx * LOG2E;
    float* rgsum = (float*)(args.ws() + WS_RGSUM);
    float carry = 0.f, Atot = 1.f;
    if (PASS == 2) { for (int j = 0; j < n; ++j) { const float aj = rgsum[(size_t)(b * 32 + j) * 512 + c], hj = rgsum[(size_t)(b * 32 + j) * 512 + 256 + c]; carry = aj * carry + hj; } }
    const int atok = 16 * ((r32 >> 2) & 1) + (r32 & 3) + 4 * (r32 >> 3);
    const bf16* proj = (const bf16*)(args.ws() + WS_PROJ); bf16* mixed = (bf16*)(args.ws() + WS_MIXED);
#pragma unroll 1
    for (int sc = 0; sc < 4; ++sc) {
        f32x16 rp, ip;
        unsigned short gq[16];
        if (PASS == 2) {
#pragma unroll
            for (int r = 0; r < 16; ++r) gq[r] = proj[(row0 + sc * 32 + 16 * hi + r) * INCOLS + 1792 + c]; }
#pragma unroll
        for (int r = 0; r < 16; ++r) { rp[r] = ba2; ip[r] = bx2; }
        { const int t = sc * 32 + atok; const LAS unsigned char* ap = lds + t * 512; const int sw = rg_sw(atok);
#pragma unroll
          for (int ks = 0; ks < 4; ++ks) { const bf16x8v af = *(const LAS bf16x8v*)(ap + (((8 * hh + 2 * ks + hi) ^ sw) << 4));
              rp = __builtin_amdgcn_mfma_f32_32x32x16_bf16(af, waf[ks], rp, 0, 0, 0); ip = __builtin_amdgcn_mfma_f32_32x32x16_bf16(af, wxf[ks], ip, 0, 0, 0); } }
        float hl[16], ac[16]; float hrun = 0.f, arun = 1.f;
#pragma unroll
        for (int r = 0; r < 16; ++r) { const int tl = 16 * hi + r, t = sc * 32 + tl;
            const float xin = bf2f(*(const LAS unsigned short*)(lds + t * 512 + ((((c >> 3)) ^ rg_sw(tl)) << 4) + (c & 7) * 2));
            const float rg = __builtin_amdgcn_rcpf(1.0f + __builtin_amdgcn_exp2f(rp[r])), di = 1.0f + __builtin_amdgcn_exp2f(ip[r]);
            const float a = __builtin_amdgcn_exp2f(c8 * rg);
            const float y = fmaxf(1.0f - a * a, 1.0e-30f);
            const float u = (y * __builtin_amdgcn_rsqf(y * di * di)) * xin;
            hrun = a * hrun + u; arun *= a; hl[r] = hrun; ac[r] = arun; }
        const float a_o = pg8::xor32_other(arun, hi), h_o = pg8::xor32_other(hrun, hi);
        const float hin = hi ? (a_o * carry + h_o) : carry;
        const float hend = hl[15] + ac[15] * hin;
        const float hend_hi = __shfl(hend, r32 + 32);
        if (PASS == 1) {
            const float Ag = hi ? Atot * a_o : Atot;
            unsigned* rgc = (unsigned*)(args.ws() + WS_RGC) + (row0 + sc * 32 + 16 * hi) * 256 + c;
#pragma unroll
            for (int r = 0; r < 16; ++r) rgc[r * 256] = pg8::cvt_pk_bf16(hl[r] + ac[r] * hin, ac[r] * Ag);
            Atot *= arun * a_o; }
        if (PASS == 2) {
#pragma unroll
            for (int r = 0; r < 16; ++r) { const size_t row = row0 + sc * 32 + 16 * hi + r; const float h = hl[r] + ac[r] * hin;
                const float g = bf2f(gq[r]); mixed[row * D + 768 + c] = (bf16)f2bf(h * gelu_tanh(g)); } }
        carry = hend_hi;
    }
    if (PASS == 1 && hi == 0) { rgsum[(size_t)unit * 512 + c] = Atot; rgsum[(size_t)unit * 512 + 256 + c] = carry; }
}
__device__ __forceinline__ void sc_conv_vec(const KArgs& args, int l, int unit, int tid) {
    const int b = unit >> 5, n = unit & 31, c0 = (tid & 31) * 8; const size_t row0 = (size_t)b * SEQ + (size_t)n * 128;
    const bf16* proj = (const bf16*)(args.ws() + WS_PROJ); bf16* mixed = (bf16*)(args.ws() + WS_MIXED);
    float cw[3][8], cb[8];
    { const float* w = args.in[6] + (size_t)l * 3 * 256 + c0; const float* bb = args.in[7] + l * 256 + c0;
#pragma unroll
      for (int k = 0; k < 3; ++k) { const f32x4 a = *(const f32x4*)(w + k * 256), c = *(const f32x4*)(w + k * 256 + 4); cw[k][0] = a[0]; cw[k][1] = a[1]; cw[k][2] = a[2]; cw[k][3] = a[3]; cw[k][4] = c[0]; cw[k][5] = c[1]; cw[k][6] = c[2]; cw[k][7] = c[3]; }
      const f32x4 a = *(const f32x4*)bb, c = *(const f32x4*)(bb + 4); cb[0] = a[0]; cb[1] = a[1]; cb[2] = a[2]; cb[3] = a[3]; cb[4] = c[0]; cb[5] = c[1]; cb[6] = c[2]; cb[7] = c[3]; }
    const int t0 = (tid >> 5) * 8;
    v4u cr[10], xr[10], br[8];
#pragma unroll
    for (int r = 0; r < 10; ++r) { const int tt = t0 - 2 + r; cr[r] = (v4u){0u, 0u, 0u, 0u}; xr[r] = cr[r];
        if (n > 0 || tt >= 0) { const bf16* p = proj + (row0 + tt) * INCOLS + 1024 + c0; cr[r] = *(const v4u*)p; xr[r] = *(const v4u*)(p + 256); } }
#pragma unroll
    for (int i = 0; i < 8; ++i) br[i] = *(const v4u*)(proj + (row0 + t0 + i) * INCOLS + 768 + c0);
    float u[10][8];
#pragma unroll
    for (int r = 0; r < 10; ++r) { u[r][0] = bflo(cr[r].x) * bflo(xr[r].x); u[r][1] = bfhi(cr[r].x) * bfhi(xr[r].x); u[r][2] = bflo(cr[r].y) * bflo(xr[r].y); u[r][3] = bfhi(cr[r].y) * bfhi(xr[r].y);
        u[r][4] = bflo(cr[r].z) * bflo(xr[r].z); u[r][5] = bfhi(cr[r].z) * bfhi(xr[r].z); u[r][6] = bflo(cr[r].w) * bflo(xr[r].w); u[r][7] = bfhi(cr[r].w) * bfhi(xr[r].w); }
#pragma unroll
    for (int i = 0; i < 8; ++i) {
        float acc[8];
#pragma unroll
        for (int j = 0; j < 8; ++j) acc[j] = cb[j] + cw[0][j] * u[i][j] + cw[1][j] * u[i + 1][j] + cw[2][j] * u[i + 2][j];
        const v4u vb = br[i];
        v4u o; o.x = pg8::cvt_pk_bf16(acc[0] * bflo(vb.x), acc[1] * bfhi(vb.x)); o.y = pg8::cvt_pk_bf16(acc[2] * bflo(vb.y), acc[3] * bfhi(vb.y));
        o.z = pg8::cvt_pk_bf16(acc[4] * bflo(vb.z), acc[5] * bfhi(vb.z)); o.w = pg8::cvt_pk_bf16(acc[6] * bflo(vb.w), acc[7] * bfhi(vb.w));
        *(v4u*)(mixed + (row0 + t0 + i) * D + 512 + c0) = o;
    }
}
__device__ __forceinline__ void rg_out_vec(const KArgs& args, int l, int unit, int tid) {
    (void)l;
    const int b = unit >> 5, n = unit & 31, c0 = (tid & 31) * 8, t0 = (tid >> 5) * 8; const size_t row0 = (size_t)b * SEQ + (size_t)n * 128;
    const bf16* proj = (const bf16*)(args.ws() + WS_PROJ); bf16* mixed = (bf16*)(args.ws() + WS_MIXED); const unsigned* rgc = (const unsigned*)(args.ws() + WS_RGC);
    v4u q0[8], q1[8], gq[8];
#pragma unroll
    for (int i = 0; i < 8; ++i) { const size_t row = row0 + t0 + i; q0[i] = *(const v4u*)(rgc + row * 256 + c0); q1[i] = *(const v4u*)(rgc + row * 256 + c0 + 4); gq[i] = *(const v4u*)(proj + row * INCOLS + 1792 + c0); }
    float carry[8];
#pragma unroll
    for (int k = 0; k < 8; ++k) carry[k] = 0.f;
    const float* rgsum = (const float*)(args.ws() + WS_RGSUM) + (size_t)(b * 32) * 512 + c0;
#pragma unroll 4
    for (int j = 0; j < n; ++j) { const f32x4 a0 = *(const f32x4*)(rgsum + j * 512), a1 = *(const f32x4*)(rgsum + j * 512 + 4), h0 = *(const f32x4*)(rgsum + j * 512 + 256), h1 = *(const f32x4*)(rgsum + j * 512 + 260);
#pragma unroll
        for (int k = 0; k < 4; ++k) { carry[k] = a0[k] * carry[k] + h0[k]; carry[4 + k] = a1[k] * carry[4 + k] + h1[k]; } }
#pragma unroll
    for (int i = 0; i < 8; ++i) { const unsigned w[8] = {q0[i].x, q0[i].y, q0[i].z, q0[i].w, q1[i].x, q1[i].y, q1[i].z, q1[i].w}; const unsigned gw[4] = {gq[i].x, gq[i].y, gq[i].z, gq[i].w};
        float o[8];
#pragma unroll
        for (int k = 0; k < 8; ++k) { const float g = (k & 1) ? bfhi(gw[k >> 1]) : bflo(gw[k >> 1]); o[k] = (bflo(w[k]) + bfhi(w[k]) * carry[k]) * gelu_tanh(g); }
        v4u ov; ov.x = pg8::cvt_pk_bf16(o[0], o[1]); ov.y = pg8::cvt_pk_bf16(o[2], o[3]); ov.z = pg8::cvt_pk_bf16(o[4], o[5]); ov.w = pg8::cvt_pk_bf16(o[6], o[7]);
        *(v4u*)(mixed + (row0 + t0 + i) * D + 768 + c0) = ov; }
}

constexpr int NPHASES = 24;
__global__ void __launch_bounds__(NWAVES * 64, 2) hymba_fwd(Args kernarg_block) {
    KArgs args; int lo, hi; { const unsigned long long pp = ldkarg(33); lo = (int)(unsigned)pp; hi = (int)(unsigned)(pp >> 32); }
    extern __shared__ __attribute__((aligned(16))) unsigned char lds_raw[];
    LAS unsigned char* lds = (LAS unsigned char*)lds_raw;
    volatile LAS unsigned* MISC = (volatile LAS unsigned*)(lds + MISC_OFF);
    const int G = gridDim.x, bid = blockIdx.x;
#define ws (args.ws())
#define xres (args.out())
#define rowsq ((float*)(ws + WS_ROWSQ))
#define xb ((bf16*)(ws + WS_XB))
    gu32* ctl = (gu32*)(ws + WS_CTL);
    for (int u = threadIdx.x; u < (LDS_BYTES - LDSCTL_OFF) / 4; u += NWAVES * 64) ((LAS unsigned*)(lds + LDSCTL_OFF))[u] = 0u;
    __syncthreads();
#if MK_ONE_LAUNCH
    XcdBarrier bar = xcd_barrier_post((unsigned*)(ctl + CW_BAR), MISC + 8);
#define GRID_BAR() xcd_barrier(bar)
#else
    (void)MISC;
#define GRID_BAR() do { } while (0)
#endif
    int ph = 0;
#define PHASE_BEGIN if (lo <= ph && ph < hi) { int tid_p = threadIdx.x; asm volatile("" : "+v"(tid_p)); const int tid = tid_p, lane = tid & 63, wave = __builtin_amdgcn_readfirstlane(tid >> 6); (void)lane; (void)wave;
#define PHASE_END if (ph + 1 < hi) { GRID_BAR(); } else { VM_WAIT(); __syncthreads(); } } ++ph;

    PHASE_BEGIN
    {
        const int gw = bid * NWAVES + wave, NGW = G * NWAVES;
        if (gw < N_CONV_ITEMS) {
            ConvItem d0 = conv_decode(args, gw); float va[64]; conv_load(d0, va, lane);
#pragma unroll 1
            for (int it = gw; it < N_CONV_ITEMS; it += NGW) {
                const int itn = it + NGW; const bool hn = itn < N_CONV_ITEMS;
                ConvItem d1 = d0; float vb[64];
                if (hn) { d1 = conv_decode(args, itn); conv_load(d1, vb, lane); }
                conv_finish(d0, va, lane);
                if (hn) {
#pragma unroll
                    for (int i = 0; i < 64; ++i) va[i] = vb[i];
                    d0 = d1; }
            }
        }
        float* memsq = (float*)(ws + WS_MEMSQ); bf16* memb = (bf16*)(ws + WS_MEMB);
        for (int m0 = gw; m0 < M + MROWS; m0 += 2 * NGW) {
            f32x4 v[2][4]; bool ok[2]; int mm[2]; bool isx[2];
#pragma unroll
            for (int u = 0; u < 2; ++u) { const int m = m0 + u * NGW; ok[u] = m < M + MROWS; isx[u] = m < M; mm[u] = isx[u] ? m : m - M;
                if (ok[u]) { const GAS f32x4* src = (const GAS f32x4*)((isx[u] ? args.in[0] : args.in[1]) + (size_t)mm[u] * D) + lane;
#pragma unroll
                    for (int j = 0; j < 4; ++j) v[u][j] = src[64 * j]; } }
#pragma unroll
            for (int u = 0; u < 2; ++u) if (ok[u]) { float s = 0.f;
#pragma unroll
                for (int j = 0; j < 4; ++j) s += (v[u][j].x * v[u][j].x + v[u][j].y * v[u][j].y) + (v[u][j].z * v[u][j].z + v[u][j].w * v[u][j].w);
                s = wave_sum(s);
                if (lane == 0) { *(f32x4*)((isx[u] ? rowsq : memsq) + (size_t)mm[u] * 4) = (f32x4){s, 0.f, 0.f, 0.f}; }
                GAS v2u* o8 = (GAS v2u*)((isx[u] ? xb : memb) + (size_t)mm[u] * D) + lane;
#pragma unroll
                for (int j = 0; j < 4; ++j) { v2u w; w.x = pg8::cvt_pk_bf16(v[u][j].x, v[u][j].y); w.y = pg8::cvt_pk_bf16(v[u][j].z, v[u][j].w); o8[64 * j] = w; } }
        }
    }
    PHASE_END

    {
        constexpr int l = 0;
        PHASE_BEGIN
        {
            pg8::Gemm g{xb, (const bf16*)(ws + WS_WIN) + (size_t)l * 2048 * 1024, M, INCOLS, 1024}; pg8::StaticOrder S; S.init(M, INCOLS, G, bid);
            pg8::EpiScaleBf16 E{(bf16*)(ws + WS_PROJ), INCOLS, rowsq + (size_t)(3 * l) * M * 4, 1.0f};
            pg8::gemm_phase<pg8::EpiScaleBf16, pg8::StaticOrder, true, true>(lds + RING_OFF, g, S, E);
        }
        PHASE_END
        PHASE_BEGIN
        {
            int u0 = bid, ustep = G;
            if (l == 0) {
                const int nkv = (G >= 128) ? 64 : G;
                if (bid < nkv) {
                    pg8::Gemm g{(const bf16*)(ws + WS_MEMB), (const bf16*)(ws + WS_WKV), MROWS, 2048, 1024}; pg8::StaticOrder S; S.init(MROWS, 2048, nkv, bid);
                    pg8::EpiScaleBf16 E{(bf16*)(ws + WS_KVMEM), 2048, (const float*)(ws + WS_MEMSQ), 1.0f};
                    pg8::gemm_phase<pg8::EpiScaleBf16, pg8::StaticOrder, true, true>(lds + RING_OFF, g, S, E);
                    __syncthreads();
                }
                if (G >= 128) { u0 = (bid < nkv) ? 256 : bid - nkv; ustep = G - nkv; }
            }
            for (int unit = u0; unit < 256; unit += ustep) {
                { int t0 = threadIdx.x; asm volatile("" : "+v"(t0)); rg_conv_to_lds(args, lds, l, unit, t0); }
                __syncthreads();
                { int t1 = threadIdx.x; asm volatile("" : "+v"(t1)); rg_scan_mfma<1>(args, lds, l, unit, t1); }
                __syncthreads();
            }
        }
        PHASE_END
        PHASE_BEGIN
        {
            constexpr int TB_OFF = LDSCTL_OFF + 6144;
            if (tid < 192) { const int dist = tid - 32; int bk = dist;
                if (dist >= 16) { const float v = logf((float)dist / 16.0f) / logf(8.0f) * 16.0f; bk = 16 + (int)v; if (bk > 31) bk = 31; }
                const bool ok = dist >= 0 && dist < 128;
                const float* bp = args.in[2] + (ok ? bk : 0) * 8; const f32x4 b0 = *(const f32x4*)bp, b1 = *(const f32x4*)(bp + 4);
                const float bv[8] = {b0[0], b0[1], b0[2], b0[3], b1[0], b1[1], b1[2], b1[3]};
#pragma unroll
                for (int h = 0; h < 8; ++h) ((LAS float*)(lds + TB_OFF))[h * 192 + tid] = ok ? bv[h] * LOG2E : -1.0e30f; }
            __syncthreads();
            for (int unit = bid; unit < 256; unit += G) {
                { int t1 = threadIdx.x; asm volatile("" : "+v"(t1)); rg_out_vec(args, l, unit, t1); }
                { int t3 = threadIdx.x; asm volatile("" : "+v"(t3)); sc_conv_vec(args, l, unit, t3); }
                { int t2 = threadIdx.x; asm volatile("" : "+v"(t2)); swa_unit_mfma(args, lds, TB_OFF, l, unit, t2); }
            }
        }
        PHASE_END
        PHASE_BEGIN
        {
            pg8::Gemm g{(const bf16*)(ws + WS_MIXED), (const bf16*)(ws + WS_WOUT) + (size_t)l * 1024 * 1024, M, D, 1024}; pg8::StaticOrder S; S.init(M, D, G, bid);
            pg8::EpiResid E{xb, rowsq + (size_t)(3 * l + 1) * M * 4, (LAS float*)(lds + RED_OFF), (unsigned char*)(ws + WS_X8), 1.0f};
            pg8::gemm_phase<pg8::EpiResid, pg8::StaticOrder, true, true>(lds + RING_OFF, g, S, E);
        }
        PHASE_END
        PHASE_BEGIN
        {
            pg8::Gemm g{(const bf16*)(ws + WS_X8), (const bf16*)(ws + WS_WXQ + (size_t)l * 512 * 1024), M, 512, 1024}; pg8::StaticOrder S; S.init(M, 512, G, bid);
            pg8::EpiScaleBf16 E{(bf16*)(ws + WS_QXA), 512, rowsq + (size_t)(3 * l + 1) * M * 4, 1.0f / W8_SCALE};
            pg8::gemm_phase<pg8::EpiScaleBf16, pg8::StaticOrder, true, true, true>(lds + RING_OFF, g, S, E);
        }
        PHASE_END
        PHASE_BEGIN
        {
            for (int unit = bid; unit < 256; unit += G) xa_unit_mfma(args, lds, l, unit, tid);
        }
        PHASE_END
        PHASE_BEGIN
        {
            pg8::Gemm g{(const bf16*)(ws + WS_XO), (const bf16*)(ws + WS_WXO + (size_t)l * 1024 * 512), M, D, 512}; pg8::StaticOrder S; S.init(M, D, G, bid);
            pg8::EpiResid E{xb, rowsq + (size_t)(3 * l + 2) * M * 4, (LAS float*)(lds + RED_OFF), l == 1 ? (unsigned char*)(ws + WS_X8) : nullptr, 1.0f / W8_SCALE};
            pg8::gemm_phase<pg8::EpiResid, pg8::StaticOrder, true, true, true>(lds + RING_OFF, g, S, E);
        }
        PHASE_END
        if (l == 0) {
            PHASE_BEGIN
            {
                pg8::Gemm g{xb, (const bf16*)(ws + WS_WDGU), M, 2 * FFD, 1024}; pg8::StaticOrder S; S.init(M, 2 * FFD, G, bid);
                pg8::EpiSwigluF8<false> E{(unsigned char*)(ws + WS_HD), FFD, rowsq + (size_t)2 * M * 4, 0, 2 * FFD / 256, 1.0f};
                pg8::gemm_phase<pg8::EpiSwigluF8<false>, pg8::StaticOrder, true, true>(lds + RING_OFF, g, S, E);
            }
            PHASE_END
            PHASE_BEGIN
            {
                pg8::Gemm g{(const bf16*)(ws + WS_HD), (const bf16*)(ws + WS_WDD), M, D, FFD}; pg8::StaticOrder S; S.init(M, D, G, bid);
                pg8::EpiResid E{xb, rowsq + (size_t)3 * M * 4, (LAS float*)(lds + RED_OFF), nullptr, 1.0f / W8_SCALE};
                pg8::gemm_phase<pg8::EpiResid, pg8::StaticOrder, true, true, true>(lds + RING_OFF, g, S, E);
            }
            PHASE_END
        } else {
            int* tok_e = (int*)(ws + WS_TOKE); float* tok_w = (float*)(ws + WS_TOKW); int* tok_p = (int*)(ws + WS_TOKP); float* tok_r = (float*)(ws + WS_TOKR);
            int* slot_tok = (int*)(ws + WS_SLOTT); float* slot_gate = (float*)(ws + WS_SLOTG); float* slot_rstd = (float*)(ws + WS_SLOTR);
            int* tile_e = (int*)(ws + WS_TILEE); int* wgcnt = (int*)(ws + WS_WGCNT); int* wvbase = (int*)(ws + WS_WVCNT);
            PHASE_BEGIN
            {
                LAS unsigned char* Rt = lds;
                LAS float* Dl = (LAS float*)(lds + 32768);
                LAS int* wcnt = (LAS int*)(lds + 32768 + 8192);
                { const float* rp = args.in[26]; const float* gp = args.in[22] + 1024;
#pragma unroll
                  for (int i = 0; i < 16; ++i) { const int q = tid + i * NWAVES * 64, k = q >> 3, e = q & 7; const float v = rp[q] * gp[k];
                      const unsigned hb = f2bf(v); const unsigned lb = f2bf(v - __builtin_bit_cast(float, hb << 16));
                      *(LAS unsigned short*)(Rt + e * 2048 + (((k >> 3) ^ e) << 4) + (k & 7) * 2) = (unsigned short)hb;
                      *(LAS unsigned short*)(Rt + (8 + e) * 2048 + (((k >> 3) ^ (8 + e)) << 4) + (k & 7) * 2) = (unsigned short)lb; } }
                for (int tb = bid; tb < 256; tb += G) {
                    __syncthreads();
                    if (tid < 64) wcnt[tid] = 0;
                    __syncthreads();
                    if (wave < 4) {
                        const int r32 = lane & 31, hi = lane >> 5; const int t = tb * 128 + wave * 32 + r32;
                        const bf16* xp = xb + (size_t)t * D + hi * 8;
                        f32x16 acc;
#pragma unroll
                        for (int r = 0; r < 16; ++r) acc[r] = 0.f;
#pragma unroll 1
                        for (int ks0 = 0; ks0 < 64; ks0 += 8) {
                            bf16x8v a[8];
#pragma unroll
                            for (int j = 0; j < 8; ++j) a[j] = *(const bf16x8v*)(xp + (ks0 + j) * 16);
#pragma unroll
                            for (int j = 0; j < 8; ++j) { const int ks = ks0 + j; v4u bz = (v4u){0u, 0u, 0u, 0u};
                                if (r32 < 16) bz = *(const LAS v4u*)(Rt + r32 * 2048 + (((2 * ks + hi) ^ r32) << 4));
                                acc = __builtin_amdgcn_mfma_f32_32x32x16_bf16(a[j], __builtin_bit_cast(bf16x8v, bz), acc, 0, 0, 0); }
                        }
                        LAS float* dw = Dl + wave * 512;
                        if (r32 < 16) {
#pragma unroll
                            for (int r = 0; r < 16; ++r) dw[((r & 3) + 8 * (r >> 2) + 4 * hi) * 16 + r32] = acc[r]; }
                        LDS_WAIT();
                        int e1 = -1, e2 = -1; float w1 = 0.f, w2 = 0.f, rs = 0.f;
                        if (lane < 32) {
                            const f32x4 pq = *(const f32x4*)(rowsq + ((size_t)5 * M + t) * 4);
                            rs = pg8::rstd_of((pq[0] + pq[1]) + (pq[2] + pq[3]));
                            float lg[8];
#pragma unroll
                            for (int e = 0; e < 8; ++e) lg[e] = (dw[lane * 16 + e] + dw[lane * 16 + 8 + e]) * rs;
                            e1 = 0; float l1 = lg[0];
#pragma unroll
                            for (int e = 1; e < 8; ++e) if (lg[e] > l1) { l1 = lg[e]; e1 = e; }
                            float l2 = -3.0e38f;
#pragma unroll
                            for (int e = 0; e < 8; ++e) if (e != e1 && lg[e] > l2) { l2 = lg[e]; e2 = e; }
                            w2 = 1.0f / (1.0f + expf(l1 - l2)); w1 = 1.0f - w2;
                        }
                        int p1 = 0, p2 = 0, cnt_e = 0;
#pragma unroll
                        for (int e = 0; e < 8; ++e) { const unsigned long long m = __ballot((e1 == e) || (e2 == e)); const int rk = __popcll(m & ((1ull << lane) - 1ull));
                            if (e1 == e) p1 = rk; if (e2 == e) p2 = rk; if (lane == e) cnt_e = __popcll(m); }
                        if (lane < 8) wcnt[wave * 8 + lane] = cnt_e;
                        if (lane < 32) { tok_e[2 * t] = e1; tok_e[2 * t + 1] = e2; tok_w[2 * t] = w1; tok_w[2 * t + 1] = w2; tok_p[2 * t] = p1; tok_p[2 * t + 1] = p2; tok_r[t] = rs; }
                    }
                    __syncthreads();
                    if (tid < 8) { int s = 0; for (int w = 0; w < 8; ++w) { const int c = wcnt[w * 8 + tid]; wvbase[(tb * 8 + w) * 8 + tid] = s; s += c; } wgcnt[tb * 8 + tid] = s; }
                }
            }
            PHASE_END
            PHASE_BEGIN
            {
                LAS int* tot = (LAS int*)lds; LAS int* offs = (LAS int*)(lds + 64); LAS int* base = (LAS int*)(lds + 128);
                LAS int* cl = (LAS int*)(lds + 1024);
                LAS int* ps = (LAS int*)(lds + 1024 + 8192);
                LAS int* pb = (LAS int*)(lds + 1024 + 8192 + 2048);
                for (int i = tid; i < 2048; i += NWAVES * 64) cl[i] = wgcnt[i];
                __syncthreads();
                for (int tb = bid; tb < 256; tb += G) {
                    { const int e = tid & 7, part = tid >> 3; int s = 0, sb = 0;
#pragma unroll
                      for (int j = 0; j < 4; ++j) { const int w = part * 4 + j; const int c = cl[w * 8 + e]; s += c; sb += (w < tb) ? c : 0; }
                      ps[tid] = s; pb[tid] = sb; }
                    __syncthreads();
                    if (tid < 8) { int s = 0, sb = 0;
#pragma unroll 8
                        for (int part = 0; part < 64; ++part) { s += ps[part * 8 + tid]; sb += pb[part * 8 + tid]; }
                        tot[tid] = s; base[tid] = sb; }
                    __syncthreads();
                    if (tid == 0) { int o = 0; for (int e = 0; e < 8; ++e) { offs[e] = o; o += (tot[e] + 255) & ~255; } offs[8] = o; }
                    __syncthreads();
                    if (tb == 0) {
                        if (tid == 0) { int nt = 0; for (int e = 0; e < 8; ++e) { const int k = (offs[e + 1] - offs[e]) >> 8; for (int j = 0; j < k; ++j) tile_e[nt++] = e; } tile_e[300] = nt; }
                        for (int e = 0; e < 8; ++e) for (int s = offs[e] + tot[e] + tid; s < offs[e + 1]; s += NWAVES * 64) slot_tok[s] = -1;
                    }
                    if (tid < 256) {
                        const int p = tid, t = tb * 128 + (p >> 1), k = p & 1;
                        const int e = tok_e[2 * t + k]; const int slot = offs[e] + base[e] + wvbase[(tb * 8 + (p >> 6)) * 8 + e] + tok_p[2 * t + k];
                        slot_tok[slot] = t | (k << 24); slot_gate[slot] = tok_w[2 * t + k]; slot_rstd[slot] = tok_r[t];
                    }
                    __syncthreads();
                }
            }
            PHASE_END
            PHASE_BEGIN
            {
                const int nt = __builtin_amdgcn_readfirstlane(__hip_atomic_load(tile_e + 300, RLX_AGENT)); const int ntA = nt - GTILES;
                LAS int* te_lds = (LAS int*)(lds + LDSCTL_OFF + 6144);
                for (int i = tid; i < nt; i += NWAVES * 64) te_lds[i] = __hip_atomic_load(tile_e + i, RLX_AGENT);
                __syncthreads();
                pg8::Gemm g{(const bf16*)(ws + WS_X8), (const bf16*)(ws + WS_WMGU), 0, 0, 1024}; pg8::MoeGatherOrder S; S.init(ntA, 2 * FFE / 256, G, bid, 0, 0, te_lds); S.slot_tok = slot_tok;
                pg8::EpiSwigluF8<true> E{(unsigned char*)(ws + WS_HG), FFE, slot_rstd, 0, 2 * FFE / 256, 1.0f / W8_SCALE};
                pg8::gemm_phase<pg8::EpiSwigluF8<true>, pg8::MoeGatherOrder, true, true, true>(lds + RING_OFF, g, S, E);
            }
            PHASE_END
            PHASE_BEGIN
            {
                const int nt = __builtin_amdgcn_readfirstlane(__hip_atomic_load(tile_e + 300, RLX_AGENT)); const int ntA = nt - GTILES;
                LAS int* te_lds = (LAS int*)(lds + LDSCTL_OFF + 6144);
                for (int i = tid; i < nt; i += NWAVES * 64) te_lds[i] = __hip_atomic_load(tile_e + i, RLX_AGENT);
                __syncthreads();
                {
                    pg8::Gemm g{(const bf16*)(ws + WS_HG), (const bf16*)(ws + WS_WMD), 0, 0, FFE}; pg8::MoeOrder S; S.init(ntA, D / 256, G, bid, 0, 0, te_lds);
                    pg8::EpiMoeDown E{(unsigned char*)(ws + WS_Y0), (unsigned char*)(ws + WS_Y1), slot_tok, slot_gate, 0, D / 256, 1.0f / W8_SCALE};
                    pg8::gemm_phase<pg8::EpiMoeDown, pg8::MoeOrder, true, true, true>(lds + RING_OFF, g, S, E);
                }
                __syncthreads();
                {
                    const int nmd = ntA * (D / 256);
                    pg8::Gemm g{(const bf16*)(ws + WS_X8), (const bf16*)(ws + WS_WMGU), 0, 0, 1024}; pg8::MoeGatherSkipOrder S; S.init(GTILES, 2 * FFE / 256, G, bid, ntA, ntA, te_lds + ntA); S.slot_tok = slot_tok;
                    S.rem = nmd % G; S.skip = (S.rem == 0) ? 0 : MD_SKIP;
                    pg8::EpiSwigluF8<true> E{(unsigned char*)(ws + WS_HGB), FFE, slot_rstd, ntA, 2 * FFE / 256, 1.0f / W8_SCALE};
                    pg8::gemm_phase<pg8::EpiSwigluF8<true>, pg8::MoeGatherSkipOrder, true, true, true>(lds + RING_OFF, g, S, E);
                }
            }
            PHASE_END
            PHASE_BEGIN
            {
                const int nt = __builtin_amdgcn_readfirstlane(__hip_atomic_load(tile_e + 300, RLX_AGENT)); const int ntA = nt - GTILES;
                LAS int* te_lds = (LAS int*)(lds + LDSCTL_OFF + 6144);
                for (int i = tid; i < nt; i += NWAVES * 64) te_lds[i] = __hip_atomic_load(tile_e + i, RLX_AGENT);
                __syncthreads();
                pg8::Gemm g{(const bf16*)(ws + WS_HGB), (const bf16*)(ws + WS_WMD), 0, 0, FFE}; pg8::MoeOrder S; S.init(GTILES, D / 256, G, bid, 0, ntA, te_lds + ntA);
                pg8::EpiMoeDown E{(unsigned char*)(ws + WS_Y0), (unsigned char*)(ws + WS_Y1), slot_tok, slot_gate, ntA, D / 256, 1.0f / W8_SCALE};
                pg8::gemm_phase<pg8::EpiMoeDown, pg8::MoeOrder, true, true, true>(lds + RING_OFF, g, S, E);
            }
            PHASE_END
        }
    }
    {
        constexpr int l = 1;
        PHASE_BEGIN
        {
            pg8::Gemm g{xb, (const bf16*)(ws + WS_WIN) + (size_t)l * 2048 * 1024, M, INCOLS, 1024}; pg8::StaticOrder S; S.init(M, INCOLS, G, bid);
            pg8::EpiScaleBf16 E{(bf16*)(ws + WS_PROJ), INCOLS, rowsq + (size_t)(3 * l) * M * 4, 1.0f};
            pg8::gemm_phase<pg8::EpiScaleBf16, pg8::StaticOrder, true, true>(lds + RING_OFF, g, S, E);
        }
        PHASE_END
        PHASE_BEGIN
        {
            int u0 = bid, ustep = G;
            if (l == 0) {
                const int nkv = (G >= 128) ? 64 : G;
                if (bid < nkv) {
                    pg8::Gemm g{(const bf16*)(ws + WS_MEMB), (const bf16*)(ws + WS_WKV), MROWS, 2048, 1024}; pg8::StaticOrder S; S.init(MROWS, 2048, nkv, bid);
                    pg8::EpiScaleBf16 E{(bf16*)(ws + WS_KVMEM), 2048, (const float*)(ws + WS_MEMSQ), 1.0f};
                    pg8::gemm_phase<pg8::EpiScaleBf16, pg8::StaticOrder, true, true>(lds + RING_OFF, g, S, E);
                    __syncthreads();
                }
                if (G >= 128) { u0 = (bid < nkv) ? 256 : bid - nkv; ustep = G - nkv; }
            }
            for (int unit = u0; unit < 256; unit += ustep) {
                { int t0 = threadIdx.x; asm volatile("" : "+v"(t0)); rg_conv_to_lds(args, lds, l, unit, t0); }
                __syncthreads();
                { int t1 = threadIdx.x; asm volatile("" : "+v"(t1)); rg_scan_mfma<1>(args, lds, l, unit, t1); }
                __syncthreads();
            }
        }
        PHASE_END
        PHASE_BEGIN
        {
            constexpr int TB_OFF = LDSCTL_OFF + 6144;
            if (tid < 192) { const int dist = tid - 32; int bk = dist;
                if (dist >= 16) { const float v = logf((float)dist / 16.0f) / logf(8.0f) * 16.0f; bk = 16 + (int)v; if (bk > 31) bk = 31; }
                const bool ok = dist >= 0 && dist < 128;
                const float* bp = args.in[2] + (ok ? bk : 0) * 8; const f32x4 b0 = *(const f32x4*)bp, b1 = *(const f32x4*)(bp + 4);
                const float bv[8] = {b0[0], b0[1], b0[2], b0[3], b1[0], b1[1], b1[2], b1[3]};
#pragma unroll
                for (int h = 0; h < 8; ++h) ((LAS float*)(lds + TB_OFF))[h * 192 + tid] = ok ? bv[h] * LOG2E : -1.0e30f; }
            __syncthreads();
            for (int unit = bid; unit < 256; unit += G) {
                { int t1 = threadIdx.x; asm volatile("" : "+v"(t1)); rg_out_vec(args, l, unit, t1); }
                { int t3 = threadIdx.x; asm volatile("" : "+v"(t3)); sc_conv_vec(args, l, unit, t3); }
                { int t2 = threadIdx.x; asm volatile("" : "+v"(t2)); swa_unit_mfma(args, lds, TB_OFF, l, unit, t2); }
            }
        }
        PHASE_END
        PHASE_BEGIN
        {
            pg8::Gemm g{(const bf16*)(ws + WS_MIXED), (const bf16*)(ws + WS_WOUT) + (size_t)l * 1024 * 1024, M, D, 1024}; pg8::StaticOrder S; S.init(M, D, G, bid);
            pg8::EpiResid E{xb, rowsq + (size_t)(3 * l + 1) * M * 4, (LAS float*)(lds + RED_OFF), (unsigned char*)(ws + WS_X8), 1.0f};
            pg8::gemm_phase<pg8::EpiResid, pg8::StaticOrder, true, true>(lds + RING_OFF, g, S, E);
        }
        PHASE_END
        PHASE_BEGIN
        {
            pg8::Gemm g{(const bf16*)(ws + WS_X8), (const bf16*)(ws + WS_WXQ + (size_t)l * 512 * 1024), M, 512, 1024}; pg8::StaticOrder S; S.init(M, 512, G, bid);
            pg8::EpiScaleBf16 E{(bf16*)(ws + WS_QXA), 512, rowsq + (size_t)(3 * l + 1) * M * 4, 1.0f / W8_SCALE};
            pg8::gemm_phase<pg8::EpiScaleBf16, pg8::StaticOrder, true, true, true>(lds + RING_OFF, g, S, E);
        }
        PHASE_END
        PHASE_BEGIN
        {
            for (int unit = bid; unit < 256; unit += G) xa_unit_mfma(args, lds, l, unit, tid);
        }
        PHASE_END
        PHASE_BEGIN
        {
            pg8::Gemm g{(const bf16*)(ws + WS_XO), (const bf16*)(ws + WS_WXO + (size_t)l * 1024 * 512), M, D, 512}; pg8::StaticOrder S; S.init(M, D, G, bid);
            pg8::EpiResid E{xb, rowsq + (size_t)(3 * l + 2) * M * 4, (LAS float*)(lds + RED_OFF), l == 1 ? (unsigned char*)(ws + WS_X8) : nullptr, 1.0f / W8_SCALE};
            pg8::gemm_phase<pg8::EpiResid, pg8::StaticOrder, true, true, true>(lds + RING_OFF, g, S, E);
        }
        PHASE_END
        if (l == 0) {
            PHASE_BEGIN
            {
                pg8::Gemm g{xb, (const bf16*)(ws + WS_WDGU), M, 2 * FFD, 1024}; pg8::StaticOrder S; S.init(M, 2 * FFD, G, bid);
                pg8::EpiSwigluF8<false> E{(unsigned char*)(ws + WS_HD), FFD, rowsq + (size_t)2 * M * 4, 0, 2 * FFD / 256, 1.0f};
                pg8::gemm_phase<pg8::EpiSwigluF8<false>, pg8::StaticOrder, true, true>(lds + RING_OFF, g, S, E);
            }
            PHASE_END
            PHASE_BEGIN
            {
                pg8::Gemm g{(const bf16*)(ws + WS_HD), (const bf16*)(ws + WS_WDD), M, D, FFD}; pg8::StaticOrder S; S.init(M, D, G, bid);
                pg8::EpiResid E{xb, rowsq + (size_t)3 * M * 4, (LAS float*)(lds + RED_OFF), nullptr, 1.0f / W8_SCALE};
                pg8::gemm_phase<pg8::EpiResid, pg8::StaticOrder, true, true, true>(lds + RING_OFF, g, S, E);
            }
            PHASE_END
        } else {
            int* tok_e = (int*)(ws + WS_TOKE); float* tok_w = (float*)(ws + WS_TOKW); int* tok_p = (int*)(ws + WS_TOKP); float* tok_r = (float*)(ws + WS_TOKR);
            int* slot_tok = (int*)(ws + WS_SLOTT); float* slot_gate = (float*)(ws + WS_SLOTG); float* slot_rstd = (float*)(ws + WS_SLOTR);
            int* tile_e = (int*)(ws + WS_TILEE); int* wgcnt = (int*)(ws + WS_WGCNT); int* wvbase = (int*)(ws + WS_WVCNT);
            PHASE_BEGIN
            {
                LAS unsigned char* Rt = lds;
                LAS float* Dl = (LAS float*)(lds + 32768);
                LAS int* wcnt = (LAS int*)(lds + 32768 + 8192);
                { const float* rp = args.in[26]; const float* gp = args.in[22] + 1024;
#pragma unroll
                  for (int i = 0; i < 16; ++i) { const int q = tid + i * NWAVES * 64, k = q >> 3, e = q & 7; const float v = rp[q] * gp[k];
                      const unsigned hb = f2bf(v); const unsigned lb = f2bf(v - __builtin_bit_cast(float, hb << 16));
                      *(LAS unsigned short*)(Rt + e * 2048 + (((k >> 3) ^ e) << 4) + (k & 7) * 2) = (unsigned short)hb;
                      *(LAS unsigned short*)(Rt + (8 + e) * 2048 + (((k >> 3) ^ (8 + e)) << 4) + (k & 7) * 2) = (unsigned short)lb; } }
                for (int tb = bid; tb < 256; tb += G) {
                    __syncthreads();
                    if (tid < 64) wcnt[tid] = 0;
                    __syncthreads();
                    if (wave < 4) {
                        const int r32 = lane & 31, hi = lane >> 5; const int t = tb * 128 + wave * 32 + r32;
                        const bf16* xp = xb + (size_t)t * D + hi * 8;
                        f32x16 acc;
#pragma unroll
                        for (int r = 0; r < 16; ++r) acc[r] = 0.f;
#pragma unroll 1
                        for (int ks0 = 0; ks0 < 64; ks0 += 8) {
                            bf16x8v a[8];
#pragma unroll
                            for (int j = 0; j < 8; ++j) a[j] = *(const bf16x8v*)(xp + (ks0 + j) * 16);
#pragma unroll
                            for (int j = 0; j < 8; ++j) { const int ks = ks0 + j; v4u bz = (v4u){0u, 0u, 0u, 0u};
                                if (r32 < 16) bz = *(const LAS v4u*)(Rt + r32 * 2048 + (((2 * ks + hi) ^ r32) << 4));
                                acc = __builtin_amdgcn_mfma_f32_32x32x16_bf16(a[j], __builtin_bit_cast(bf16x8v, bz), acc, 0, 0, 0); }
                        }
                        LAS float* dw = Dl + wave * 512;
                        if (r32 < 16) {
#pragma unroll
                            for (int r = 0; r < 16; ++r) dw[((r & 3) + 8 * (r >> 2) + 4 * hi) * 16 + r32] = acc[r]; }
                        LDS_WAIT();
                        int e1 = -1, e2 = -1; float w1 = 0.f, w2 = 0.f, rs = 0.f;
                        if (lane < 32) {
                            const f32x4 pq = *(const f32x4*)(rowsq + ((size_t)5 * M + t) * 4);
                            rs = pg8::rstd_of((pq[0] + pq[1]) + (pq[2] + pq[3]));
                            float lg[8];
#pragma unroll
                            for (int e = 0; e < 8; ++e) lg[e] = (dw[lane * 16 + e] + dw[lane * 16 + 8 + e]) * rs;
                            e1 = 0; float l1 = lg[0];
#pragma unroll
                            for (int e = 1; e < 8; ++e) if (lg[e] > l1) { l1 = lg[e]; e1 = e; }
                            float l2 = -3.0e38f;
#pragma unroll
                            for (int e = 0; e < 8; ++e) if (e != e1 && lg[e] > l2) { l2 = lg[e]; e2 = e; }
                            w2 = 1.0f / (1.0f + expf(l1 - l2)); w1 = 1.0f - w2;
                        }
                        int p1 = 0, p2 = 0, cnt_e = 0;
#pragma unroll
                        for (int e = 0; e < 8; ++e) { const unsigned long long m = __ballot((e1 == e) || (e2 == e)); const int rk = __popcll(m & ((1ull << lane) - 1ull));
                            if (e1 == e) p1 = rk; if (e2 == e) p2 = rk; if (lane == e) cnt_e = __popcll(m); }
                        if (lane < 8) wcnt[wave * 8 + lane] = cnt_e;
                        if (lane < 32) { tok_e[2 * t] = e1; tok_e[2 * t + 1] = e2; tok_w[2 * t] = w1; tok_w[2 * t + 1] = w2; tok_p[2 * t] = p1; tok_p[2 * t + 1] = p2; tok_r[t] = rs; }
                    }
                    __syncthreads();
                    if (tid < 8) { int s = 0; for (int w = 0; w < 8; ++w) { const int c = wcnt[w * 8 + tid]; wvbase[(tb * 8 + w) * 8 + tid] = s; s += c; } wgcnt[tb * 8 + tid] = s; }
                }
            }
            PHASE_END
            PHASE_BEGIN
            {
                LAS int* tot = (LAS int*)lds; LAS int* offs = (LAS int*)(lds + 64); LAS int* base = (LAS int*)(lds + 128);
                LAS int* cl = (LAS int*)(lds + 1024);
                LAS int* ps = (LAS int*)(lds + 1024 + 8192);
                LAS int* pb = (LAS int*)(lds + 1024 + 8192 + 2048);
                for (int i = tid; i < 2048; i += NWAVES * 64) cl[i] = wgcnt[i];
                __syncthreads();
                for (int tb = bid; tb < 256; tb += G) {
                    { const int e = tid & 7, part = tid >> 3; int s = 0, sb = 0;
#pragma unroll
                      for (int j = 0; j < 4; ++j) { const int w = part * 4 + j; const int c = cl[w * 8 + e]; s += c; sb += (w < tb) ? c : 0; }
                      ps[tid] = s; pb[tid] = sb; }
                    __syncthreads();
                    if (tid < 8) { int s = 0, sb = 0;
#pragma unroll 8
                        for (int part = 0; part < 64; ++part) { s += ps[part * 8 + tid]; sb += pb[part * 8 + tid]; }
                        tot[tid] = s; base[tid] = sb; }
                    __syncthreads();
                    if (tid == 0) { int o = 0; for (int e = 0; e < 8; ++e) { offs[e] = o; o += (tot[e] + 255) & ~255; } offs[8] = o; }
                    __syncthreads();
                    if (tb == 0) {
                        if (tid == 0) { int nt = 0; for (int e = 0; e < 8; ++e) { const int k = (offs[e + 1] - offs[e]) >> 8; for (int j = 0; j < k; ++j) tile_e[nt++] = e; } tile_e[300] = nt; }
                        for (int e = 0; e < 8; ++e) for (int s = offs[e] + tot[e] + tid; s < offs[e + 1]; s += NWAVES * 64) slot_tok[s] = -1;
                    }
                    if (tid < 256) {
                        const int p = tid, t = tb * 128 + (p >> 1), k = p & 1;
                        const int e = tok_e[2 * t + k]; const int slot = offs[e] + base[e] + wvbase[(tb * 8 + (p >> 6)) * 8 + e] + tok_p[2 * t + k];
                        slot_tok[slot] = t | (k << 24); slot_gate[slot] = tok_w[2 * t + k]; slot_rstd[slot] = tok_r[t];
                    }
                    __syncthreads();
                }
            }
            PHASE_END
            PHASE_BEGIN
            {
                const int nt = __builtin_amdgcn_readfirstlane(__hip_atomic_load(tile_e + 300, RLX_AGENT)); const int ntA = nt - GTILES;
                LAS int* te_lds = (LAS int*)(lds + LDSCTL_OFF + 6144);
                for (int i = tid; i < nt; i += NWAVES * 64) te_lds[i] = __hip_atomic_load(tile_e + i, RLX_AGENT);
                __syncthreads();
                pg8::Gemm g{(const bf16*)(ws + WS_X8), (const bf16*)(ws + WS_WMGU), 0, 0, 1024}; pg8::MoeGatherOrder S; S.init(ntA, 2 * FFE / 256, G, bid, 0, 0, te_lds); S.slot_tok = slot_tok;
                pg8::EpiSwigluF8<true> E{(unsigned char*)(ws + WS_HG), FFE, slot_rstd, 0, 2 * FFE / 256, 1.0f / W8_SCALE};
                pg8::gemm_phase<pg8::EpiSwigluF8<true>, pg8::MoeGatherOrder, true, true, true>(lds + RING_OFF, g, S, E);
            }
            PHASE_END
            PHASE_BEGIN
            {
                const int nt = __builtin_amdgcn_readfirstlane(__hip_atomic_load(tile_e + 300, RLX_AGENT)); const int ntA = nt - GTILES;
                LAS int* te_lds = (LAS int*)(lds + LDSCTL_OFF + 6144);
                for (int i = tid; i < nt; i += NWAVES * 64) te_lds[i] = __hip_atomic_load(tile_e + i, RLX_AGENT);
                __syncthreads();
                {
                    pg8::Gemm g{(const bf16*)(ws + WS_HG), (const bf16*)(ws + WS_WMD), 0, 0, FFE}; pg8::MoeOrder S; S.init(ntA, D / 256, G, bid, 0, 0, te_lds);
                    pg8::EpiMoeDown E{(unsigned char*)(ws + WS_Y0), (unsigned char*)(ws + WS_Y1), slot_tok, slot_gate, 0, D / 256, 1.0f / W8_SCALE};
                    pg8::gemm_phase<pg8::EpiMoeDown, pg8::MoeOrder, true, true, true>(lds + RING_OFF, g, S, E);
                }
                __syncthreads();
                {
                    const int nmd = ntA * (D / 256);
                    pg8::Gemm g{(const bf16*)(ws + WS_X8), (const bf16*)(ws + WS_WMGU), 0, 0, 1024}; pg8::MoeGatherSkipOrder S; S.init(GTILES, 2 * FFE / 256, G, bid, ntA, ntA, te_lds + ntA); S.slot_tok = slot_tok;
                    S.rem = nmd % G; S.skip = (S.rem == 0) ? 0 : MD_SKIP;
                    pg8::EpiSwigluF8<true> E{(unsigned char*)(ws + WS_HGB), FFE, slot_rstd, ntA, 2 * FFE / 256, 1.0f / W8_SCALE};
                    pg8::gemm_phase<pg8::EpiSwigluF8<true>, pg8::MoeGatherSkipOrder, true, true, true>(lds + RING_OFF, g, S, E);
                }
            }
            PHASE_END
            PHASE_BEGIN
            {
                const int nt = __builtin_amdgcn_readfirstlane(__hip_atomic_load(tile_e + 300, RLX_AGENT)); const int ntA = nt - GTILES;
                LAS int* te_lds = (LAS int*)(lds + LDSCTL_OFF + 6144);
                for (int i = tid; i < nt; i += NWAVES * 64) te_lds[i] = __hip_atomic_load(tile_e + i, RLX_AGENT);
                __syncthreads();
                pg8::Gemm g{(const bf16*)(ws + WS_HGB), (const bf16*)(ws + WS_WMD), 0, 0, FFE}; pg8::MoeOrder S; S.init(GTILES, D / 256, G, bid, 0, ntA, te_lds + ntA);
                pg8::EpiMoeDown E{(unsigned char*)(ws + WS_Y0), (unsigned char*)(ws + WS_Y1), slot_tok, slot_gate, ntA, D / 256, 1.0f / W8_SCALE};
                pg8::gemm_phase<pg8::EpiMoeDown, pg8::MoeOrder, true, true, true>(lds + RING_OFF, g, S, E);
            }
            PHASE_END
        }
    }
    PHASE_BEGIN
    {
        const int gw = bid * NWAVES + wave, NGW = G * NWAVES; const unsigned char* Y0 = (const unsigned char*)(ws + WS_Y0); const unsigned char* Y1 = (const unsigned char*)(ws + WS_Y1);
        f32x4 gg[4];
        { const GAS f32x4* gr = (const GAS f32x4*)args.in[30]; gg[0] = gr[2 * lane]; gg[1] = gr[2 * lane + 1]; gg[2] = gr[128 + 2 * lane]; gg[3] = gr[128 + 2 * lane + 1]; }
        for (int m0 = gw; m0 < M; m0 += 4 * NGW) {
            v4u a[4][2]; v2u b0[4][2], b1[4][2];
#pragma unroll
            for (int u = 0; u < 4; ++u) { const size_t m = (size_t)(m0 + u * NGW);
                const GAS v4u* xr = (const GAS v4u*)(xb + m * D) + lane; const GAS v2u* y0 = (const GAS v2u*)(Y0 + m * D) + lane; const GAS v2u* y1 = (const GAS v2u*)(Y1 + m * D) + lane;
                a[u][0] = xr[0]; a[u][1] = xr[64]; b0[u][0] = y0[0]; b0[u][1] = y0[64]; b1[u][0] = y1[0]; b1[u][1] = y1[64]; }
#pragma unroll
            for (int u = 0; u < 4; ++u) { const size_t m = (size_t)(m0 + u * NGW); f32x4 v[4]; float s = 0.f;
#pragma unroll
                for (int h = 0; h < 2; ++h) { const v4u xa = a[u][h]; const v2u ya = b0[u][h], yb = b1[u][h];
                    const f32x2 p0 = __builtin_amdgcn_cvt_pk_f32_fp8((int)ya.x, false), p1 = __builtin_amdgcn_cvt_pk_f32_fp8((int)ya.x, true), p2 = __builtin_amdgcn_cvt_pk_f32_fp8((int)ya.y, false), p3 = __builtin_amdgcn_cvt_pk_f32_fp8((int)ya.y, true);
                    const f32x2 r0 = __builtin_amdgcn_cvt_pk_f32_fp8((int)yb.x, false), r1 = __builtin_amdgcn_cvt_pk_f32_fp8((int)yb.x, true), r2 = __builtin_amdgcn_cvt_pk_f32_fp8((int)yb.y, false), r3 = __builtin_amdgcn_cvt_pk_f32_fp8((int)yb.y, true);
                    v[2 * h] = (f32x4){bflo(xa.x) + p0.x + r0.x, bfhi(xa.x) + p0.y + r0.y, bflo(xa.y) + p1.x + r1.x, bfhi(xa.y) + p1.y + r1.y};
                    v[2 * h + 1] = (f32x4){bflo(xa.z) + p2.x + r2.x, bfhi(xa.z) + p2.y + r2.y, bflo(xa.w) + p3.x + r3.x, bfhi(xa.w) + p3.y + r3.y}; }
#pragma unroll
                for (int j = 0; j < 4; ++j) s += (v[j].x * v[j].x + v[j].y * v[j].y) + (v[j].z * v[j].z + v[j].w * v[j].w);
                const float rs = pg8::rstd_of(wave_sum(s));
                GAS f32x4* orow = (GAS f32x4*)(xres + m * D);
                orow[2 * lane] = v[0] * rs * gg[0]; orow[2 * lane + 1] = v[1] * rs * gg[1]; orow[128 + 2 * lane] = v[2] * rs * gg[2]; orow[128 + 2 * lane + 1] = v[3] * rs * gg[3]; }
        }
    }
    PHASE_END
#undef PHASE_BEGIN
#undef PHASE_END
#undef ws
#undef xres
#undef rowsq
#undef xb
}

extern "C" void kernel_launch(void* const* d_in, const int* in_sizes, int n_in, void* d_out, int out_size, void* d_ws, size_t ws_size, hipStream_t stream) {
    static int grid = 0;
    if (grid == 0) {
        if (n_in != 31 || in_sizes[0] != M * D || out_size != M * D || ws_size < WS_END) { fprintf(stderr, "kernel_launch: unexpected shapes / workspace (n_in %d, ws %zu, need %zu)\n", n_in, ws_size, (size_t)WS_END); grid = -1; return; }
        int dev = 0, cus = 0, per_cu = 0;
        if (hipGetDevice(&dev) != hipSuccess || hipDeviceGetAttribute(&cus, hipDeviceAttributeMultiprocessorCount, dev) != hipSuccess) { grid = -1; return; }
        if (hipFuncSetAttribute((const void*)hymba_fwd, hipFuncAttributeMaxDynamicSharedMemorySize, LDS_BYTES) != hipSuccess) { fprintf(stderr, "kernel_launch: hipFuncSetAttribute failed\n"); grid = -1; return; }
        if (hipOccupancyMaxActiveBlocksPerMultiprocessor(&per_cu, (const void*)hymba_fwd, NWAVES * 64, LDS_BYTES) != hipSuccess || per_cu < 1) fprintf(stderr, "kernel_launch: occupancy query reports %d\n", per_cu);
        (void)hipGetLastError();
        grid = cus;
    }
    if (grid < 0) return;
    if (hipMemsetAsync((char*)d_ws + WS_CTL, 0, CTL_ZERO_BYTES, stream) != hipSuccess) return;
    Args a{};
    for (int i = 0; i < 31; ++i) a.in[i] = (const float*)d_in[i];
    a.out = (float*)d_out; a.ws = (unsigned char*)d_ws;
#if MK_ONE_LAUNCH
    a.ph_lo = 0; a.ph_hi = 1000;
    hipLaunchKernelGGL(hymba_fwd, dim3(grid), dim3(NWAVES * 64), LDS_BYTES, stream, a);
#else
    for (int p = 0; p < NPHASES; ++p) { a.ph_lo = p; a.ph_hi = p + 1; hipLaunchKernelGGL(hymba_fwd, dim3(grid), dim3(NWAVES * 64), LDS_BYTES, stream, a); }
#endif
}
```
